# Optimizing an MI355X kernel written in HIP

```python
import jax, jax.numpy as jnp
from jax import lax
import numpy as np

D_MODEL = 1024
BATCH = 2
SEQ = 8192
DEPTH = 1

N_META = 16
D_MIX = D_MODEL
D_CONV = D_MIX // 2
CONV_HEADS = 8
CONV_WIDTH = 3
D_RET = D_MIX - D_CONV
RET_HEADS = 4
RET_HEAD_DIM = D_RET // RET_HEADS
CHUNK = 128
ROPE_BASE = 10000.0
EPS = 1e-6
N_PROJ = 8

kernel_name = "hymba_conv_retention_hybrid"


def rms_norm(x, g):
    xf = x.astype(jnp.float32)
    y = xf * lax.rsqrt(jnp.mean(xf * xf, axis=-1, keepdims=True) + EPS)
    return (y * g.astype(jnp.float32)).astype(x.dtype)


def rotary(t, pos):
    half = t.shape[-1] // 2
    freqs = 1.0 / (ROPE_BASE ** (jnp.arange(half, dtype=jnp.float32) / half))
    ang = pos.astype(jnp.float32)[:, None] * freqs[None, :]
    cos = jnp.cos(ang)[None, :, None, :]
    sin = jnp.sin(ang)[None, :, None, :]
    t1, t2 = t[..., :half], t[..., half:]
    return jnp.concatenate([t1 * cos - t2 * sin, t1 * sin + t2 * cos], axis=-1)


def short_conv_branch(h, b_gate, c_gate, conv_w):
    u = c_gate * h
    kern = conv_w.reshape(CONV_WIDTH, 1, D_CONV).astype(u.dtype)
    conv = lax.conv_general_dilated(
        u, kern, window_strides=(1,), padding=[(CONV_WIDTH - 1, 0)],
        dimension_numbers=('NWC', 'WIO', 'NWC'), feature_group_count=D_CONV)
    return b_gate * conv


def retention_chunkwise(q, k, v):
    bsz, L, H, d = q.shape
    pad = CHUNK - N_META
    P = L + pad
    n_chunks = P // CHUNK

    def to_chunks(t):
        t = jnp.pad(t, ((0, 0), (pad, 0), (0, 0), (0, 0)))
        return t.reshape(bsz, n_chunks, CHUNK, H, d).transpose(0, 3, 1, 2, 4)

    qc, kc, vc = to_chunks(q), to_chunks(k), to_chunks(v)
    log_g = jnp.log(1.0 - 2.0 ** (-5.0 - jnp.arange(H, dtype=jnp.float32)))
    idx = jnp.arange(CHUNK, dtype=jnp.float32)
    diff = idx[:, None] - idx[None, :]
    decay = jnp.where(diff[None] >= 0, jnp.exp(diff[None] * log_g[:, None, None]), 0.0)

    scores = jnp.einsum('bhnid,bhnjd->bhnij', qc, kc) * decay[None, :, None]
    inner = jnp.einsum('bhnij,bhnje->bhnie', scores, vc)

    zeta = jnp.exp((CHUNK - 1 - idx)[None, :] * log_g[:, None])
    upd = jnp.einsum('bhnjd,bhnje->nbhde', kc * zeta[None, :, None, :, None], vc)
    chunk_decay = jnp.exp(CHUNK * log_g)[None, :, None, None]

    def step(state, u):
        return chunk_decay * state + u, state

    init = jnp.zeros((bsz, H, d, d), jnp.float32)
    _, states = lax.scan(step, init, upd)
    xi = jnp.exp((idx + 1.0)[None, :] * log_g[:, None])
    cross = jnp.einsum('bhnid,nbhde->bhnie', qc * xi[None, :, None, :, None], states)

    out = (inner + cross).transpose(0, 2, 3, 1, 4).reshape(bsz, P, H, d)
    return out[:, pad:]


def head_group_norm(o, g):
    mu = jnp.mean(o, axis=-1, keepdims=True)
    var = jnp.mean(jnp.square(o - mu), axis=-1, keepdims=True)
    y = (o - mu) * lax.rsqrt(var + EPS)
    bsz, L = o.shape[:2]
    return y.reshape(bsz, L, D_RET) * g.astype(jnp.float32)


def mixer_layer(h, norm_g, w_in, conv_w, ret_norm_g, w_out, pos):
    bsz, L, _ = h.shape
    hn = rms_norm(h, norm_g)
    proj = jnp.einsum('bld,de->ble', hn, w_in)
    cx, cb, cc, cg, q, k, v, rg = jnp.split(proj, N_PROJ, axis=-1)

    conv_out = short_conv_branch(cx, cb, cc, conv_w) * jax.nn.silu(cg)

    shp = (bsz, L, RET_HEADS, RET_HEAD_DIM)
    qf = rotary(q.reshape(shp).astype(jnp.float32), pos) * (RET_HEAD_DIM ** -0.5)
    kf = rotary(k.reshape(shp).astype(jnp.float32), pos)
    vf = v.reshape(shp).astype(jnp.float32)
    ret = head_group_norm(retention_chunkwise(qf, kf, vf), ret_norm_g)
    ret_out = ret.astype(h.dtype) * jax.nn.silu(rg)

    mixed = jnp.concatenate([conv_out, ret_out], axis=-1)
    return h + jnp.einsum('ble,ed->bld', mixed, w_out)


def setup_inputs(seed: int = 0) -> dict:
    key = jax.random.key(seed)
    ks = jax.random.split(key, 8)
    x = jax.random.normal(ks[0], (BATCH, SEQ, D_MODEL), jnp.float32)
    meta = jax.random.normal(ks[1], (N_META, D_MODEL), jnp.float32)
    norm1_g = 1.0 + 0.02 * jax.random.normal(ks[2], (D_MODEL,), jnp.float32)
    w_in = jax.random.normal(ks[3], (D_MODEL, N_PROJ * D_CONV), jnp.float32) * D_MODEL ** -0.5
    conv_w = jax.random.normal(ks[4], (CONV_WIDTH, D_CONV), jnp.float32) * CONV_WIDTH ** -0.5
    ret_norm_g = 1.0 + 0.02 * jax.random.normal(ks[5], (D_RET,), jnp.float32)
    w_out = jax.random.normal(ks[6], (D_MIX, D_MODEL), jnp.float32) * D_MIX ** -0.5
    final_g = 1.0 + 0.02 * jax.random.normal(ks[7], (D_MODEL,), jnp.float32)
    return {"x": x, "meta": meta, "norm1_g": norm1_g, "w_in": w_in, "conv_w": conv_w,
            "ret_norm_g": ret_norm_g, "w_out": w_out, "final_g": final_g}


def reference(x, meta, norm1_g, w_in, conv_w, ret_norm_g, w_out, final_g):
    bsz = x.shape[0]
    meta_b = jnp.broadcast_to(meta.astype(x.dtype)[None], (bsz, N_META, D_MODEL))
    h = jnp.concatenate([meta_b, x], axis=1)
    pos = jnp.arange(h.shape[1], dtype=jnp.int32)
    for _ in range(DEPTH):
        h = mixer_layer(h, norm1_g, w_in, conv_w, ret_norm_g, w_out, pos)
    h = rms_norm(h, final_g)
    return h[:, N_META:]
```

```cpp
#include <hip/hip_runtime.h>
#include <hip/hip_cooperative_groups.h>
#include <cstdio>
#include <cstdint>
namespace cg = cooperative_groups;

#define DI __device__ __forceinline__
#define LAS __attribute__((address_space(3)))
typedef unsigned short bf16_t;
typedef short bf16x8 __attribute__((ext_vector_type(8)));
typedef short s16x4 __attribute__((ext_vector_type(4)));
typedef short v4i16_t __attribute__((ext_vector_type(4)));
typedef float f32x2 __attribute__((ext_vector_type(2)));
typedef float f32x4 __attribute__((ext_vector_type(4)));
typedef float f32x16 __attribute__((ext_vector_type(16)));
typedef unsigned u32x2 __attribute__((ext_vector_type(2)));
typedef unsigned u32x4 __attribute__((ext_vector_type(4)));
typedef __bf16 bf16x2_t __attribute__((ext_vector_type(2)));

constexpr int M_TOK = 16384, DM = 1024, NPROJ = 4096, SEQ = 8192, NMETA = 16, NCHUNK = 64;
constexpr float EPS = 1e-6f;

constexpr size_t MiB = 1u << 20;
constexpr size_t WS_RSTD = 64 * 1024, WS_MP = 128 * 1024, WS_PART = 1 * MiB, WS_WIN = 2 * MiB, WS_WOUT = 10 * MiB, WS_XB = 16 * MiB;
constexpr size_t WS_U = 48 * MiB, WS_G = 64 * MiB, WS_QS = 80 * MiB, WS_KZ = 96 * MiB, WS_V = 112 * MiB, WS_SRG = 128 * MiB;
constexpr size_t WS_UPD = 144 * MiB, WS_TT = 176 * MiB, WS_MIX = 194 * MiB, WS_END = 226 * MiB;
constexpr int LDS_BYTES = 147456;

DI unsigned pk2(float lo, float hi) { f32x2 v = {lo, hi}; bf16x2_t b = __builtin_convertvector(v, bf16x2_t); return __builtin_bit_cast(unsigned, b); }
DI float bf_lo(unsigned u) { return __uint_as_float(u << 16); }
DI float bf_hi(unsigned u) { return __uint_as_float(u & 0xffff0000u); }
DI float silu_f(float x) { return x * __builtin_amdgcn_rcpf(1.f + __expf(-x)); }
DI float wave_sum(float v) {
#pragma unroll
    for (int o = 1; o < 64; o <<= 1) v += __shfl_xor(v, o);
    return v;
}
DI void sincos_rr(float ang, float& s, float& c) {
    const float k = rintf(ang * 0.15915494309189535f);
    float r = fmaf(-k, 6.2831854820251465f, ang);
    r = fmaf(-k, -1.7484555e-7f, r);
    const float rev = r * 0.15915494309189535f;
    s = __builtin_amdgcn_sinf(rev); c = __builtin_amdgcn_cosf(rev);
}
DI int opaque_tid() { int t = threadIdx.x; asm volatile("" : "+v"(t)); return t; }
DI float rope_freq(int d) { return exp2f(-(float)d * (13.287712379549449f / 64.f)); }
DI float log2_gamma(int h) { return log2f(1.f - exp2f(-5.f - (float)h)); }

namespace pg8 {
constexpr int BM = 256, BK = 64, HALF = 128, HTB = HALF * BK * 2, STAGE_BYTES = 8 * HTB, NXCD = 8, WGM = 8;
DI int lds_byte(int r, int c) { const int st = (r >> 4) * 2 + (c >> 5), rr = r & 15, cc = c & 31, ob = rr * 64 + cc * 2; return st * 1024 + (ob ^ (((ob >> 9) & 1) << 5)); }
DI void stage_rc(int b, int& R, int& C) { const int st = b / 1024, sb = b % 1024, swz = sb ^ (((sb >> 9) & 1) << 5); R = (st >> 1) * 16 + swz / 64; C = (st & 1) * 32 + (swz % 64) / 2; }
DI int perm32(int rho) { const int n = rho >> 4, i = rho & 15; return 8 * (i >> 2) + 4 * n + (i & 3); }
struct Unit { int pm, pn; };
struct Gemm { const bf16_t* A; const bf16_t* Bt; int M, N, K; };
struct StaticOrder {
    int nM, nN, nwg, G, c;
    DI void init(int M, int N, int G_, int c_) { nM = M / BM; nN = N / BM; nwg = nM * nN; G = G_; c = c_; }
    DI bool next(int i, Unit& u) const {
        const long L = (long)i * G + c; if (L >= nwg) return false;
        int wgid = (int)L; { const int q = nwg / NXCD, r = nwg % NXCD, xcd = wgid % NXCD, off = wgid / NXCD; wgid = (xcd < r ? xcd * (q + 1) : r * (q + 1) + (xcd - r) * q) + off; }
        const int nig = WGM * nN, gid = wgid / nig, fm = gid * WGM, gsz = (nM - fm) < WGM ? (nM - fm) : WGM;
        u.pm = fm + ((wgid % nig) % gsz); u.pn = (wgid % nig) / gsz; return true;
    }
    DI void a_ready(const Unit&) const {}
    DI void done(const Unit&) const {}
};

template <class Epi, class Sched, bool ALIGN_EPI = false, bool SP2 = false>
DI void gemm_phase(LAS unsigned char* lds, const Gemm g, const Sched& S, const Epi& E) {
    const int tid = opaque_tid(), wid = __builtin_amdgcn_readfirstlane(tid >> 6), lane = tid & 63, wr = wid >> 2, wc = wid & 3, fr = lane & 15, fq = lane >> 4;
    const int K = g.K, nt = K / BK;
    unsigned voffA[2], voffB[2];
#pragma unroll
    for (int i = 0; i < 2; ++i) { int R, C; stage_rc(tid * 16 + i * 8192, R, C); const int Rb = Epi::PERM ? ((R & ~31) + perm32(R & 31)) : R;
        voffA[i] = (unsigned)(R * K + C) * 2u; voffB[i] = (unsigned)(Rb * K + C) * 2u; }
    const size_t kstep = (size_t)(BK * 2);
    const size_t hstep = (size_t)HALF * K * 2;
    const size_t tstep = 2 * hstep;
    const unsigned ldsw = (unsigned)wid * 1024u;
    const int aoff = lds_byte(wr * 64 + fr, fq * 8), boff = lds_byte(wc * 32 + fr, fq * 8);
#define PG8_SA(b, h) (((b) * 2 + (h)) * HTB)
#define PG8_SB(b, h) ((4 + (b) * 2 + (h)) * HTB)
#define PG8_STAGE(bufoff, gbase, voff) do { _Pragma("unroll") for (int _i = 0; _i < 2; ++_i) \
        __builtin_amdgcn_global_load_lds((const unsigned*)((const char*)(gbase) + (voff)[_i]), (LAS unsigned*)(lds + (bufoff) + ldsw + _i * 8192), 16, 0, 0); } while (0)
#define PG8_LDA(dst, b, h) do { _Pragma("unroll") for (int m = 0; m < 4; ++m) _Pragma("unroll") for (int k = 0; k < 2; ++k) dst[m][k] = *(const LAS bf16x8*)(lds + PG8_SA(b, h) + aoff + m * 2048 + k * 1024); } while (0)
#define PG8_LDB(dst, b, h) do { _Pragma("unroll") for (int n = 0; n < 2; ++n) _Pragma("unroll") for (int k = 0; k < 2; ++k) dst[n][k] = *(const LAS bf16x8*)(lds + PG8_SB(b, h) + boff + n * 2048 + k * 1024); } while (0)
#define PG8_MMA(ai, bj, At, Bt) do { __builtin_amdgcn_s_setprio(1); _Pragma("unroll") for (int m = 0; m < 4; ++m) _Pragma("unroll") for (int n = 0; n < 2; ++n) _Pragma("unroll") for (int k = 0; k < 2; ++k) \
        acc[ai][bj][m][n] = __builtin_amdgcn_mfma_f32_16x16x32_bf16(Bt[n][k], At[m][k], acc[ai][bj][m][n], 0, 0, 0); __builtin_amdgcn_s_setprio(0); } while (0)
#define PG8_WAIT_V(n) asm volatile("s_waitcnt vmcnt(" #n ")" ::: "memory")
#define PG8_WAIT_L(n) asm volatile("s_waitcnt lgkmcnt(" #n ")" ::: "memory")
#define PG8_BAR __builtin_amdgcn_s_barrier()
#define PG8_SCHED __builtin_amdgcn_sched_barrier(0)
    Unit cur, nxt; int ui = 0;
    if (!S.next(0, cur)) return;
    f32x4 acc[2][2][4][2];
#pragma unroll
    for (int a = 0; a < 2; ++a)
#pragma unroll
        for (int b = 0; b < 2; ++b)
#pragma unroll
            for (int m = 0; m < 4; ++m)
#pragma unroll
                for (int n = 0; n < 2; ++n) acc[a][b][m][n] = (f32x4){0.f, 0.f, 0.f, 0.f};
    bf16x8 At[4][2], B0[2][2], B1[2][2];
    const char* cA = (const char*)g.A + (size_t)cur.pm * tstep; const char* cB = (const char*)g.Bt + (size_t)cur.pn * tstep;
    S.a_ready(cur);
    if constexpr (SP2) {
        PG8_STAGE(PG8_SB(0, 0), cB, voffB); PG8_STAGE(PG8_SB(0, 1), cB + hstep, voffB); PG8_STAGE(PG8_SA(0, 0), cA, voffA); PG8_STAGE(PG8_SA(0, 1), cA + hstep, voffA);
        if (wr == 1) PG8_BAR;
        PG8_WAIT_V(2); PG8_BAR;
        PG8_STAGE(PG8_SB(1, 0), cB + kstep, voffB); PG8_STAGE(PG8_SA(1, 0), cA + kstep, voffA); PG8_STAGE(PG8_SB(1, 1), cB + hstep + kstep, voffB);
        PG8_WAIT_V(6); PG8_BAR;
    } else {
        PG8_STAGE(PG8_SB(0, 0), cB, voffB); PG8_STAGE(PG8_SA(0, 0), cA, voffA); PG8_STAGE(PG8_SB(0, 1), cB + hstep, voffB); PG8_STAGE(PG8_SA(0, 1), cA + hstep, voffA);
        if (wr == 1) PG8_BAR;
        PG8_WAIT_V(4); PG8_BAR;
        PG8_STAGE(PG8_SB(1, 0), cB + kstep, voffB); PG8_STAGE(PG8_SA(1, 0), cA + kstep, voffA); PG8_STAGE(PG8_SB(1, 1), cB + hstep + kstep, voffB);
        PG8_WAIT_V(6); PG8_BAR;
    }
    for (;;) {
        const bool has_next = S.next(ui + 1, nxt);
        const char* nA = has_next ? (const char*)g.A + (size_t)nxt.pm * tstep : cA; const char* nB = has_next ? (const char*)g.Bt + (size_t)nxt.pn * tstep : cB;
        for (int t = 0; t < nt; t += 2) {
            const bool last = (t == nt - 2);
            const char* a1 = cA + (size_t)(t + 1) * kstep;
            const char* a2 = last ? nA : cA + (size_t)(t + 2) * kstep; const char* b2 = last ? nB : cB + (size_t)(t + 2) * kstep;
            const char* a3 = a2 + kstep; const char* b3 = b2 + kstep;
            if (last && has_next) S.a_ready(nxt);
            if constexpr (SP2) {
            PG8_LDB(B0, 0, 0); PG8_LDB(B1, 0, 1); PG8_SCHED; PG8_LDA(At, 0, 0); PG8_STAGE(PG8_SA(1, 1), a1 + hstep, voffA);
            PG8_WAIT_V(8); PG8_WAIT_L(0); PG8_BAR; PG8_MMA(0, 0, At, B0); PG8_MMA(0, 1, At, B1); PG8_BAR; PG8_SCHED;
            PG8_LDA(At, 0, 1); PG8_STAGE(PG8_SB(0, 0), b2, voffB); PG8_STAGE(PG8_SB(0, 1), b2 + hstep, voffB); PG8_STAGE(PG8_SA(0, 0), a2, voffA);
            PG8_WAIT_V(8); PG8_WAIT_L(0); PG8_BAR; PG8_MMA(1, 0, At, B0); PG8_MMA(1, 1, At, B1); PG8_BAR; PG8_SCHED;
            PG8_LDB(B0, 1, 0); PG8_LDB(B1, 1, 1); PG8_SCHED; PG8_LDA(At, 1, 0); PG8_STAGE(PG8_SA(0, 1), a2 + hstep, voffA);
            PG8_WAIT_V(8); PG8_WAIT_L(0); PG8_BAR; PG8_MMA(0, 0, At, B0); PG8_MMA(0, 1, At, B1); PG8_BAR; PG8_SCHED;
            PG8_LDA(At, 1, 1); PG8_STAGE(PG8_SB(1, 0), b3, voffB); PG8_STAGE(PG8_SB(1, 1), b3 + hstep, voffB); PG8_STAGE(PG8_SA(1, 0), a3, voffA);
            PG8_WAIT_V(8); PG8_WAIT_L(0); PG8_BAR; PG8_MMA(1, 0, At, B0); PG8_MMA(1, 1, At, B1); PG8_BAR; PG8_SCHED;
            } else {
            PG8_LDB(B0, 0, 0); PG8_SCHED; PG8_LDA(At, 0, 0); PG8_STAGE(PG8_SA(1, 1), a1 + hstep, voffA);
            PG8_WAIT_L(8); PG8_BAR; PG8_WAIT_L(0); PG8_MMA(0, 0, At, B0); PG8_BAR; PG8_SCHED;
            PG8_LDB(B1, 0, 1); PG8_STAGE(PG8_SB(0, 0), b2, voffB);
            PG8_BAR; PG8_WAIT_L(0); PG8_MMA(0, 1, At, B1); PG8_BAR;
            PG8_LDA(At, 0, 1); PG8_STAGE(PG8_SA(0, 0), a2, voffA);
            PG8_BAR; PG8_WAIT_L(0); PG8_MMA(1, 0, At, B0); PG8_BAR; PG8_SCHED;
            PG8_STAGE(PG8_SB(0, 1), b2 + hstep, voffB);
            PG8_WAIT_V(6); PG8_BAR; PG8_MMA(1, 1, At, B1); PG8_BAR;
            PG8_LDB(B0, 1, 0); PG8_SCHED; PG8_LDA(At, 1, 0); PG8_STAGE(PG8_SA(0, 1), a2 + hstep, voffA);
            PG8_WAIT_L(8); PG8_BAR; PG8_WAIT_L(0); PG8_MMA(0, 0, At, B0); PG8_BAR; PG8_SCHED;
            PG8_LDB(B1, 1, 1); PG8_STAGE(PG8_SB(1, 0), b3, voffB);
            PG8_BAR; PG8_WAIT_L(0); PG8_MMA(0, 1, At, B1); PG8_BAR;
            PG8_LDA(At, 1, 1); PG8_STAGE(PG8_SA(1, 0), a3, voffA);
            PG8_BAR; PG8_WAIT_L(0); PG8_MMA(1, 0, At, B0); PG8_BAR; PG8_SCHED;
            PG8_STAGE(PG8_SB(1, 1), b3 + hstep, voffB);
            PG8_WAIT_V(6); PG8_BAR; PG8_MMA(1, 1, At, B1); PG8_BAR;
            }
        }
        if constexpr (ALIGN_EPI) { if (wr == 0) PG8_BAR; }
        if constexpr (!Epi::AFTER_DRAIN) { E(acc, cur, wr, wc, fr, fq); S.done(cur); }
        if (!has_next) break;
#pragma unroll
        for (int a = 0; a < 2; ++a)
#pragma unroll
            for (int b = 0; b < 2; ++b)
#pragma unroll
                for (int m = 0; m < 4; ++m)
#pragma unroll
                    for (int n = 0; n < 2; ++n) acc[a][b][m][n] = (f32x4){0.f, 0.f, 0.f, 0.f};
        cur = nxt; cA = nA; cB = nB; ++ui;
        if constexpr (ALIGN_EPI) { if (wr == 1) PG8_BAR; }
    }
    PG8_WAIT_V(0);
    if constexpr (!ALIGN_EPI) { if (wr == 0) PG8_BAR; }
    PG8_BAR;
    if constexpr (Epi::AFTER_DRAIN) { E.fused(acc, cur, wr, wc, fr, fq, lds, wid, lane); S.done(cur); }
#undef PG8_SA
#undef PG8_SB
#undef PG8_STAGE
#undef PG8_LDA
#undef PG8_LDB
#undef PG8_MMA
#undef PG8_WAIT_V
#undef PG8_WAIT_L
#undef PG8_BAR
#undef PG8_SCHED
}
}

DI u32x4 pack8(f32x4 a, f32x4 b) { u32x4 w; w.x = pk2(a[0], a[1]); w.y = pk2(a[2], a[3]); w.z = pk2(b[0], b[1]); w.w = pk2(b[2], b[3]); return w; }
DI f32x4 silu4(f32x4 v) { f32x4 o; o[0] = silu_f(v[0]); o[1] = silu_f(v[1]); o[2] = silu_f(v[2]); o[3] = silu_f(v[3]); return o; }

struct EpiProj {
    static constexpr bool PERM = true, AFTER_DRAIN = false;
    const float* rstd; bf16_t *U, *G, *QS, *KZ, *V, *SRG;
    DI void operator()(const f32x4 (&acc)[2][2][4][2], const pg8::Unit& u, int wr, int wc, int fr, int fq) const {
        const int pn = u.pn;
        const int row0 = u.pm * 256 + wr * 64 + fr;
        const int cw = wc * 32 + 8 * fq;
        if (pn < 8) {
            bf16_t* dst = (wc < 2 ? U : G) + pn * 64 + (cw & 63);
#pragma unroll
            for (int ai = 0; ai < 2; ++ai)
#pragma unroll
                for (int m = 0; m < 4; ++m) {
                    const int row = row0 + ai * 128 + m * 16; const float rs = rstd[row];
                    f32x4 a0 = acc[ai][0][m][0] * rs, a1 = acc[ai][0][m][1] * rs, b0 = acc[ai][1][m][0] * rs, b1 = acc[ai][1][m][1] * rs;
                    if (wc >= 2) { b0 = silu4(b0); b1 = silu4(b1); }
                    *(u32x4*)(dst + (size_t)row * 512) = pack8(a0 * b0, a1 * b1);
                }
        } else if (pn < 12) {
            const bool isq = pn < 10;
            const int head = 2 * ((pn - 8) & 1) + (wc >> 1);
            const int d0 = cw & 63;
            float fr8[8];
#pragma unroll
            for (int j = 0; j < 8; ++j) fr8[j] = rope_freq(d0 + j);
            const float lg = log2_gamma(head);
            bf16_t* dst = (isq ? QS : KZ) + head * 128 + d0;
#pragma unroll
            for (int ai = 0; ai < 2; ++ai)
#pragma unroll
                for (int m = 0; m < 4; ++m) {
                    const int row = row0 + ai * 128 + m * 16; const float rs = rstd[row];
                    const int t = row & (SEQ - 1), tl = t & 127; const float pos = (float)(NMETA + t);
                    const float sc = rs * (isq ? 0.08838834764831845f * exp2f((float)(tl - 127) * lg) : exp2f((float)(127 - tl) * lg));
                    f32x4 r1[2], r2[2];
#pragma unroll
                    for (int j = 0; j < 8; ++j) {
                        float s, c; sincos_rr(pos * fr8[j], s, c);
                        const float x1 = acc[ai][0][m][j >> 2][j & 3], x2 = acc[ai][1][m][j >> 2][j & 3];
                        r1[j >> 2][j & 3] = (x1 * c - x2 * s) * sc; r2[j >> 2][j & 3] = (x1 * s + x2 * c) * sc;
                    }
                    *(u32x4*)(dst + (size_t)row * 512) = pack8(r1[0], r1[1]);
                    *(u32x4*)(dst + (size_t)row * 512 + 64) = pack8(r2[0], r2[1]);
                }
        } else {
            const bool isv = pn < 14;
            bf16_t* dst = (isv ? V : SRG) + ((pn - 12) & 1) * 256 + cw;
#pragma unroll
            for (int ai = 0; ai < 2; ++ai)
#pragma unroll
                for (int m = 0; m < 4; ++m) {
                    const int row = row0 + ai * 128 + m * 16; const float rs = rstd[row];
#pragma unroll
                    for (int bj = 0; bj < 2; ++bj) {
                        f32x4 a0 = acc[ai][bj][m][0] * rs, a1 = acc[ai][bj][m][1] * rs;
                        if (!isv) { a0 = silu4(a0); a1 = silu4(a1); }
                        *(u32x4*)(dst + (size_t)row * 512 + bj * 128) = pack8(a0, a1);
                    }
                }
        }
    }
};

struct EpiOut {
    static constexpr bool PERM = true, AFTER_DRAIN = false;
    const float* x; float* out; float* part;
    DI void operator()(const f32x4 (&acc)[2][2][4][2], const pg8::Unit& u, int wr, int wc, int fr, int fq) const {
        const int row0 = u.pm * 256 + wr * 64 + fr, col0 = u.pn * 256 + wc * 32 + 8 * fq;
#pragma unroll
        for (int ai = 0; ai < 2; ++ai)
#pragma unroll
            for (int m = 0; m < 4; ++m) {
                const int row = row0 + ai * 128 + m * 16; float ss = 0.f;
#pragma unroll
                for (int bj = 0; bj < 2; ++bj) {
                    const size_t o = (size_t)row * DM + col0 + bj * 128;
                    const f32x4 y0 = acc[ai][bj][m][0] + *(const f32x4*)(x + o), y1 = acc[ai][bj][m][1] + *(const f32x4*)(x + o + 4);
                    ss += (y0[0] * y0[0] + y0[1] * y0[1]) + (y0[2] * y0[2] + y0[3] * y0[3]) + (y1[0] * y1[0] + y1[1] * y1[1]) + (y1[2] * y1[2] + y1[3] * y1[3]);
                    *(f32x4*)(out + o) = y0; *(f32x4*)(out + o + 4) = y1;
                }
                ss += __shfl_xor(ss, 16); ss += __shfl_xor(ss, 32);
                if (fq == 0) part[(size_t)(u.pn * 4 + wc) * M_TOK + row] = ss;
            }
    }
};

DI unsigned off_b(unsigned row, unsigned ch) { return 256u * row + 16u * (ch ^ (((row & 3) << 2) | ((row >> 2) & 3))); }
DI bf16x8 row_frag(const unsigned char* img, int rb, int s, int lane) {
    return *(const bf16x8*)(img + 8192 * rb + off_b(lane & 31, 2 * s + (lane >> 5)));
}
DI s16x4 tr_read(const unsigned char* p) { return __builtin_bit_cast(s16x4, __builtin_amdgcn_ds_read_tr16_b64_v4i16((LAS v4i16_t*)(const LAS unsigned char*)p)); }
template <bool PERMK> DI bf16x8 tr_frag(const unsigned char* img, int c, int rbase, int lane) {
    const int h = lane >> 5, blk = (lane >> 4) & 1, q = (lane & 15) >> 2, p = lane & 3;
    const int r0 = rbase + (PERMK ? 4 * h : 8 * h) + q, r1 = r0 + (PERMK ? 8 : 4);
    const unsigned ch = 4 * c + 2 * blk + (p >> 1), bo = 8 * (p & 1);
    const s16x4 lo = tr_read(img + off_b(r0, ch) + bo), hi = tr_read(img + off_b(r1, ch) + bo);
    return __builtin_shufflevector(lo, hi, 0, 1, 2, 3, 4, 5, 6, 7);
}
DI void load_tile(unsigned char* img, const bf16_t* src, int ld, int tid) {
#pragma unroll
    for (int i = 0; i < 4; ++i) { const int idx = tid + 512 * i, row = idx >> 4, ch = idx & 15;
        *(u32x4*)(img + off_b(row, ch)) = *(const u32x4*)(src + (size_t)row * ld + ch * 8); }
}
DI int crow(int reg, int h) { return (reg & 3) + 8 * (reg >> 2) + 4 * h; }
#define MFMA32(a, b, c) __builtin_amdgcn_mfma_f32_32x32x16_bf16((a), (b), (c), 0, 0, 0)

struct Params { const float *x, *meta, *g1, *w_in, *conv_w, *rg, *w_out, *gf; float* out; unsigned char* ws; };


DI int dest_pos(int n) {
    const int type = n >> 9, r = n & 511;
    if (type < 4) return (r >> 6) * 256 + type * 64 + (r & 63);
    if (type < 6) { const int h = r >> 7, d = r & 127; return (8 + (type - 4) * 2 + (h >> 1)) * 256 + (d >> 6) * 128 + (h & 1) * 64 + (d & 63); }
    return n;
}

DI void p0_transpose_item(const float* W, const float* gain, int K, int N, bf16_t* WT, bool perm, float* scr, int item, int lane) {
    const int nblk = N / 32, kb = item / nblk, nb = item % nblk, k0 = 64 * kb, n0 = 32 * nb;
#pragma unroll 8
    for (int i = 0; i < 32; ++i) { const int kk = 2 * i + (lane >> 5); float w = W[(size_t)(k0 + kk) * N + n0 + (lane & 31)]; if (gain) w *= gain[k0 + kk]; scr[kk * 33 + (lane & 31)] = w; }
    __builtin_amdgcn_s_waitcnt(0xc07f); asm volatile("" ::: "memory");
    const int c = lane & 7;
    const int nd0 = perm ? dest_pos(n0) : n0;
#pragma unroll
    for (int j = 0; j < 4; ++j) { const int n = (lane >> 3) + 8 * j; const float* s = scr + (8 * c) * 33 + n;
        u32x4 o; o.x = pk2(s[0 * 33], s[1 * 33]); o.y = pk2(s[2 * 33], s[3 * 33]); o.z = pk2(s[4 * 33], s[5 * 33]); o.w = pk2(s[6 * 33], s[7 * 33]);
        *(u32x4*)(WT + (size_t)(nd0 + n) * K + k0 + 8 * c) = o; }
    __builtin_amdgcn_s_waitcnt(0xc07f); asm volatile("" ::: "memory");
}

DI void phase0(const Params& p, unsigned char* lds) {
    const int tid = opaque_tid(), lane = tid & 63, wave = tid >> 6;
    unsigned char* ws = p.ws;
    float* rstd = (float*)(ws + WS_RSTD); float* MP = (float*)(ws + WS_MP);
    bf16_t* XB = (bf16_t*)(ws + WS_XB); bf16_t* WIN = (bf16_t*)(ws + WS_WIN); bf16_t* WOUT = (bf16_t*)(ws + WS_WOUT);
    {
        float* metaL = (float*)lds; float* red = (float*)(lds + 65536); float* rsL = (float*)(lds + 98304);
        for (int i = tid; i < 4096; i += 512) ((f32x4*)metaL)[i] = ((const f32x4*)p.meta)[i];
        __syncthreads();
#pragma unroll
        for (int rr = 0; rr < 2; ++rr) { const int m = 2 * wave + rr; float s = 0.f;
#pragma unroll
            for (int i = 0; i < 16; ++i) { const float v = metaL[m * 1024 + lane + 64 * i]; s += v * v; }
            s = wave_sum(s); if (lane == 0) rsL[m] = 1.f / sqrtf(s * (1.f / 1024.f) + EPS); }
        for (int cgp = blockIdx.x; cgp < 256; cgp += gridDim.x) {
            const int col = tid & 15, ks = tid >> 4, n = cgp * 16 + col;
            float a[16];
#pragma unroll
            for (int m = 0; m < 16; ++m) a[m] = 0.f;
#pragma unroll 4
            for (int kk = 0; kk < 32; ++kk) { const int k = kk * 32 + ks; const float w = p.w_in[(size_t)k * NPROJ + n] * p.g1[k];
#pragma unroll
                for (int m = 0; m < 16; ++m) a[m] = fmaf(metaL[m * 1024 + k], w, a[m]); }
#pragma unroll
            for (int m = 0; m < 16; ++m) red[(ks * 16 + m) * 16 + col] = a[m];
            __syncthreads();
            if (tid < 256) { const int m = tid >> 4, c = tid & 15; float s = 0.f;
#pragma unroll 8
                for (int k2 = 0; k2 < 32; ++k2) s += red[(k2 * 16 + m) * 16 + c];
                MP[m * NPROJ + cgp * 16 + c] = s * rsL[m]; }
            __syncthreads();
        }
    }
    __syncthreads();
    const int gw = blockIdx.x * 8 + wave, NGW = gridDim.x * 8;
    {
        float* scr = (float*)(lds + wave * 16384);
        constexpr int I_IN = (DM / 64) * (NPROJ / 32), I_OUT = (DM / 64) * (DM / 32);
        for (int it = gw; it < I_IN + I_OUT; it += NGW) {
            if (it < I_IN) p0_transpose_item(p.w_in, p.g1, DM, NPROJ, WIN, true, scr, it, lane);
            else p0_transpose_item(p.w_out, nullptr, DM, DM, WOUT, false, scr, it - I_IN, lane);
        }
    }
    for (int row = gw; row < M_TOK; row += NGW) {
        const f32x4* xr = (const f32x4*)(p.x + (size_t)row * DM) + lane;
        f32x4 v[4]; float s = 0.f;
#pragma unroll
        for (int j = 0; j < 4; ++j) { v[j] = xr[64 * j]; s += (v[j][0] * v[j][0] + v[j][1] * v[j][1]) + (v[j][2] * v[j][2] + v[j][3] * v[j][3]); }
        s = wave_sum(s);
        if (lane == 0) rstd[row] = 1.f / sqrtf(s * (1.f / 1024.f) + EPS);
        u32x2* o = (u32x2*)(XB + (size_t)row * DM) + lane;
#pragma unroll
        for (int j = 0; j < 4; ++j) { u32x2 w; w.x = pk2(v[j][0], v[j][1]); w.y = pk2(v[j][2], v[j][3]); o[64 * j] = w; }
    }
}

DI void phase2(const Params& p, unsigned char* lds) {
    const int tid = opaque_tid(), lane = tid & 63, wave = tid >> 6, h5 = lane >> 5;
    const bf16_t* KZ = (const bf16_t*)(p.ws + WS_KZ); const bf16_t* V = (const bf16_t*)(p.ws + WS_V); float* UPD = (float*)(p.ws + WS_UPD);
    unsigned char* Kimg = lds; unsigned char* Vimg = lds + 32768;
    const int eb = wave & 3, dh = wave >> 2;
    for (int it = blockIdx.x; it < 8 * 63; it += gridDim.x) {
        const int bh = it / 63, n = 1 + it % 63, b = bh >> 2, h = bh & 3;
        const size_t row0 = (size_t)b * SEQ + (size_t)(n - 1) * 128;
        load_tile(Kimg, KZ + row0 * 512 + h * 128, 512, tid);
        load_tile(Vimg, V + row0 * 512 + h * 128, 512, tid);
        __syncthreads();
        f32x16 a0, a1;
#pragma unroll
        for (int i = 0; i < 16; ++i) { a0[i] = 0.f; a1[i] = 0.f; }
#pragma unroll
        for (int ks = 0; ks < 8; ++ks) {
            const bf16x8 av = tr_frag<false>(Vimg, eb, 16 * ks, lane);
            const bf16x8 b0 = tr_frag<false>(Kimg, 2 * dh, 16 * ks, lane), b1 = tr_frag<false>(Kimg, 2 * dh + 1, 16 * ks, lane);
            a0 = MFMA32(av, b0, a0); a1 = MFMA32(av, b1, a1);
        }
        float* dst = UPD + ((size_t)(bh * 64 + n) * 128 + 32 * eb) * 128 + 64 * dh + (lane & 31);
#pragma unroll
        for (int r = 0; r < 16; ++r) { const int e = crow(r, h5); dst[e * 128] = a0[r]; dst[e * 128 + 32] = a1[r]; }
        __syncthreads();
    }
}

DI void phase3(const Params& p) {
    const float* MP = (const float*)(p.ws + WS_MP); const float* UPD = (const float*)(p.ws + WS_UPD); bf16_t* TT = (bf16_t*)(p.ws + WS_TT);
    const int tid3 = opaque_tid();
    for (int gid = blockIdx.x * 512 + tid3; gid < 8 * 16384; gid += gridDim.x * 512) {
        const int bh = gid >> 14, idx = gid & 16383, e = idx >> 7, d = idx & 127, h = bh & 3;
        const float lg = log2_gamma(h), cdec = exp2f(128.f * lg);
        const int dl = d & 63; const float fq = rope_freq(dl);
        float s1 = 0.f;
#pragma unroll 4
        for (int m = 0; m < NMETA; ++m) {
            const float* mp = MP + m * NPROJ;
            const float x1 = mp[5 * 512 + h * 128 + dl], x2 = mp[5 * 512 + h * 128 + 64 + dl];
            float s, c; sincos_rr((float)m * fq, s, c);
            const float kr = (d < 64) ? (x1 * c - x2 * s) : (x1 * s + x2 * c);
            s1 = fmaf(mp[6 * 512 + h * 128 + e] * exp2f((float)(15 - m) * lg), kr, s1);
        }
        float T = cdec * s1;
        const float* up = UPD + (size_t)bh * 64 * 16384 + idx;
        bf16_t* tt = TT + (size_t)bh * 65 * 16384 + idx;
        tt[16384] = (bf16_t)(pk2(T, 0.f) & 0xffffu);
#pragma unroll 1
        for (int n0 = 1; n0 < 64; n0 += 9) {
            float u[9];
#pragma unroll
            for (int i = 0; i < 9; ++i) u[i] = (n0 + i < 64) ? up[(size_t)(n0 + i) * 16384] : 0.f;
#pragma unroll
            for (int i = 0; i < 9; ++i) if (n0 + i < 64) { T = cdec * (T + u[i]); tt[(size_t)(n0 + i + 1) * 16384] = (bf16_t)(pk2(T, 0.f) & 0xffffu); }
        }
    }
}

DI void phase4(const Params& p, unsigned char* lds) {
    const int tid = opaque_tid(), lane = tid & 63, wave = tid >> 6, h5 = lane >> 5;
    const bf16_t* QS = (const bf16_t*)(p.ws + WS_QS); const bf16_t* KZ = (const bf16_t*)(p.ws + WS_KZ); const bf16_t* V = (const bf16_t*)(p.ws + WS_V);
    const bf16_t* SRG = (const bf16_t*)(p.ws + WS_SRG); const bf16_t* TT = (const bf16_t*)(p.ws + WS_TT); bf16_t* MIX = (bf16_t*)(p.ws + WS_MIX);
    unsigned char* Qimg = lds; unsigned char* Kimg = lds + 32768; unsigned char* Vimg = lds + 65536; unsigned char* Timg = lds + 98304;
    float* OL = (float*)lds;
    const int ib = wave & 3, eh = wave >> 2;
    for (int it = blockIdx.x; it < 8 * 64; it += gridDim.x) {
        const int bh = it >> 6, n = 1 + (it & 63), b = bh >> 2, h = bh & 3;
        const size_t row0 = (size_t)b * SEQ + (size_t)(n - 1) * 128;
        load_tile(Qimg, QS + row0 * 512 + h * 128, 512, tid);
        load_tile(Kimg, KZ + row0 * 512 + h * 128, 512, tid);
        load_tile(Vimg, V + row0 * 512 + h * 128, 512, tid);
        load_tile(Timg, TT + ((size_t)bh * 65 + n) * 16384, 128, tid);
        __syncthreads();
        bf16x8 qf[8];
#pragma unroll
        for (int s = 0; s < 8; ++s) qf[s] = row_frag(Qimg, ib, s, lane);
        f32x16 O0, O1;
#pragma unroll
        for (int i = 0; i < 16; ++i) { O0[i] = 0.f; O1[i] = 0.f; }
#pragma unroll
        for (int jb = 0; jb < 4; ++jb) {
            if (jb <= ib) {
                f32x16 c;
#pragma unroll
                for (int i = 0; i < 16; ++i) c[i] = 0.f;
#pragma unroll
                for (int s = 0; s < 8; ++s) c = MFMA32(row_frag(Kimg, jb, s, lane), qf[s], c);
                if (jb == ib) {
#pragma unroll
                    for (int r = 0; r < 16; ++r) if (crow(r, h5) > (lane & 31)) c[r] = 0.f;
                }
#pragma unroll
                for (int s2 = 0; s2 < 2; ++s2) {
                    u32x4 pw; pw.x = pk2(c[8 * s2 + 0], c[8 * s2 + 1]); pw.y = pk2(c[8 * s2 + 2], c[8 * s2 + 3]); pw.z = pk2(c[8 * s2 + 4], c[8 * s2 + 5]); pw.w = pk2(c[8 * s2 + 6], c[8 * s2 + 7]);
                    const bf16x8 pa = __builtin_bit_cast(bf16x8, pw);
                    const bf16x8 v0 = tr_frag<true>(Vimg, 2 * eh, 32 * jb + 16 * s2, lane), v1 = tr_frag<true>(Vimg, 2 * eh + 1, 32 * jb + 16 * s2, lane);
                    O0 = MFMA32(pa, v0, O0); O1 = MFMA32(pa, v1, O1);
                }
            }
        }
#pragma unroll
        for (int s = 0; s < 8; ++s) { O0 = MFMA32(qf[s], row_frag(Timg, 2 * eh, s, lane), O0); O1 = MFMA32(qf[s], row_frag(Timg, 2 * eh + 1, s, lane), O1); }
        __syncthreads();
        {
            float* o = OL + (32 * ib) * 132 + 64 * eh + (lane & 31);
#pragma unroll
            for (int r = 0; r < 16; ++r) { const int i = crow(r, h5); o[i * 132] = O0[r]; o[i * 132 + 32] = O1[r]; }
        }
        __syncthreads();
        {
            const int row = tid >> 2, part = tid & 3;
            const float* o = OL + row * 132 + 32 * part;
            f32x4 v[8]; float s = 0.f;
#pragma unroll
            for (int k = 0; k < 8; ++k) { v[k] = *(const f32x4*)(o + 4 * k); s += (v[k][0] + v[k][1]) + (v[k][2] + v[k][3]); }
            s += __shfl_xor(s, 1); s += __shfl_xor(s, 2);
            const float mu = s * (1.f / 128.f); float q = 0.f;
#pragma unroll
            for (int k = 0; k < 8; ++k) { v[k] = v[k] - mu; q += (v[k][0] * v[k][0] + v[k][1] * v[k][1]) + (v[k][2] * v[k][2] + v[k][3] * v[k][3]); }
            q += __shfl_xor(q, 1); q += __shfl_xor(q, 2);
            const float rs = 1.f / sqrtf(q * (1.f / 128.f) + EPS);
            const size_t grow = row0 + row;
            const float* gp = p.rg + h * 128 + 32 * part;
            const u32x4* sp = (const u32x4*)(SRG + grow * 512 + h * 128 + 32 * part);
            u32x4* dp = (u32x4*)(MIX + grow * 1024 + 512 + h * 128 + 32 * part);
#pragma unroll
            for (int k2 = 0; k2 < 4; ++k2) {
                const u32x4 sg = sp[k2]; const f32x4 g0 = *(const f32x4*)(gp + 8 * k2), g1 = *(const f32x4*)(gp + 8 * k2 + 4);
                const f32x4 a = v[2 * k2], c2 = v[2 * k2 + 1];
                u32x4 w;
                w.x = pk2(a[0] * rs * g0[0] * bf_lo(sg.x), a[1] * rs * g0[1] * bf_hi(sg.x));
                w.y = pk2(a[2] * rs * g0[2] * bf_lo(sg.y), a[3] * rs * g0[3] * bf_hi(sg.y));
                w.z = pk2(c2[0] * rs * g1[0] * bf_lo(sg.z), c2[1] * rs * g1[1] * bf_hi(sg.z));
                w.w = pk2(c2[2] * rs * g1[2] * bf_lo(sg.w), c2[3] * rs * g1[3] * bf_hi(sg.w));
                dp[k2] = w;
            }
        }
        __syncthreads();
    }
    {
        const bf16_t* U = (const bf16_t*)(p.ws + WS_U); const bf16_t* G = (const bf16_t*)(p.ws + WS_G); const float* MP = (const float*)(p.ws + WS_MP);
        const int ch = (tid & 63) * 8, ts = tid >> 6;
        float w0[8], w1[8], w2[8];
#pragma unroll
        for (int j = 0; j < 8; ++j) { w0[j] = p.conv_w[ch + j]; w1[j] = p.conv_w[512 + ch + j]; w2[j] = p.conv_w[1024 + ch + j]; }
        for (int it = blockIdx.x; it < M_TOK / 32; it += gridDim.x) {
            const int rowb = it * 32 + ts * 4;
            float um2[8], um1[8];
#pragma unroll
            for (int k = 0; k < 2; ++k) {
                float* dstu = k ? um1 : um2; const int r = rowb - 2 + k; const int t = (rowb & (SEQ - 1)) - 2 + k;
                if (t >= 0) { const u32x4 w = *(const u32x4*)(U + (size_t)r * 512 + ch);
                    dstu[0] = bf_lo(w.x); dstu[1] = bf_hi(w.x); dstu[2] = bf_lo(w.y); dstu[3] = bf_hi(w.y); dstu[4] = bf_lo(w.z); dstu[5] = bf_hi(w.z); dstu[6] = bf_lo(w.w); dstu[7] = bf_hi(w.w);
                } else { const float* mp = MP + (NMETA + t) * NPROJ;
#pragma unroll
                    for (int j = 0; j < 8; ++j) dstu[j] = mp[ch + j] * mp[1024 + ch + j]; }
            }
#pragma unroll
            for (int i = 0; i < 4; ++i) {
                const size_t r = (size_t)(rowb + i);
                const u32x4 w = *(const u32x4*)(U + r * 512 + ch), gw = *(const u32x4*)(G + r * 512 + ch);
                float uc[8], gg[8];
                uc[0] = bf_lo(w.x); uc[1] = bf_hi(w.x); uc[2] = bf_lo(w.y); uc[3] = bf_hi(w.y); uc[4] = bf_lo(w.z); uc[5] = bf_hi(w.z); uc[6] = bf_lo(w.w); uc[7] = bf_hi(w.w);
                gg[0] = bf_lo(gw.x); gg[1] = bf_hi(gw.x); gg[2] = bf_lo(gw.y); gg[3] = bf_hi(gw.y); gg[4] = bf_lo(gw.z); gg[5] = bf_hi(gw.z); gg[6] = bf_lo(gw.w); gg[7] = bf_hi(gw.w);
                float o[8];
#pragma unroll
                for (int j = 0; j < 8; ++j) { o[j] = gg[j] * (w0[j] * um2[j] + w1[j] * um1[j] + w2[j] * uc[j]); um2[j] = um1[j]; um1[j] = uc[j]; }
                u32x4 ow; ow.x = pk2(o[0], o[1]); ow.y = pk2(o[2], o[3]); ow.z = pk2(o[4], o[5]); ow.w = pk2(o[6], o[7]);
                *(u32x4*)(MIX + r * 1024 + ch) = ow;
            }
        }
    }
}

DI void phase6(const Params& p) {
    const int tid = opaque_tid(), lane = tid & 63, wave = tid >> 6;
    const float* part = (const float*)(p.ws + WS_PART);
    const int gw = blockIdx.x * 8 + wave, NGW = gridDim.x * 8;
    f32x4 g[4];
#pragma unroll
    for (int j = 0; j < 4; ++j) g[j] = ((const f32x4*)p.gf)[lane + 64 * j];
    for (int row = gw; row < M_TOK; row += NGW) {
        float s = (lane < 16) ? part[(size_t)lane * M_TOK + row] : 0.f;
        s = wave_sum(s);
        const float rs = 1.f / sqrtf(s * (1.f / 1024.f) + EPS);
        f32x4* o = (f32x4*)(p.out + (size_t)row * DM) + lane;
#pragma unroll
        for (int j = 0; j < 4; ++j) { f32x4 v = o[64 * j]; v = v * rs * g[j]; o[64 * j] = v; }
    }
}

__global__ void __launch_bounds__(512, 2) hymba_fwd(Params p) {
    extern __shared__ __attribute__((aligned(16))) unsigned char lds[];
    cg::grid_group grid = cg::this_grid();
    unsigned char* ws = p.ws;
    phase0(p, lds);
    grid.sync();
    {
        pg8::Gemm g{(const bf16_t*)(ws + WS_XB), (const bf16_t*)(ws + WS_WIN), M_TOK, NPROJ, DM};
        pg8::StaticOrder S; S.init(M_TOK, NPROJ, (int)gridDim.x, (int)blockIdx.x);
        EpiProj E{(const float*)(ws + WS_RSTD), (bf16_t*)(ws + WS_U), (bf16_t*)(ws + WS_G), (bf16_t*)(ws + WS_QS), (bf16_t*)(ws + WS_KZ), (bf16_t*)(ws + WS_V), (bf16_t*)(ws + WS_SRG)};
        pg8::gemm_phase<EpiProj, pg8::StaticOrder, true, true>((LAS unsigned char*)lds, g, S, E);
    }
    grid.sync();
    phase2(p, lds);
    grid.sync();
    phase3(p);
    grid.sync();
    phase4(p, lds);
    grid.sync();
    {
        pg8::Gemm g{(const bf16_t*)(ws + WS_MIX), (const bf16_t*)(ws + WS_WOUT), M_TOK, DM, DM};
        pg8::StaticOrder S; S.init(M_TOK, DM, (int)gridDim.x, (int)blockIdx.x);
        EpiOut E{p.x, p.out, (float*)(ws + WS_PART)};
        pg8::gemm_phase<EpiOut, pg8::StaticOrder, true, true>((LAS unsigned char*)lds, g, S, E);
    }
    grid.sync();
    phase6(p);
}

extern "C" void kernel_launch(void* const* d_in, const int* in_sizes, int n_in, void* d_out, int out_size, void* d_ws, size_t ws_size, hipStream_t stream) {
    static int grid = 0;
    if (grid == 0) {
        if (n_in != 8 || in_sizes[0] != M_TOK * DM || out_size != M_TOK * DM || ws_size < WS_END) { fprintf(stderr, "kernel_launch: unexpected shapes (n_in %d, in0 %d, out %d, ws %zu)\n", n_in, n_in > 0 ? in_sizes[0] : -1, out_size, ws_size); grid = -1; return; }
        int dev = 0, cus = 0, per_cu = 0;
        hipGetDevice(&dev);
        hipDeviceGetAttribute(&cus, hipDeviceAttributeMultiprocessorCount, dev);
        if (hipFuncSetAttribute((const void*)hymba_fwd, hipFuncAttributeMaxDynamicSharedMemorySize, LDS_BYTES) != hipSuccess) { fprintf(stderr, "kernel_launch: hipFuncSetAttribute failed\n"); grid = -1; return; }
        if (hipOccupancyMaxActiveBlocksPerMultiprocessor(&per_cu, (const void*)hymba_fwd, 512, LDS_BYTES) != hipSuccess || per_cu < 1) { fprintf(stderr, "kernel_launch: occupancy query gave %d\n", per_cu); (void)hipGetLastError(); per_cu = 1; }
        grid = cus * per_cu;
        if (grid > 256) grid = 256;
    }
    if (grid < 0) return;
    Params p{};
    p.x = (const float*)d_in[0]; p.meta = (const float*)d_in[1]; p.g1 = (const float*)d_in[2]; p.w_in = (const float*)d_in[3];
    p.conv_w = (const float*)d_in[4]; p.rg = (const float*)d_in[5]; p.w_out = (const float*)d_in[6]; p.gf = (const float*)d_in[7];
    p.out = (float*)d_out; p.ws = (unsigned char*)d_ws;
    void* args[] = {&p};
    hipError_t e = hipLaunchCooperativeKernel((const void*)hymba_fwd, dim3(grid), dim3(512), args, LDS_BYTES, stream);
    if (e != hipSuccess) fprintf(stderr, "cooperative launch failed: %s (grid %d)\n", hipGetErrorString(e), grid);
}
```

```cpp
#include <hip/hip_runtime.h>
#include <hip/hip_cooperative_groups.h>
#include <cstdio>
#include <cstdint>
namespace cg = cooperative_groups;

#define DI __device__ __forceinline__
#define LAS __attribute__((address_space(3)))
typedef unsigned short bf16_t;
typedef short bf16x8 __attribute__((ext_vector_type(8)));
typedef short s16x4 __attribute__((ext_vector_type(4)));
typedef short v4i16_t __attribute__((ext_vector_type(4)));
typedef float f32x2 __attribute__((ext_vector_type(2)));
typedef float f32x4 __attribute__((ext_vector_type(4)));
typedef float f32x16 __attribute__((ext_vector_type(16)));
typedef unsigned u32x2 __attribute__((ext_vector_type(2)));
typedef unsigned u32x4 __attribute__((ext_vector_type(4)));
typedef __bf16 bf16x2_t __attribute__((ext_vector_type(2)));

constexpr int M_TOK = 16384, DM = 1024, NPROJ = 4096, SEQ = 8192, NMETA = 16, NCHUNK = 64;
constexpr float EPS = 1e-6f;

constexpr size_t MiB = 1u << 20;
constexpr size_t WS_RSTD = 64 * 1024, WS_MP = 128 * 1024, WS_PART = 1 * MiB, WS_WIN = 2 * MiB, WS_WOUT = 10 * MiB, WS_XB = 16 * MiB;
constexpr size_t WS_U = 48 * MiB, WS_G = 64 * MiB, WS_QS = 80 * MiB, WS_KZ = 96 * MiB, WS_V = 112 * MiB, WS_SRG = 128 * MiB;
constexpr size_t WS_UPD = 144 * MiB, WS_TT = 176 * MiB, WS_MIX = 194 * MiB, WS_END = 226 * MiB;
constexpr int LDS_BYTES = 147456;

DI unsigned pk2(float lo, float hi) { f32x2 v = {lo, hi}; bf16x2_t b = __builtin_convertvector(v, bf16x2_t); return __builtin_bit_cast(unsigned, b); }
DI float bf_lo(unsigned u) { return __uint_as_float(u << 16); }
DI float bf_hi(unsigned u) { return __uint_as_float(u & 0xffff0000u); }
DI float silu_f(float x) { return x * __builtin_amdgcn_rcpf(1.f + __expf(-x)); }
DI float wave_sum(float v) {
#pragma unroll
    for (int o = 1; o < 64; o <<= 1) v += __shfl_xor(v, o);
    return v;
}
DI void sincos_rr(float ang, float& s, float& c) {
    const float k = rintf(ang * 0.15915494309189535f);
    float r = fmaf(-k, 6.2831854820251465f, ang);
    r = fmaf(-k, -1.7484555e-7f, r);
    const float rev = r * 0.15915494309189535f;
    s = __builtin_amdgcn_sinf(rev); c = __builtin_amdgcn_cosf(rev);
}
DI int opaque_tid() { int t = threadIdx.x; asm volatile("" : "+v"(t)); return t; }
DI float rope_freq(int d) { return exp2f(-(float)d * (13.287712379549449f / 64.f)); }
DI float log2_gamma(int h) { return log2f(1.f - exp2f(-5.f - (float)h)); }

namespace pg8 {
constexpr int BM = 256, BK = 64, HALF = 128, HTB = HALF * BK * 2, STAGE_BYTES = 8 * HTB, NXCD = 8, WGM = 8;
DI int lds_byte(int r, int c) { const int st = (r >> 4) * 2 + (c >> 5), rr = r & 15, cc = c & 31, ob = rr * 64 + cc * 2; return st * 1024 + (ob ^ (((ob >> 9) & 1) << 5)); }
DI void stage_rc(int b, int& R, int& C) { const int st = b / 1024, sb = b % 1024, swz = sb ^ (((sb >> 9) & 1) << 5); R = (st >> 1) * 16 + swz / 64; C = (st & 1) * 32 + (swz % 64) / 2; }
DI int perm32(int rho) { const int n = rho >> 4, i = rho & 15; return 8 * (i >> 2) + 4 * n + (i & 3); }
struct Unit { int pm, pn; };
struct Gemm { const bf16_t* A; const bf16_t* Bt; int M, N, K; };
struct StaticOrder {
    int nM, nN, nwg, G, c;
    DI void init(int M, int N, int G_, int c_) { nM = M / BM; nN = N / BM; nwg = nM * nN; G = G_; c = c_; }
    DI bool next(int i, Unit& u) const {
        const long L = (long)i * G + c; if (L >= nwg) return false;
        int wgid = (int)L; { const int q = nwg / NXCD, r = nwg % NXCD, xcd = wgid % NXCD, off = wgid / NXCD; wgid = (xcd < r ? xcd * (q + 1) : r * (q + 1) + (xcd - r) * q) + off; }
        const int nig = WGM * nN, gid = wgid / nig, fm = gid * WGM, gsz = (nM - fm) < WGM ? (nM - fm) : WGM;
        u.pm = fm + ((wgid % nig) % gsz); u.pn = (wgid % nig) / gsz; return true;
    }
    DI void a_ready(const Unit&) const {}
    DI void done(const Unit&) const {}
};

template <class Epi, class Sched, bool ALIGN_EPI = false, bool SP2 = false>
DI void gemm_phase(LAS unsigned char* lds, const Gemm g, const Sched& S, const Epi& E) {
    const int tid = opaque_tid(), wid = __builtin_amdgcn_readfirstlane(tid >> 6), lane = tid & 63, wr = wid >> 2, wc = wid & 3, fr = lane & 15, fq = lane >> 4;
    const int K = g.K, nt = K / BK;
    unsigned voffA[2], voffB[2];
#pragma unroll
    for (int i = 0; i < 2; ++i) { int R, C; stage_rc(tid * 16 + i * 8192, R, C); const int Rb = Epi::PERM ? ((R & ~31) + perm32(R & 31)) : R;
        voffA[i] = (unsigned)(R * K + C) * 2u; voffB[i] = (unsigned)(Rb * K + C) * 2u; }
    const size_t kstep = (size_t)(BK * 2);
    const size_t hstep = (size_t)HALF * K * 2;
    const size_t tstep = 2 * hstep;
    const unsigned ldsw = (unsigned)wid * 1024u;
    const int aoff = lds_byte(wr * 64 + fr, fq * 8), boff = lds_byte(wc * 32 + fr, fq * 8);
#define PG8_SA(b, h) (((b) * 2 + (h)) * HTB)
#define PG8_SB(b, h) ((4 + (b) * 2 + (h)) * HTB)
#define PG8_STAGE(bufoff, gbase, voff) do { _Pragma("unroll") for (int _i = 0; _i < 2; ++_i) \
        __builtin_amdgcn_global_load_lds((const unsigned*)((const char*)(gbase) + (voff)[_i]), (LAS unsigned*)(lds + (bufoff) + ldsw + _i * 8192), 16, 0, 0); } while (0)
#define PG8_LDA(dst, b, h) do { _Pragma("unroll") for (int m = 0; m < 4; ++m) _Pragma("unroll") for (int k = 0; k < 2; ++k) dst[m][k] = *(const LAS bf16x8*)(lds + PG8_SA(b, h) + aoff + m * 2048 + k * 1024); } while (0)
#define PG8_LDB(dst, b, h) do { _Pragma("unroll") for (int n = 0; n < 2; ++n) _Pragma("unroll") for (int k = 0; k < 2; ++k) dst[n][k] = *(const LAS bf16x8*)(lds + PG8_SB(b, h) + boff + n * 2048 + k * 1024); } while (0)
#define PG8_MMA(ai, bj, At, Bt) do { __builtin_amdgcn_s_setprio(1); _Pragma("unroll") for (int m = 0; m < 4; ++m) _Pragma("unroll") for (int n = 0; n < 2; ++n) _Pragma("unroll") for (int k = 0; k < 2; ++k) \
        acc[ai][bj][m][n] = __builtin_amdgcn_mfma_f32_16x16x32_bf16(Bt[n][k], At[m][k], acc[ai][bj][m][n], 0, 0, 0); __builtin_amdgcn_s_setprio(0); } while (0)
#define PG8_WAIT_V(n) asm volatile("s_waitcnt vmcnt(" #n ")" ::: "memory")
#define PG8_WAIT_L(n) asm volatile("s_waitcnt lgkmcnt(" #n ")" ::: "memory")
#define PG8_BAR __builtin_amdgcn_s_barrier()
#define PG8_SCHED __builtin_amdgcn_sched_barrier(0)
    Unit cur, nxt; int ui = 0;
    if (!S.next(0, cur)) return;
    f32x4 acc[2][2][4][2];
#pragma unroll
    for (int a = 0; a < 2; ++a)
#pragma unroll
        for (int b = 0; b < 2; ++b)
#pragma unroll
            for (int m = 0; m < 4; ++m)
#pragma unroll
                for (int n = 0; n < 2; ++n) acc[a][b][m][n] = (f32x4){0.f, 0.f, 0.f, 0.f};
    bf16x8 At[4][2], B0[2][2], B1[2][2];
    const char* cA = (const char*)g.A + (size_t)cur.pm * tstep; const char* cB = (const char*)g.Bt + (size_t)cur.pn * tstep;
    S.a_ready(cur);
    if constexpr (SP2) {
        PG8_STAGE(PG8_SB(0, 0), cB, voffB); PG8_STAGE(PG8_SB(0, 1), cB + hstep, voffB); PG8_STAGE(PG8_SA(0, 0), cA, voffA); PG8_STAGE(PG8_SA(0, 1), cA + hstep, voffA);
        if (wr == 1) PG8_BAR;
        PG8_WAIT_V(2); PG8_BAR;
        PG8_STAGE(PG8_SB(1, 0), cB + kstep, voffB); PG8_STAGE(PG8_SA(1, 0), cA + kstep, voffA); PG8_STAGE(PG8_SB(1, 1), cB + hstep + kstep, voffB);
        PG8_WAIT_V(6); PG8_BAR;
    } else {
        PG8_STAGE(PG8_SB(0, 0), cB, voffB); PG8_STAGE(PG8_SA(0, 0), cA, voffA); PG8_STAGE(PG8_SB(0, 1), cB + hstep, voffB); PG8_STAGE(PG8_SA(0, 1), cA + hstep, voffA);
        if (wr == 1) PG8_BAR;
        PG8_WAIT_V(4); PG8_BAR;
        PG8_STAGE(PG8_SB(1, 0), cB + kstep, voffB); PG8_STAGE(PG8_SA(1, 0), cA + kstep, voffA); PG8_STAGE(PG8_SB(1, 1), cB + hstep + kstep, voffB);
        PG8_WAIT_V(6); PG8_BAR;
    }
    for (;;) {
        const bool has_next = S.next(ui + 1, nxt);
        const char* nA = has_next ? (const char*)g.A + (size_t)nxt.pm * tstep : cA; const char* nB = has_next ? (const char*)g.Bt + (size_t)nxt.pn * tstep : cB;
        for (int t = 0; t < nt; t += 2) {
            const bool last = (t == nt - 2);
            const char* a1 = cA + (size_t)(t + 1) * kstep;
            const char* a2 = last ? nA : cA + (size_t)(t + 2) * kstep; const char* b2 = last ? nB : cB + (size_t)(t + 2) * kstep;
            const char* a3 = a2 + kstep; const char* b3 = b2 + kstep;
            if (last && has_next) S.a_ready(nxt);
            if constexpr (SP2) {
            PG8_LDB(B0, 0, 0); PG8_LDB(B1, 0, 1); PG8_SCHED; PG8_LDA(At, 0, 0); PG8_STAGE(PG8_SA(1, 1), a1 + hstep, voffA);
            PG8_WAIT_V(8); PG8_WAIT_L(0); PG8_BAR; PG8_MMA(0, 0, At, B0); PG8_MMA(0, 1, At, B1); PG8_BAR; PG8_SCHED;
            PG8_LDA(At, 0, 1); PG8_STAGE(PG8_SB(0, 0), b2, voffB); PG8_STAGE(PG8_SB(0, 1), b2 + hstep, voffB); PG8_STAGE(PG8_SA(0, 0), a2, voffA);
            PG8_WAIT_V(8); PG8_WAIT_L(0); PG8_BAR; PG8_MMA(1, 0, At, B0); PG8_MMA(1, 1, At, B1); PG8_BAR; PG8_SCHED;
            PG8_LDB(B0, 1, 0); PG8_LDB(B1, 1, 1); PG8_SCHED; PG8_LDA(At, 1, 0); PG8_STAGE(PG8_SA(0, 1), a2 + hstep, voffA);
            PG8_WAIT_V(8); PG8_WAIT_L(0); PG8_BAR; PG8_MMA(0, 0, At, B0); PG8_MMA(0, 1, At, B1); PG8_BAR; PG8_SCHED;
            PG8_LDA(At, 1, 1); PG8_STAGE(PG8_SB(1, 0), b3, voffB); PG8_STAGE(PG8_SB(1, 1), b3 + hstep, voffB); PG8_STAGE(PG8_SA(1, 0), a3, voffA);
            PG8_WAIT_V(8); PG8_WAIT_L(0); PG8_BAR; PG8_MMA(1, 0, At, B0); PG8_MMA(1, 1, At, B1); PG8_BAR; PG8_SCHED;
            } else {
            PG8_LDB(B0, 0, 0); PG8_SCHED; PG8_LDA(At, 0, 0); PG8_STAGE(PG8_SA(1, 1), a1 + hstep, voffA);
            PG8_WAIT_L(8); PG8_BAR; PG8_WAIT_L(0); PG8_MMA(0, 0, At, B0); PG8_BAR; PG8_SCHED;
            PG8_LDB(B1, 0, 1); PG8_STAGE(PG8_SB(0, 0), b2, voffB);
            PG8_BAR; PG8_WAIT_L(0); PG8_MMA(0, 1, At, B1); PG8_BAR;
            PG8_LDA(At, 0, 1); PG8_STAGE(PG8_SA(0, 0), a2, voffA);
            PG8_BAR; PG8_WAIT_L(0); PG8_MMA(1, 0, At, B0); PG8_BAR; PG8_SCHED;
            PG8_STAGE(PG8_SB(0, 1), b2 + hstep, voffB);
            PG8_WAIT_V(6); PG8_BAR; PG8_MMA(1, 1, At, B1); PG8_BAR;
            PG8_LDB(B0, 1, 0); PG8_SCHED; PG8_LDA(At, 1, 0); PG8_STAGE(PG8_SA(0, 1), a2 + hstep, voffA);
            PG8_WAIT_L(8); PG8_BAR; PG8_WAIT_L(0); PG8_MMA(0, 0, At, B0); PG8_BAR; PG8_SCHED;
            PG8_LDB(B1, 1, 1); PG8_STAGE(PG8_SB(1, 0), b3, voffB);
            PG8_BAR; PG8_WAIT_L(0); PG8_MMA(0, 1, At, B1); PG8_BAR;
            PG8_LDA(At, 1, 1); PG8_STAGE(PG8_SA(1, 0), a3, voffA);
            PG8_BAR; PG8_WAIT_L(0); PG8_MMA(1, 0, At, B0); PG8_BAR; PG8_SCHED;
            PG8_STAGE(PG8_SB(1, 1), b3 + hstep, voffB);
            PG8_WAIT_V(6); PG8_BAR; PG8_MMA(1, 1, At, B1); PG8_BAR;
            }
        }
        if constexpr (ALIGN_EPI) { if (wr == 0) PG8_BAR; }
        if constexpr (!Epi::AFTER_DRAIN) { E(acc, cur, wr, wc, fr, fq); S.done(cur); }
        if (!has_next) break;
#pragma unroll
        for (int a = 0; a < 2; ++a)
#pragma unroll
            for (int b = 0; b < 2; ++b)
#pragma unroll
                for (int m = 0; m < 4; ++m)
#pragma unroll
                    for (int n = 0; n < 2; ++n) acc[a][b][m][n] = (f32x4){0.f, 0.f, 0.f, 0.f};
        cur = nxt; cA = nA; cB = nB; ++ui;
        if constexpr (ALIGN_EPI) { if (wr == 1) PG8_BAR; }
    }
    PG8_WAIT_V(0);
    if constexpr (!ALIGN_EPI) { if (wr == 0) PG8_BAR; }
    PG8_BAR;
    if constexpr (Epi::AFTER_DRAIN) { E.fused(acc, cur, wr, wc, fr, fq, lds, wid, lane); S.done(cur); }
#undef PG8_SA
#undef PG8_SB
#undef PG8_STAGE
#undef PG8_LDA
#undef PG8_LDB
#undef PG8_MMA
#undef PG8_WAIT_V
#undef PG8_WAIT_L
#undef PG8_BAR
#undef PG8_SCHED
}
}


#define XB_TMO      128
#define XB_XCNT(j)  (256  + 64 * (j))
#define XB_XSUB(j)  (1280 + 64 * (j))
#define XB_XGEN(j)  (2304 + 64 * (j))
#define XB_TOP      3328
#define XB_TOPGEN   3392
#define XCD_BAR_WORDS 3456
#define XB_SPIN_CAP (1u << 18)
constexpr int CW_PANEL = 4096;
constexpr size_t CTL_ZERO_BYTES = 40960;
DI unsigned xb_ld(unsigned* p)              { return __hip_atomic_load(p, __ATOMIC_RELAXED, __HIP_MEMORY_SCOPE_AGENT); }
DI unsigned xb_add(unsigned* p, unsigned v) { return __hip_atomic_fetch_add(p, v, __ATOMIC_RELAXED, __HIP_MEMORY_SCOPE_AGENT); }
DI unsigned xb_xcc_id() { return (unsigned)__builtin_amdgcn_s_getreg((3 << 11) | 20) & 0xFu; }
#define XB_SPIN(cond, bar) do { unsigned _sp = 0; while (cond) { __builtin_amdgcn_s_sleep(1); \
    if ((++_sp & 255u) == 0u) { if (xb_ld(&(bar)[XB_TMO])) break; if (_sp > XB_SPIN_CAP) { atomicAdd(&(bar)[XB_TMO], 1u); break; } } } } while (0)
struct XcdBarrier { unsigned* bar; unsigned x; volatile LAS unsigned* st; };
DI XcdBarrier xcd_barrier_post(unsigned* bar, volatile LAS unsigned* st) {
    XcdBarrier b; b.bar = bar; b.x = xb_xcc_id(); b.st = st;
    if (threadIdx.x == 0) (void)xb_add(&bar[XB_XCNT(b.x)], 1u);
    return b;
}
DI void xcd_barrier_complete(unsigned* bar, unsigned x, unsigned& nloc, unsigned& nx) {
    const unsigned G = gridDim.x * gridDim.y * gridDim.z;
    unsigned sum, cnt, mine, sp = 0u;
    for (;;) {
        sum = 0u; cnt = 0u; mine = 0u;
#pragma unroll
        for (unsigned j = 0; j < 16; ++j) { const unsigned c = xb_ld(&bar[XB_XCNT(j)]); sum += c; cnt += (c > 0u) ? 1u : 0u; mine = (j == x) ? c : mine; }
        if (sum == G) break;
        __builtin_amdgcn_s_sleep(1);
        if ((++sp & 255u) == 0u) { if (xb_ld(&bar[XB_TMO])) break; if (sp > XB_SPIN_CAP) { atomicAdd(&bar[XB_TMO], 1u); break; } }
    }
    nloc = mine > 0u ? mine : 1u; nx = cnt > 0u ? cnt : 1u;
}
DI void xcd_barrier(const XcdBarrier& b) {
    asm volatile("s_waitcnt vmcnt(0)" ::: "memory");
    __syncthreads();
    if (threadIdx.x == 0) {
        unsigned* bar = b.bar;
        __builtin_amdgcn_s_waitcnt(0);
        unsigned nloc = b.st[0], nx = b.st[1];
        if (nloc == 0u) { xcd_barrier_complete(bar, b.x, nloc, nx); b.st[0] = nloc; b.st[1] = nx; }
        const unsigned old = xb_add(&bar[XB_XSUB(b.x)], 1u);
        const unsigned gen = old / nloc;
        if (old + 1u == (gen + 1u) * nloc) {
            __builtin_amdgcn_fence(__ATOMIC_RELEASE, "agent");
            asm volatile("s_waitcnt vmcnt(0)" ::: "memory");
            const unsigned og = xb_add(&bar[XB_TOP], 1u);
            const unsigned tg = og / nx;
            if (og + 1u == (tg + 1u) * nx) xb_add(&bar[XB_TOPGEN], 1u);
            else XB_SPIN(xb_ld(&bar[XB_TOPGEN]) == tg, bar);
            __builtin_amdgcn_fence(__ATOMIC_ACQUIRE, "agent");
            xb_add(&bar[XB_XGEN(b.x)], 1u);
            asm volatile("s_waitcnt vmcnt(0)" ::: "memory");
        } else {
            XB_SPIN(xb_ld(&bar[XB_XGEN(b.x)]) == gen, bar);
            __builtin_amdgcn_fence(__ATOMIC_ACQUIRE, "agent");
            asm volatile("s_waitcnt vmcnt(0)" ::: "memory");
        }
    }
    __syncthreads();
}


DI u32x4 pack8(f32x4 a, f32x4 b) { u32x4 w; w.x = pk2(a[0], a[1]); w.y = pk2(a[2], a[3]); w.z = pk2(b[0], b[1]); w.w = pk2(b[2], b[3]); return w; }
DI f32x4 silu4(f32x4 v) { f32x4 o; o[0] = silu_f(v[0]); o[1] = silu_f(v[1]); o[2] = silu_f(v[2]); o[3] = silu_f(v[3]); return o; }

struct EpiProj {
    static constexpr bool PERM = true, AFTER_DRAIN = false;
    const float* rstd; bf16_t *U, *G, *QS, *KZ, *V, *SRG;
    DI void operator()(const f32x4 (&acc)[2][2][4][2], const pg8::Unit& u, int wr, int wc, int fr, int fq) const {
        const int pn = u.pn;
        const int row0 = u.pm * 256 + wr * 64 + fr;
        const int cw = wc * 32 + 8 * fq;
        if (pn < 8) {
            bf16_t* dst = (wc < 2 ? U : G) + pn * 64 + (cw & 63);
#pragma unroll
            for (int ai = 0; ai < 2; ++ai)
#pragma unroll
                for (int m = 0; m < 4; ++m) {
                    const int row = row0 + ai * 128 + m * 16; const float rs = rstd[row];
                    f32x4 a0 = acc[ai][0][m][0] * rs, a1 = acc[ai][0][m][1] * rs, b0 = acc[ai][1][m][0] * rs, b1 = acc[ai][1][m][1] * rs;
                    if (wc >= 2) { b0 = silu4(b0); b1 = silu4(b1); }
                    *(u32x4*)(dst + (size_t)row * 512) = pack8(a0 * b0, a1 * b1);
                }
        } else if (pn < 12) {
            const bool isq = pn < 10;
            const int head = 2 * ((pn - 8) & 1) + (wc >> 1);
            const int d0 = cw & 63;
            float fr8[8];
#pragma unroll
            for (int j = 0; j < 8; ++j) fr8[j] = rope_freq(d0 + j);
            const float lg = log2_gamma(head);
            bf16_t* dst = (isq ? QS : KZ) + head * 128 + d0;
#pragma unroll
            for (int ai = 0; ai < 2; ++ai)
#pragma unroll
                for (int m = 0; m < 4; ++m) {
                    const int row = row0 + ai * 128 + m * 16; const float rs = rstd[row];
                    const int t = row & (SEQ - 1), tl = t & 127; const float pos = (float)(NMETA + t);
                    const float sc = rs * (isq ? 0.08838834764831845f * exp2f((float)(tl - 127) * lg) : exp2f((float)(127 - tl) * lg));
                    f32x4 r1[2], r2[2];
#pragma unroll
                    for (int j = 0; j < 8; ++j) {
                        float s, c; sincos_rr(pos * fr8[j], s, c);
                        const float x1 = acc[ai][0][m][j >> 2][j & 3], x2 = acc[ai][1][m][j >> 2][j & 3];
                        r1[j >> 2][j & 3] = (x1 * c - x2 * s) * sc; r2[j >> 2][j & 3] = (x1 * s + x2 * c) * sc;
                    }
                    *(u32x4*)(dst + (size_t)row * 512) = pack8(r1[0], r1[1]);
                    *(u32x4*)(dst + (size_t)row * 512 + 64) = pack8(r2[0], r2[1]);
                }
        } else {
            const bool isv = pn < 14;
            bf16_t* dst = (isv ? V : SRG) + ((pn - 12) & 1) * 256 + cw;
#pragma unroll
            for (int ai = 0; ai < 2; ++ai)
#pragma unroll
                for (int m = 0; m < 4; ++m) {
                    const int row = row0 + ai * 128 + m * 16; const float rs = rstd[row];
#pragma unroll
                    for (int bj = 0; bj < 2; ++bj) {
                        f32x4 a0 = acc[ai][bj][m][0] * rs, a1 = acc[ai][bj][m][1] * rs;
                        if (!isv) { a0 = silu4(a0); a1 = silu4(a1); }
                        *(u32x4*)(dst + (size_t)row * 512 + bj * 128) = pack8(a0, a1);
                    }
                }
        }
    }
};

struct EpiOut {
    static constexpr bool PERM = true, AFTER_DRAIN = false;
    const float* x; float* out; float* part;
    DI void operator()(const f32x4 (&acc)[2][2][4][2], const pg8::Unit& u, int wr, int wc, int fr, int fq) const {
        const int row0 = u.pm * 256 + wr * 64 + fr, col0 = u.pn * 256 + wc * 32 + 8 * fq;
#pragma unroll
        for (int ai = 0; ai < 2; ++ai)
#pragma unroll
            for (int m = 0; m < 4; ++m) {
                const int row = row0 + ai * 128 + m * 16; float ss = 0.f;
#pragma unroll
                for (int bj = 0; bj < 2; ++bj) {
                    const size_t o = (size_t)row * DM + col0 + bj * 128;
                    const f32x4 y0 = acc[ai][bj][m][0] + *(const f32x4*)(x + o), y1 = acc[ai][bj][m][1] + *(const f32x4*)(x + o + 4);
                    ss += (y0[0] * y0[0] + y0[1] * y0[1]) + (y0[2] * y0[2] + y0[3] * y0[3]) + (y1[0] * y1[0] + y1[1] * y1[1]) + (y1[2] * y1[2] + y1[3] * y1[3]);
                    *(f32x4*)(out + o) = y0; *(f32x4*)(out + o + 4) = y1;
                }
                ss += __shfl_xor(ss, 16); ss += __shfl_xor(ss, 32);
                if (fq == 0) part[(size_t)(u.pn * 4 + wc) * M_TOK + row] = ss;
            }
    }
};


struct EpiOutNorm {
    static constexpr bool PERM = true, AFTER_DRAIN = true;
    const float* x; float* out; const float* gf; float* xch; unsigned* ctl;
    DI void fused(f32x4 (&acc)[2][2][4][2], const pg8::Unit& u, int wr, int wc, int fr, int fq, LAS unsigned char* lds, int wid, int lane) const {
        LAS float* P = (LAS float*)lds;
        LAS float* R = (LAS float*)(lds + 4096);
        const int row0 = u.pm * 256 + wr * 64 + fr, col0 = u.pn * 256 + wc * 32 + 8 * fq;
#pragma unroll
        for (int ai = 0; ai < 2; ++ai)
#pragma unroll
            for (int m = 0; m < 4; ++m) {
                const int row = row0 + ai * 128 + m * 16; float ss = 0.f;
#pragma unroll
                for (int bj = 0; bj < 2; ++bj) {
                    const size_t o = (size_t)row * DM + col0 + bj * 128;
                    const f32x4 y0 = acc[ai][bj][m][0] + *(const f32x4*)(x + o), y1 = acc[ai][bj][m][1] + *(const f32x4*)(x + o + 4);
                    ss += (y0[0] * y0[0] + y0[1] * y0[1]) + (y0[2] * y0[2] + y0[3] * y0[3]) + (y1[0] * y1[0] + y1[1] * y1[1]) + (y1[2] * y1[2] + y1[3] * y1[3]);
                    acc[ai][bj][m][0] = y0; acc[ai][bj][m][1] = y1;
                }
                ss += __shfl_xor(ss, 16); ss += __shfl_xor(ss, 32);
                if (fq == 0) P[(ai * 128 + wr * 64 + m * 16 + fr) * 4 + wc] = ss;
            }
        __syncthreads();
        const int tid = wid * 64 + lane;
        float* slot = xch + (size_t)(u.pm * 4) * 256;
        if (tid < 256) { const f32x4 pp = *(const LAS f32x4*)(P + tid * 4); const float v = (pp[0] + pp[1]) + (pp[2] + pp[3]);
            __hip_atomic_store(slot + u.pn * 256 + tid, v, __ATOMIC_RELAXED, __HIP_MEMORY_SCOPE_AGENT); }
        asm volatile("s_waitcnt vmcnt(0)" ::: "memory");
        __syncthreads();
        if (tid == 0) {
            unsigned* cnt = ctl + CW_PANEL + 64 * u.pm;
            __builtin_amdgcn_fence(__ATOMIC_RELEASE, "agent");
            asm volatile("s_waitcnt vmcnt(0)" ::: "memory");
            xb_add(cnt, 1u);
            unsigned sp = 0u;
            while (xb_ld(cnt) < 4u) { __builtin_amdgcn_s_sleep(1); if (++sp > (1u << 22)) break; }
            __builtin_amdgcn_fence(__ATOMIC_ACQUIRE, "agent");
            asm volatile("s_waitcnt vmcnt(0)" ::: "memory");
        }
        __syncthreads();
        if (tid < 256) { float s = 0.f;
#pragma unroll
            for (int q = 0; q < 4; ++q) s += __hip_atomic_load(slot + q * 256 + tid, __ATOMIC_RELAXED, __HIP_MEMORY_SCOPE_AGENT);
            R[tid] = 1.f / sqrtf(s * (1.f / 1024.f) + EPS); }
        __syncthreads();
        f32x4 gv[2][2];
#pragma unroll
        for (int bj = 0; bj < 2; ++bj) { gv[bj][0] = *(const f32x4*)(gf + col0 + bj * 128); gv[bj][1] = *(const f32x4*)(gf + col0 + bj * 128 + 4); }
#pragma unroll
        for (int ai = 0; ai < 2; ++ai)
#pragma unroll
            for (int m = 0; m < 4; ++m) {
                const int lrow = ai * 128 + wr * 64 + m * 16 + fr; const float rs = R[lrow];
#pragma unroll
                for (int bj = 0; bj < 2; ++bj) {
                    const size_t o = (size_t)(u.pm * 256 + lrow) * DM + col0 + bj * 128;
                    *(f32x4*)(out + o) = acc[ai][bj][m][0] * rs * gv[bj][0]; *(f32x4*)(out + o + 4) = acc[ai][bj][m][1] * rs * gv[bj][1];
                }
            }
    }
};

DI unsigned off_b(unsigned row, unsigned ch) { return 256u * row + 16u * (ch ^ (((row & 3) << 2) | ((row >> 2) & 3))); }
DI bf16x8 row_frag(const unsigned char* img, int rb, int s, int lane) {
    return *(const bf16x8*)(img + 8192 * rb + off_b(lane & 31, 2 * s + (lane >> 5)));
}
DI s16x4 tr_read(const unsigned char* p) { return __builtin_bit_cast(s16x4, __builtin_amdgcn_ds_read_tr16_b64_v4i16((LAS v4i16_t*)(const LAS unsigned char*)p)); }
template <bool PERMK> DI bf16x8 tr_frag(const unsigned char* img, int c, int rbase, int lane) {
    const int h = lane >> 5, blk = (lane >> 4) & 1, q = (lane & 15) >> 2, p = lane & 3;
    const int r0 = rbase + (PERMK ? 4 * h : 8 * h) + q, r1 = r0 + (PERMK ? 8 : 4);
    const unsigned ch = 4 * c + 2 * blk + (p >> 1), bo = 8 * (p & 1);
    const s16x4 lo = tr_read(img + off_b(r0, ch) + bo), hi = tr_read(img + off_b(r1, ch) + bo);
    return __builtin_shufflevector(lo, hi, 0, 1, 2, 3, 4, 5, 6, 7);
}
DI void load_tile(unsigned char* img, const bf16_t* src, int ld, int tid) {
#pragma unroll
    for (int i = 0; i < 4; ++i) { const int idx = tid + 512 * i, row = idx >> 4, ch = idx & 15;
        *(u32x4*)(img + off_b(row, ch)) = *(const u32x4*)(src + (size_t)row * ld + ch * 8); }
}
DI int crow(int reg, int h) { return (reg & 3) + 8 * (reg >> 2) + 4 * h; }
#define MFMA32(a, b, c) __builtin_amdgcn_mfma_f32_32x32x16_bf16((a), (b), (c), 0, 0, 0)

struct Params { const float *x, *meta, *g1, *w_in, *conv_w, *rg, *w_out, *gf; float* out; unsigned char* ws; };


DI int dest_pos(int n) {
    const int type = n >> 9, r = n & 511;
    if (type < 4) return (r >> 6) * 256 + type * 64 + (r & 63);
    if (type < 6) { const int h = r >> 7, d = r & 127; return (8 + (type - 4) * 2 + (h >> 1)) * 256 + (d >> 6) * 128 + (h & 1) * 64 + (d & 63); }
    return n;
}

DI void p0_transpose_item(const float* W, const float* gain, int K, int N, bf16_t* WT, bool perm, float* scr, int item, int lane) {
    const int nblk = N / 32, kb = item / nblk, nb = item % nblk, k0 = 64 * kb, n0 = 32 * nb;
#pragma unroll 8
    for (int i = 0; i < 32; ++i) { const int kk = 2 * i + (lane >> 5); float w = W[(size_t)(k0 + kk) * N + n0 + (lane & 31)]; if (gain) w *= gain[k0 + kk]; scr[kk * 33 + (lane & 31)] = w; }
    __builtin_amdgcn_s_waitcnt(0xc07f); asm volatile("" ::: "memory");
    const int c = lane & 7;
    const int nd0 = perm ? dest_pos(n0) : n0;
#pragma unroll
    for (int j = 0; j < 4; ++j) { const int n = (lane >> 3) + 8 * j; const float* s = scr + (8 * c) * 33 + n;
        u32x4 o; o.x = pk2(s[0 * 33], s[1 * 33]); o.y = pk2(s[2 * 33], s[3 * 33]); o.z = pk2(s[4 * 33], s[5 * 33]); o.w = pk2(s[6 * 33], s[7 * 33]);
        *(u32x4*)(WT + (size_t)(nd0 + n) * K + k0 + 8 * c) = o; }
    __builtin_amdgcn_s_waitcnt(0xc07f); asm volatile("" ::: "memory");
}

DI void phase0(const Params& p, unsigned char* lds) {
    const int tid = opaque_tid(), lane = tid & 63, wave = tid >> 6;
    unsigned char* ws = p.ws;
    float* rstd = (float*)(ws + WS_RSTD); float* MP = (float*)(ws + WS_MP);
    bf16_t* XB = (bf16_t*)(ws + WS_XB); bf16_t* WIN = (bf16_t*)(ws + WS_WIN); bf16_t* WOUT = (bf16_t*)(ws + WS_WOUT);
    {
        float* metaL = (float*)lds; float* red = (float*)(lds + 65536); float* rsL = (float*)(lds + 98304);
        for (int i = tid; i < 4096; i += 512) ((f32x4*)metaL)[i] = ((const f32x4*)p.meta)[i];
        __syncthreads();
#pragma unroll
        for (int rr = 0; rr < 2; ++rr) { const int m = 2 * wave + rr; float s = 0.f;
#pragma unroll
            for (int i = 0; i < 16; ++i) { const float v = metaL[m * 1024 + lane + 64 * i]; s += v * v; }
            s = wave_sum(s); if (lane == 0) rsL[m] = 1.f / sqrtf(s * (1.f / 1024.f) + EPS); }
        for (int cgp = blockIdx.x; cgp < 256; cgp += gridDim.x) {
            const int col = tid & 15, ks = tid >> 4, n = cgp * 16 + col;
            float a[16];
#pragma unroll
            for (int m = 0; m < 16; ++m) a[m] = 0.f;
#pragma unroll 4
            for (int kk = 0; kk < 32; ++kk) { const int k = kk * 32 + ks; const float w = p.w_in[(size_t)k * NPROJ + n] * p.g1[k];
#pragma unroll
                for (int m = 0; m < 16; ++m) a[m] = fmaf(metaL[m * 1024 + k], w, a[m]); }
#pragma unroll
            for (int m = 0; m < 16; ++m) red[(ks * 16 + m) * 16 + col] = a[m];
            __syncthreads();
            if (tid < 256) { const int m = tid >> 4, c = tid & 15; float s = 0.f;
#pragma unroll 8
                for (int k2 = 0; k2 < 32; ++k2) s += red[(k2 * 16 + m) * 16 + c];
                MP[m * NPROJ + cgp * 16 + c] = s * rsL[m]; }
            __syncthreads();
        }
    }
    __syncthreads();
    const int gw = blockIdx.x * 8 + wave, NGW = gridDim.x * 8;
    {
        float* scr = (float*)(lds + wave * 16384);
        constexpr int I_IN = (DM / 64) * (NPROJ / 32), I_OUT = (DM / 64) * (DM / 32);
        for (int it = gw; it < I_IN + I_OUT; it += NGW) {
            if (it < I_IN) p0_transpose_item(p.w_in, p.g1, DM, NPROJ, WIN, true, scr, it, lane);
            else p0_transpose_item(p.w_out, nullptr, DM, DM, WOUT, false, scr, it - I_IN, lane);
        }
    }
    for (int row = gw; row < M_TOK; row += NGW) {
        const f32x4* xr = (const f32x4*)(p.x + (size_t)row * DM) + lane;
        f32x4 v[4]; float s = 0.f;
#pragma unroll
        for (int j = 0; j < 4; ++j) { v[j] = xr[64 * j]; s += (v[j][0] * v[j][0] + v[j][1] * v[j][1]) + (v[j][2] * v[j][2] + v[j][3] * v[j][3]); }
        s = wave_sum(s);
        if (lane == 0) rstd[row] = 1.f / sqrtf(s * (1.f / 1024.f) + EPS);
        u32x2* o = (u32x2*)(XB + (size_t)row * DM) + lane;
#pragma unroll
        for (int j = 0; j < 4; ++j) { u32x2 w; w.x = pk2(v[j][0], v[j][1]); w.y = pk2(v[j][2], v[j][3]); o[64 * j] = w; }
    }
}

DI void phase2(const Params& p, unsigned char* lds) {
    const int tid = opaque_tid(), lane = tid & 63, wave = tid >> 6, h5 = lane >> 5;
    const bf16_t* KZ = (const bf16_t*)(p.ws + WS_KZ); const bf16_t* V = (const bf16_t*)(p.ws + WS_V); float* UPD = (float*)(p.ws + WS_UPD);
    unsigned char* Kimg = lds; unsigned char* Vimg = lds + 32768;
    const int eb = wave & 3, dh = wave >> 2;
    for (int it = blockIdx.x; it < 8 * 63; it += gridDim.x) {
        const int bh = it / 63, n = 1 + it % 63, b = bh >> 2, h = bh & 3;
        const size_t row0 = (size_t)b * SEQ + (size_t)(n - 1) * 128;
        load_tile(Kimg, KZ + row0 * 512 + h * 128, 512, tid);
        load_tile(Vimg, V + row0 * 512 + h * 128, 512, tid);
        __syncthreads();
        f32x16 a0, a1;
#pragma unroll
        for (int i = 0; i < 16; ++i) { a0[i] = 0.f; a1[i] = 0.f; }
#pragma unroll
        for (int ks = 0; ks < 8; ++ks) {
            const bf16x8 av = tr_frag<false>(Vimg, eb, 16 * ks, lane);
            const bf16x8 b0 = tr_frag<false>(Kimg, 2 * dh, 16 * ks, lane), b1 = tr_frag<false>(Kimg, 2 * dh + 1, 16 * ks, lane);
            a0 = MFMA32(av, b0, a0); a1 = MFMA32(av, b1, a1);
        }
        float* dst = UPD + ((size_t)(bh * 64 + n) * 128 + 32 * eb) * 128 + 64 * dh + (lane & 31);
#pragma unroll
        for (int r = 0; r < 16; ++r) { const int e = crow(r, h5); dst[e * 128] = a0[r]; dst[e * 128 + 32] = a1[r]; }
        __syncthreads();
    }
}

DI void phase3(const Params& p) {
    const float* MP = (const float*)(p.ws + WS_MP); const float* UPD = (const float*)(p.ws + WS_UPD); bf16_t* TT = (bf16_t*)(p.ws + WS_TT);
    const int tid3 = opaque_tid();
    for (int gid = blockIdx.x * 512 + tid3; gid < 8 * 16384; gid += gridDim.x * 512) {
        const int bh = gid >> 14, idx = gid & 16383, e = idx >> 7, d = idx & 127, h = bh & 3;
        const float lg = log2_gamma(h), cdec = exp2f(128.f * lg);
        const int dl = d & 63; const float fq = rope_freq(dl);
        float s1 = 0.f;
#pragma unroll 4
        for (int m = 0; m < NMETA; ++m) {
            const float* mp = MP + m * NPROJ;
            const float x1 = mp[5 * 512 + h * 128 + dl], x2 = mp[5 * 512 + h * 128 + 64 + dl];
            float s, c; sincos_rr((float)m * fq, s, c);
            const float kr = (d < 64) ? (x1 * c - x2 * s) : (x1 * s + x2 * c);
            s1 = fmaf(mp[6 * 512 + h * 128 + e] * exp2f((float)(15 - m) * lg), kr, s1);
        }
        float T = cdec * s1;
        const float* up = UPD + (size_t)bh * 64 * 16384 + idx;
        bf16_t* tt = TT + (size_t)bh * 65 * 16384 + idx;
        tt[16384] = (bf16_t)(pk2(T, 0.f) & 0xffffu);
#pragma unroll 1
        for (int n0 = 1; n0 < 64; n0 += 9) {
            float u[9];
#pragma unroll
            for (int i = 0; i < 9; ++i) u[i] = (n0 + i < 64) ? up[(size_t)(n0 + i) * 16384] : 0.f;
#pragma unroll
            for (int i = 0; i < 9; ++i) if (n0 + i < 64) { T = cdec * (T + u[i]); tt[(size_t)(n0 + i + 1) * 16384] = (bf16_t)(pk2(T, 0.f) & 0xffffu); }
        }
    }
}

DI void phase4(const Params& p, unsigned char* lds) {
    const int tid = opaque_tid(), lane = tid & 63, wave = tid >> 6, h5 = lane >> 5;
    const bf16_t* QS = (const bf16_t*)(p.ws + WS_QS); const bf16_t* KZ = (const bf16_t*)(p.ws + WS_KZ); const bf16_t* V = (const bf16_t*)(p.ws + WS_V);
    const bf16_t* SRG = (const bf16_t*)(p.ws + WS_SRG); const bf16_t* TT = (const bf16_t*)(p.ws + WS_TT); bf16_t* MIX = (bf16_t*)(p.ws + WS_MIX);
    unsigned char* Qimg = lds; unsigned char* Kimg = lds + 32768; unsigned char* Vimg = lds + 65536; unsigned char* Timg = lds + 98304;
    float* OL = (float*)lds;
    const int ib = wave & 3, eh = wave >> 2;
    for (int it = blockIdx.x; it < 8 * 64; it += gridDim.x) {
        const int bh = it >> 6, n = 1 + (it & 63), b = bh >> 2, h = bh & 3;
        const size_t row0 = (size_t)b * SEQ + (size_t)(n - 1) * 128;
        load_tile(Qimg, QS + row0 * 512 + h * 128, 512, tid);
        load_tile(Kimg, KZ + row0 * 512 + h * 128, 512, tid);
        load_tile(Vimg, V + row0 * 512 + h * 128, 512, tid);
        load_tile(Timg, TT + ((size_t)bh * 65 + n) * 16384, 128, tid);
        __syncthreads();
        bf16x8 qf[8];
#pragma unroll
        for (int s = 0; s < 8; ++s) qf[s] = row_frag(Qimg, ib, s, lane);
        f32x16 O0, O1;
#pragma unroll
        for (int i = 0; i < 16; ++i) { O0[i] = 0.f; O1[i] = 0.f; }
#pragma unroll
        for (int jb = 0; jb < 4; ++jb) {
            if (jb <= ib) {
                f32x16 c;
#pragma unroll
                for (int i = 0; i < 16; ++i) c[i] = 0.f;
#pragma unroll
                for (int s = 0; s < 8; ++s) c = MFMA32(row_frag(Kimg, jb, s, lane), qf[s], c);
                if (jb == ib) {
#pragma unroll
                    for (int r = 0; r < 16; ++r) if (crow(r, h5) > (lane & 31)) c[r] = 0.f;
                }
#pragma unroll
                for (int s2 = 0; s2 < 2; ++s2) {
                    u32x4 pw; pw.x = pk2(c[8 * s2 + 0], c[8 * s2 + 1]); pw.y = pk2(c[8 * s2 + 2], c[8 * s2 + 3]); pw.z = pk2(c[8 * s2 + 4], c[8 * s2 + 5]); pw.w = pk2(c[8 * s2 + 6], c[8 * s2 + 7]);
                    const bf16x8 pa = __builtin_bit_cast(bf16x8, pw);
                    const bf16x8 v0 = tr_frag<true>(Vimg, 2 * eh, 32 * jb + 16 * s2, lane), v1 = tr_frag<true>(Vimg, 2 * eh + 1, 32 * jb + 16 * s2, lane);
                    O0 = MFMA32(pa, v0, O0); O1 = MFMA32(pa, v1, O1);
                }
            }
        }
#pragma unroll
        for (int s = 0; s < 8; ++s) { O0 = MFMA32(qf[s], row_frag(Timg, 2 * eh, s, lane), O0); O1 = MFMA32(qf[s], row_frag(Timg, 2 * eh + 1, s, lane), O1); }
        __syncthreads();
        {
            float* o = OL + (32 * ib) * 132 + 64 * eh + (lane & 31);
#pragma unroll
            for (int r = 0; r < 16; ++r) { const int i = crow(r, h5); o[i * 132] = O0[r]; o[i * 132 + 32] = O1[r]; }
        }
        __syncthreads();
        {
            const int row = tid >> 2, part = tid & 3;
            const float* o = OL + row * 132 + 32 * part;
            f32x4 v[8]; float s = 0.f;
#pragma unroll
            for (int k = 0; k < 8; ++k) { v[k] = *(const f32x4*)(o + 4 * k); s += (v[k][0] + v[k][1]) + (v[k][2] + v[k][3]); }
            s += __shfl_xor(s, 1); s += __shfl_xor(s, 2);
            const float mu = s * (1.f / 128.f); float q = 0.f;
#pragma unroll
            for (int k = 0; k < 8; ++k) { v[k] = v[k] - mu; q += (v[k][0] * v[k][0] + v[k][1] * v[k][1]) + (v[k][2] * v[k][2] + v[k][3] * v[k][3]); }
            q += __shfl_xor(q, 1); q += __shfl_xor(q, 2);
            const float rs = 1.f / sqrtf(q * (1.f / 128.f) + EPS);
            const size_t grow = row0 + row;
            const float* gp = p.rg + h * 128 + 32 * part;
            const u32x4* sp = (const u32x4*)(SRG + grow * 512 + h * 128 + 32 * part);
            u32x4* dp = (u32x4*)(MIX + grow * 1024 + 512 + h * 128 + 32 * part);
#pragma unroll
            for (int k2 = 0; k2 < 4; ++k2) {
                const u32x4 sg = sp[k2]; const f32x4 g0 = *(const f32x4*)(gp + 8 * k2), g1 = *(const f32x4*)(gp + 8 * k2 + 4);
                const f32x4 a = v[2 * k2], c2 = v[2 * k2 + 1];
                u32x4 w;
                w.x = pk2(a[0] * rs * g0[0] * bf_lo(sg.x), a[1] * rs * g0[1] * bf_hi(sg.x));
                w.y = pk2(a[2] * rs * g0[2] * bf_lo(sg.y), a[3] * rs * g0[3] * bf_hi(sg.y));
                w.z = pk2(c2[0] * rs * g1[0] * bf_lo(sg.z), c2[1] * rs * g1[1] * bf_hi(sg.z));
                w.w = pk2(c2[2] * rs * g1[2] * bf_lo(sg.w), c2[3] * rs * g1[3] * bf_hi(sg.w));
                dp[k2] = w;
            }
        }
        __syncthreads();
    }
    {
        const bf16_t* U = (const bf16_t*)(p.ws + WS_U); const bf16_t* G = (const bf16_t*)(p.ws + WS_G); const float* MP = (const float*)(p.ws + WS_MP);
        const int ch = (tid & 63) * 8, ts = tid >> 6;
        float w0[8], w1[8], w2[8];
#pragma unroll
        for (int j = 0; j < 8; ++j) { w0[j] = p.conv_w[ch + j]; w1[j] = p.conv_w[512 + ch + j]; w2[j] = p.conv_w[1024 + ch + j]; }
        for (int it = blockIdx.x; it < M_TOK / 32; it += gridDim.x) {
            const int rowb = it * 32 + ts * 4;
            float um2[8], um1[8];
#pragma unroll
            for (int k = 0; k < 2; ++k) {
                float* dstu = k ? um1 : um2; const int r = rowb - 2 + k; const int t = (rowb & (SEQ - 1)) - 2 + k;
                if (t >= 0) { const u32x4 w = *(const u32x4*)(U + (size_t)r * 512 + ch);
                    dstu[0] = bf_lo(w.x); dstu[1] = bf_hi(w.x); dstu[2] = bf_lo(w.y); dstu[3] = bf_hi(w.y); dstu[4] = bf_lo(w.z); dstu[5] = bf_hi(w.z); dstu[6] = bf_lo(w.w); dstu[7] = bf_hi(w.w);
                } else { const float* mp = MP + (NMETA + t) * NPROJ;
#pragma unroll
                    for (int j = 0; j < 8; ++j) dstu[j] = mp[ch + j] * mp[1024 + ch + j]; }
            }
#pragma unroll
            for (int i = 0; i < 4; ++i) {
                const size_t r = (size_t)(rowb + i);
                const u32x4 w = *(const u32x4*)(U + r * 512 + ch), gw = *(const u32x4*)(G + r * 512 + ch);
                float uc[8], gg[8];
                uc[0] = bf_lo(w.x); uc[1] = bf_hi(w.x); uc[2] = bf_lo(w.y); uc[3] = bf_hi(w.y); uc[4] = bf_lo(w.z); uc[5] = bf_hi(w.z); uc[6] = bf_lo(w.w); uc[7] = bf_hi(w.w);
                gg[0] = bf_lo(gw.x); gg[1] = bf_hi(gw.x); gg[2] = bf_lo(gw.y); gg[3] = bf_hi(gw.y); gg[4] = bf_lo(gw.z); gg[5] = bf_hi(gw.z); gg[6] = bf_lo(gw.w); gg[7] = bf_hi(gw.w);
                float o[8];
#pragma unroll
                for (int j = 0; j < 8; ++j) { o[j] = gg[j] * (w0[j] * um2[j] + w1[j] * um1[j] + w2[j] * uc[j]); um2[j] = um1[j]; um1[j] = uc[j]; }
                u32x4 ow; ow.x = pk2(o[0], o[1]); ow.y = pk2(o[2], o[3]); ow.z = pk2(o[4], o[5]); ow.w = pk2(o[6], o[7]);
                *(u32x4*)(MIX + r * 1024 + ch) = ow;
            }
        }
    }
}

DI void phase6(const Params& p) {
    const int tid = opaque_tid(), lane = tid & 63, wave = tid >> 6;
    const float* part = (const float*)(p.ws + WS_PART);
    const int gw = blockIdx.x * 8 + wave, NGW = gridDim.x * 8;
    f32x4 g[4];
#pragma unroll
    for (int j = 0; j < 4; ++j) g[j] = ((const f32x4*)p.gf)[lane + 64 * j];
    for (int row = gw; row < M_TOK; row += NGW) {
        float s = (lane < 16) ? part[(size_t)lane * M_TOK + row] : 0.f;
        s = wave_sum(s);
        const float rs = 1.f / sqrtf(s * (1.f / 1024.f) + EPS);
        f32x4* o = (f32x4*)(p.out + (size_t)row * DM) + lane;
#pragma unroll
        for (int j = 0; j < 4; ++j) { f32x4 v = o[64 * j]; v = v * rs * g[j]; o[64 * j] = v; }
    }
}

#ifndef DUP
#define DUP -1
#endif
#define REP(k) for (int rep_ = 0; rep_ < ((DUP == (k)) ? 2 : 1); ++rep_)
__global__ void __launch_bounds__(512, 2) hymba_fwd(Params p) {
    extern __shared__ __attribute__((aligned(16))) unsigned char lds[];
    cg::grid_group grid = cg::this_grid();
    unsigned char* ws = p.ws;
    unsigned* ctl = (unsigned*)ws;
    const bool fast = (gridDim.x == 256);
    volatile LAS unsigned* st = (volatile LAS unsigned*)((LAS unsigned char*)lds + 131072);
    if (threadIdx.x < 4) st[threadIdx.x] = 0u;
    __syncthreads();
    XcdBarrier bar = xcd_barrier_post(ctl, st);
#define SEAM() do { if (fast) xcd_barrier(bar); else grid.sync(); } while (0)
    REP(0) { phase0(p, lds); __syncthreads(); }
    SEAM();
    if (DUP == 7) { for (int i_ = 0; i_ < 6; ++i_) SEAM(); }
    REP(1) {
        pg8::Gemm g{(const bf16_t*)(ws + WS_XB), (const bf16_t*)(ws + WS_WIN), M_TOK, NPROJ, DM};
        pg8::StaticOrder S; S.init(M_TOK, NPROJ, (int)gridDim.x, (int)blockIdx.x);
        EpiProj E{(const float*)(ws + WS_RSTD), (bf16_t*)(ws + WS_U), (bf16_t*)(ws + WS_G), (bf16_t*)(ws + WS_QS), (bf16_t*)(ws + WS_KZ), (bf16_t*)(ws + WS_V), (bf16_t*)(ws + WS_SRG)};
        pg8::gemm_phase<EpiProj, pg8::StaticOrder, true, true>((LAS unsigned char*)lds, g, S, E);
    }
    SEAM();
    REP(2) phase2(p, lds);
    SEAM();
    REP(3) phase3(p);
    SEAM();
    REP(4) phase4(p, lds);
    SEAM();
    if (fast) {
        pg8::Gemm g{(const bf16_t*)(ws + WS_MIX), (const bf16_t*)(ws + WS_WOUT), M_TOK, DM, DM};
        pg8::StaticOrder S; S.init(M_TOK, DM, (int)gridDim.x, (int)blockIdx.x);
        EpiOutNorm E{p.x, p.out, p.gf, (float*)(ws + WS_PART), ctl};
        pg8::gemm_phase<EpiOutNorm, pg8::StaticOrder, false, true>((LAS unsigned char*)lds, g, S, E);
    } else {
        pg8::Gemm g{(const bf16_t*)(ws + WS_MIX), (const bf16_t*)(ws + WS_WOUT), M_TOK, DM, DM};
        pg8::StaticOrder S; S.init(M_TOK, DM, (int)gridDim.x, (int)blockIdx.x);
        EpiOut E{p.x, p.out, (float*)(ws + WS_PART)};
        pg8::gemm_phase<EpiOut, pg8::StaticOrder, true, true>((LAS unsigned char*)lds, g, S, E);
        grid.sync();
        phase6(p);
    }
}

extern "C" void kernel_launch(void* const* d_in, const int* in_sizes, int n_in, void* d_out, int out_size, void* d_ws, size_t ws_size, hipStream_t stream) {
    static int grid = 0;
    if (grid == 0) {
        if (n_in != 8 || in_sizes[0] != M_TOK * DM || out_size != M_TOK * DM || ws_size < WS_END) { fprintf(stderr, "kernel_launch: unexpected shapes (n_in %d, in0 %d, out %d, ws %zu)\n", n_in, n_in > 0 ? in_sizes[0] : -1, out_size, ws_size); grid = -1; return; }
        int dev = 0, cus = 0, per_cu = 0;
        hipGetDevice(&dev);
        hipDeviceGetAttribute(&cus, hipDeviceAttributeMultiprocessorCount, dev);
        if (hipFuncSetAttribute((const void*)hymba_fwd, hipFuncAttributeMaxDynamicSharedMemorySize, LDS_BYTES) != hipSuccess) { fprintf(stderr, "kernel_launch: hipFuncSetAttribute failed\n"); grid = -1; return; }
        if (hipOccupancyMaxActiveBlocksPerMultiprocessor(&per_cu, (const void*)hymba_fwd, 512, LDS_BYTES) != hipSuccess || per_cu < 1) { fprintf(stderr, "kernel_launch: occupancy query gave %d\n", per_cu); (void)hipGetLastError(); per_cu = 1; }
        grid = cus * per_cu;
        if (grid > 256) grid = 256;
    }
    if (grid < 0) return;
    Params p{};
    p.x = (const float*)d_in[0]; p.meta = (const float*)d_in[1]; p.g1 = (const float*)d_in[2]; p.w_in = (const float*)d_in[3];
    p.conv_w = (const float*)d_in[4]; p.rg = (const float*)d_in[5]; p.w_out = (const float*)d_in[6]; p.gf = (const float*)d_in[7];
    p.out = (float*)d_out; p.ws = (unsigned char*)d_ws;
    if (hipMemsetAsync(d_ws, 0, CTL_ZERO_BYTES, stream) != hipSuccess) { fprintf(stderr, "kernel_launch: hipMemsetAsync failed\n"); return; }
    void* args[] = {&p};
    hipError_t e = hipLaunchCooperativeKernel((const void*)hymba_fwd, dim3(grid), dim3(512), args, LDS_BYTES, stream);
    if (e != hipSuccess) fprintf(stderr, "cooperative launch failed: %s (grid %d)\n", hipGetErrorString(e), grid);
}
```

```cpp
#include <hip/hip_runtime.h>
#include <hip/hip_cooperative_groups.h>
#include <cstdio>
#include <cstdint>
namespace cg = cooperative_groups;

#define DI __device__ __forceinline__
#define LAS __attribute__((address_space(3)))
typedef unsigned short bf16_t;
typedef short bf16x8 __attribute__((ext_vector_type(8)));
typedef short s16x4 __attribute__((ext_vector_type(4)));
typedef short v4i16_t __attribute__((ext_vector_type(4)));
typedef float f32x2 __attribute__((ext_vector_type(2)));
typedef float f32x4 __attribute__((ext_vector_type(4)));
typedef float f32x16 __attribute__((ext_vector_type(16)));
typedef unsigned u32x2 __attribute__((ext_vector_type(2)));
typedef unsigned u32x4 __attribute__((ext_vector_type(4)));
typedef __bf16 bf16x2_t __attribute__((ext_vector_type(2)));

constexpr int M_TOK = 16384, DM = 1024, NPROJ = 4096, SEQ = 8192, NMETA = 16, NCHUNK = 64;
constexpr float EPS = 1e-6f;

constexpr size_t MiB = 1u << 20;
constexpr size_t WS_RSTD = 64 * 1024, WS_MP = 128 * 1024, WS_PART = 1 * MiB, WS_WIN = 2 * MiB, WS_WOUT = 10 * MiB, WS_XB = 16 * MiB;
constexpr size_t WS_U = 48 * MiB, WS_G = 64 * MiB, WS_QS = 80 * MiB, WS_KZ = 96 * MiB, WS_V = 112 * MiB, WS_SRG = 128 * MiB;
constexpr size_t WS_UPD = 144 * MiB, WS_TT = 176 * MiB, WS_MIX = 194 * MiB, WS_END = 226 * MiB;
constexpr int LDS_BYTES = 147456;

DI unsigned pk2(float lo, float hi) { f32x2 v = {lo, hi}; bf16x2_t b = __builtin_convertvector(v, bf16x2_t); return __builtin_bit_cast(unsigned, b); }
DI float bf_lo(unsigned u) { return __uint_as_float(u << 16); }
DI float bf_hi(unsigned u) { return __uint_as_float(u & 0xffff0000u); }
DI float silu_f(float x) { return x * __builtin_amdgcn_rcpf(1.f + __expf(-x)); }
DI float wave_sum(float v) {
#pragma unroll
    for (int o = 1; o < 64; o <<= 1) v += __shfl_xor(v, o);
    return v;
}
DI void sincos_rr(float ang, float& s, float& c) {
    const float k = rintf(ang * 0.15915494309189535f);
    float r = fmaf(-k, 6.2831854820251465f, ang);
    r = fmaf(-k, -1.7484555e-7f, r);
    const float rev = r * 0.15915494309189535f;
    s = __builtin_amdgcn_sinf(rev); c = __builtin_amdgcn_cosf(rev);
}
DI int opaque_tid() { int t = threadIdx.x; asm volatile("" : "+v"(t)); return t; }
DI float rope_freq(int d) { return exp2f(-(float)d * (13.287712379549449f / 64.f)); }
DI float log2_gamma(int h) { return log2f(1.f - exp2f(-5.f - (float)h)); }

namespace pg8 {
constexpr int BM = 256, BK = 64, HALF = 128, HTB = HALF * BK * 2, STAGE_BYTES = 8 * HTB, NXCD = 8, WGM = 8;
DI int lds_byte(int r, int c) { const int st = (r >> 4) * 2 + (c >> 5), rr = r & 15, cc = c & 31, ob = rr * 64 + cc * 2; return st * 1024 + (ob ^ (((ob >> 9) & 1) << 5)); }
DI void stage_rc(int b, int& R, int& C) { const int st = b / 1024, sb = b % 1024, swz = sb ^ (((sb >> 9) & 1) << 5); R = (st >> 1) * 16 + swz / 64; C = (st & 1) * 32 + (swz % 64) / 2; }
DI int perm32(int rho) { const int n = rho >> 4, i = rho & 15; return 8 * (i >> 2) + 4 * n + (i & 3); }
struct Unit { int pm, pn; };
struct Gemm { const bf16_t* A; const bf16_t* Bt; int M, N, K; };
struct StaticOrder {
    int nM, nN, nwg, G, c;
    DI void init(int M, int N, int G_, int c_) { nM = M / BM; nN = N / BM; nwg = nM * nN; G = G_; c = c_; }
    DI bool next(int i, Unit& u) const {
        const long L = (long)i * G + c; if (L >= nwg) return false;
        int wgid = (int)L; { const int q = nwg / NXCD, r = nwg % NXCD, xcd = wgid % NXCD, off = wgid / NXCD; wgid = (xcd < r ? xcd * (q + 1) : r * (q + 1) + (xcd - r) * q) + off; }
        const int nig = WGM * nN, gid = wgid / nig, fm = gid * WGM, gsz = (nM - fm) < WGM ? (nM - fm) : WGM;
        u.pm = fm + ((wgid % nig) % gsz); u.pn = (wgid % nig) / gsz; return true;
    }
    DI void a_ready(const Unit&) const {}
    DI void done(const Unit&) const {}
};

template <class Epi, class Sched, bool ALIGN_EPI = false, bool SP2 = false>
DI void gemm_phase(LAS unsigned char* lds, const Gemm g, const Sched& S, const Epi& E) {
    const int tid = opaque_tid(), wid = __builtin_amdgcn_readfirstlane(tid >> 6), lane = tid & 63, wr = wid >> 2, wc = wid & 3, fr = lane & 15, fq = lane >> 4;
    const int K = g.K, nt = K / BK;
    unsigned voffA[2], voffB[2];
#pragma unroll
    for (int i = 0; i < 2; ++i) { int R, C; stage_rc(tid * 16 + i * 8192, R, C); const int Rb = Epi::PERM ? ((R & ~31) + perm32(R & 31)) : R;
        voffA[i] = (unsigned)(R * K + C) * 2u; voffB[i] = (unsigned)(Rb * K + C) * 2u; }
    const size_t kstep = (size_t)(BK * 2);
    const size_t hstep = (size_t)HALF * K * 2;
    const size_t tstep = 2 * hstep;
    const unsigned ldsw = (unsigned)wid * 1024u;
    const int aoff = lds_byte(wr * 64 + fr, fq * 8), boff = lds_byte(wc * 32 + fr, fq * 8);
#define PG8_SA(b, h) (((b) * 2 + (h)) * HTB)
#define PG8_SB(b, h) ((4 + (b) * 2 + (h)) * HTB)
#define PG8_STAGE(bufoff, gbase, voff) do { _Pragma("unroll") for (int _i = 0; _i < 2; ++_i) \
        __builtin_amdgcn_global_load_lds((const unsigned*)((const char*)(gbase) + (voff)[_i]), (LAS unsigned*)(lds + (bufoff) + ldsw + _i * 8192), 16, 0, 0); } while (0)
#define PG8_LDA(dst, b, h) do { _Pragma("unroll") for (int m = 0; m < 4; ++m) _Pragma("unroll") for (int k = 0; k < 2; ++k) dst[m][k] = *(const LAS bf16x8*)(lds + PG8_SA(b, h) + aoff + m * 2048 + k * 1024); } while (0)
#define PG8_LDB(dst, b, h) do { _Pragma("unroll") for (int n = 0; n < 2; ++n) _Pragma("unroll") for (int k = 0; k < 2; ++k) dst[n][k] = *(const LAS bf16x8*)(lds + PG8_SB(b, h) + boff + n * 2048 + k * 1024); } while (0)
#define PG8_MMA(ai, bj, At, Bt) do { __builtin_amdgcn_s_setprio(1); _Pragma("unroll") for (int m = 0; m < 4; ++m) _Pragma("unroll") for (int n = 0; n < 2; ++n) _Pragma("unroll") for (int k = 0; k < 2; ++k) \
        acc[ai][bj][m][n] = __builtin_amdgcn_mfma_f32_16x16x32_bf16(Bt[n][k], At[m][k], acc[ai][bj][m][n], 0, 0, 0); __builtin_amdgcn_s_setprio(0); } while (0)
#define PG8_WAIT_V(n) asm volatile("s_waitcnt vmcnt(" #n ")" ::: "memory")
#define PG8_WAIT_L(n) asm volatile("s_waitcnt lgkmcnt(" #n ")" ::: "memory")
#define PG8_BAR __builtin_amdgcn_s_barrier()
#define PG8_SCHED __builtin_amdgcn_sched_barrier(0)
    Unit cur, nxt; int ui = 0;
    if (!S.next(0, cur)) return;
    f32x4 acc[2][2][4][2];
#pragma unroll
    for (int a = 0; a < 2; ++a)
#pragma unroll
        for (int b = 0; b < 2; ++b)
#pragma unroll
            for (int m = 0; m < 4; ++m)
#pragma unroll
                for (int n = 0; n < 2; ++n) acc[a][b][m][n] = (f32x4){0.f, 0.f, 0.f, 0.f};
    bf16x8 At[4][2], B0[2][2], B1[2][2];
    const char* cA = (const char*)g.A + (size_t)cur.pm * tstep; const char* cB = (const char*)g.Bt + (size_t)cur.pn * tstep;
    S.a_ready(cur);
    if constexpr (SP2) {
        PG8_STAGE(PG8_SB(0, 0), cB, voffB); PG8_STAGE(PG8_SB(0, 1), cB + hstep, voffB); PG8_STAGE(PG8_SA(0, 0), cA, voffA); PG8_STAGE(PG8_SA(0, 1), cA + hstep, voffA);
        if (wr == 1) PG8_BAR;
        PG8_WAIT_V(2); PG8_BAR;
        PG8_STAGE(PG8_SB(1, 0), cB + kstep, voffB); PG8_STAGE(PG8_SA(1, 0), cA + kstep, voffA); PG8_STAGE(PG8_SB(1, 1), cB + hstep + kstep, voffB);
        PG8_WAIT_V(6); PG8_BAR;
    } else {
        PG8_STAGE(PG8_SB(0, 0), cB, voffB); PG8_STAGE(PG8_SA(0, 0), cA, voffA); PG8_STAGE(PG8_SB(0, 1), cB + hstep, voffB); PG8_STAGE(PG8_SA(0, 1), cA + hstep, voffA);
        if (wr == 1) PG8_BAR;
        PG8_WAIT_V(4); PG8_BAR;
        PG8_STAGE(PG8_SB(1, 0), cB + kstep, voffB); PG8_STAGE(PG8_SA(1, 0), cA + kstep, voffA); PG8_STAGE(PG8_SB(1, 1), cB + hstep + kstep, voffB);
        PG8_WAIT_V(6); PG8_BAR;
    }
    for (;;) {
        const bool has_next = S.next(ui + 1, nxt);
        const char* nA = has_next ? (const char*)g.A + (size_t)nxt.pm * tstep : cA; const char* nB = has_next ? (const char*)g.Bt + (size_t)nxt.pn * tstep : cB;
        for (int t = 0; t < nt; t += 2) {
            const bool last = (t == nt - 2);
            const char* a1 = cA + (size_t)(t + 1) * kstep;
            const char* a2 = last ? nA : cA + (size_t)(t + 2) * kstep; const char* b2 = last ? nB : cB + (size_t)(t + 2) * kstep;
            const char* a3 = a2 + kstep; const char* b3 = b2 + kstep;
            if (last && has_next) S.a_ready(nxt);
            if constexpr (SP2) {
            PG8_LDB(B0, 0, 0); PG8_LDB(B1, 0, 1); PG8_SCHED; PG8_LDA(At, 0, 0); PG8_STAGE(PG8_SA(1, 1), a1 + hstep, voffA);
            PG8_WAIT_V(8); PG8_WAIT_L(0); PG8_BAR; PG8_MMA(0, 0, At, B0); PG8_MMA(0, 1, At, B1); PG8_BAR; PG8_SCHED;
            PG8_LDA(At, 0, 1); PG8_STAGE(PG8_SB(0, 0), b2, voffB); PG8_STAGE(PG8_SB(0, 1), b2 + hstep, voffB); PG8_STAGE(PG8_SA(0, 0), a2, voffA);
            PG8_WAIT_V(8); PG8_WAIT_L(0); PG8_BAR; PG8_MMA(1, 0, At, B0); PG8_MMA(1, 1, At, B1); PG8_BAR; PG8_SCHED;
            PG8_LDB(B0, 1, 0); PG8_LDB(B1, 1, 1); PG8_SCHED; PG8_LDA(At, 1, 0); PG8_STAGE(PG8_SA(0, 1), a2 + hstep, voffA);
            PG8_WAIT_V(8); PG8_WAIT_L(0); PG8_BAR; PG8_MMA(0, 0, At, B0); PG8_MMA(0, 1, At, B1); PG8_BAR; PG8_SCHED;
            PG8_LDA(At, 1, 1); PG8_STAGE(PG8_SB(1, 0), b3, voffB); PG8_STAGE(PG8_SB(1, 1), b3 + hstep, voffB); PG8_STAGE(PG8_SA(1, 0), a3, voffA);
            PG8_WAIT_V(8); PG8_WAIT_L(0); PG8_BAR; PG8_MMA(1, 0, At, B0); PG8_MMA(1, 1, At, B1); PG8_BAR; PG8_SCHED;
            } else {
            PG8_LDB(B0, 0, 0); PG8_SCHED; PG8_LDA(At, 0, 0); PG8_STAGE(PG8_SA(1, 1), a1 + hstep, voffA);
            PG8_WAIT_L(8); PG8_BAR; PG8_WAIT_L(0); PG8_MMA(0, 0, At, B0); PG8_BAR; PG8_SCHED;
            PG8_LDB(B1, 0, 1); PG8_STAGE(PG8_SB(0, 0), b2, voffB);
            PG8_BAR; PG8_WAIT_L(0); PG8_MMA(0, 1, At, B1); PG8_BAR;
            PG8_LDA(At, 0, 1); PG8_STAGE(PG8_SA(0, 0), a2, voffA);
            PG8_BAR; PG8_WAIT_L(0); PG8_MMA(1, 0, At, B0); PG8_BAR; PG8_SCHED;
            PG8_STAGE(PG8_SB(0, 1), b2 + hstep, voffB);
            PG8_WAIT_V(6); PG8_BAR; PG8_MMA(1, 1, At, B1); PG8_BAR;
            PG8_LDB(B0, 1, 0); PG8_SCHED; PG8_LDA(At, 1, 0); PG8_STAGE(PG8_SA(0, 1), a2 + hstep, voffA);
            PG8_WAIT_L(8); PG8_BAR; PG8_WAIT_L(0); PG8_MMA(0, 0, At, B0); PG8_BAR; PG8_SCHED;
            PG8_LDB(B1, 1, 1); PG8_STAGE(PG8_SB(1, 0), b3, voffB);
            PG8_BAR; PG8_WAIT_L(0); PG8_MMA(0, 1, At, B1); PG8_BAR;
            PG8_LDA(At, 1, 1); PG8_STAGE(PG8_SA(1, 0), a3, voffA);
            PG8_BAR; PG8_WAIT_L(0); PG8_MMA(1, 0, At, B0); PG8_BAR; PG8_SCHED;
            PG8_STAGE(PG8_SB(1, 1), b3 + hstep, voffB);
            PG8_WAIT_V(6); PG8_BAR; PG8_MMA(1, 1, At, B1); PG8_BAR;
            }
        }
        if constexpr (ALIGN_EPI) { if (wr == 0) PG8_BAR; }
        if constexpr (!Epi::AFTER_DRAIN) { E(acc, cur, wr, wc, fr, fq); S.done(cur); }
        if (!has_next) break;
#pragma unroll
        for (int a = 0; a < 2; ++a)
#pragma unroll
            for (int b = 0; b < 2; ++b)
#pragma unroll
                for (int m = 0; m < 4; ++m)
#pragma unroll
                    for (int n = 0; n < 2; ++n) acc[a][b][m][n] = (f32x4){0.f, 0.f, 0.f, 0.f};
        cur = nxt; cA = nA; cB = nB; ++ui;
        if constexpr (ALIGN_EPI) { if (wr == 1) PG8_BAR; }
    }
    PG8_WAIT_V(0);
    if constexpr (!ALIGN_EPI) { if (wr == 0) PG8_BAR; }
    PG8_BAR;
    if constexpr (Epi::AFTER_DRAIN) { E.fused(acc, cur, wr, wc, fr, fq, lds, wid, lane); S.done(cur); }
#undef PG8_SA
#undef PG8_SB
#undef PG8_STAGE
#undef PG8_LDA
#undef PG8_LDB
#undef PG8_MMA
#undef PG8_WAIT_V
#undef PG8_WAIT_L
#undef PG8_BAR
#undef PG8_SCHED
}
}


#define XB_TMO      128
#define XB_XCNT(j)  (256  + 64 * (j))
#define XB_XSUB(j)  (1280 + 64 * (j))
#define XB_XGEN(j)  (2304 + 64 * (j))
#define XB_TOP      3328
#define XB_TOPGEN   3392
#define XCD_BAR_WORDS 3456
#define XB_SPIN_CAP (1u << 18)
constexpr int CW_PANEL = 4096;
constexpr size_t CTL_ZERO_BYTES = 40960;
DI unsigned xb_ld(unsigned* p)              { return __hip_atomic_load(p, __ATOMIC_RELAXED, __HIP_MEMORY_SCOPE_AGENT); }
DI unsigned xb_add(unsigned* p, unsigned v) { return __hip_atomic_fetch_add(p, v, __ATOMIC_RELAXED, __HIP_MEMORY_SCOPE_AGENT); }
DI unsigned xb_xcc_id() { return (unsigned)__builtin_amdgcn_s_getreg((3 << 11) | 20) & 0xFu; }
#define XB_SPIN(cond, bar) do { unsigned _sp = 0; while (cond) { __builtin_amdgcn_s_sleep(1); \
    if ((++_sp & 255u) == 0u) { if (xb_ld(&(bar)[XB_TMO])) break; if (_sp > XB_SPIN_CAP) { atomicAdd(&(bar)[XB_TMO], 1u); break; } } } } while (0)
struct XcdBarrier { unsigned* bar; unsigned x; volatile LAS unsigned* st; };
DI XcdBarrier xcd_barrier_post(unsigned* bar, volatile LAS unsigned* st) {
    XcdBarrier b; b.bar = bar; b.x = xb_xcc_id(); b.st = st;
    if (threadIdx.x == 0) (void)xb_add(&bar[XB_XCNT(b.x)], 1u);
    return b;
}
DI void xcd_barrier_complete(unsigned* bar, unsigned x, unsigned& nloc, unsigned& nx) {
    const unsigned G = gridDim.x * gridDim.y * gridDim.z;
    unsigned sum, cnt, mine, sp = 0u;
    for (;;) {
        sum = 0u; cnt = 0u; mine = 0u;
#pragma unroll
        for (unsigned j = 0; j < 16; ++j) { const unsigned c = xb_ld(&bar[XB_XCNT(j)]); sum += c; cnt += (c > 0u) ? 1u : 0u; mine = (j == x) ? c : mine; }
        if (sum == G) break;
        __builtin_amdgcn_s_sleep(1);
        if ((++sp & 255u) == 0u) { if (xb_ld(&bar[XB_TMO])) break; if (sp > XB_SPIN_CAP) { atomicAdd(&bar[XB_TMO], 1u); break; } }
    }
    nloc = mine > 0u ? mine : 1u; nx = cnt > 0u ? cnt : 1u;
}
DI void xcd_barrier(const XcdBarrier& b) {
    asm volatile("s_waitcnt vmcnt(0)" ::: "memory");
    __syncthreads();
    if (threadIdx.x == 0) {
        unsigned* bar = b.bar;
        __builtin_amdgcn_s_waitcnt(0);
        unsigned nloc = b.st[0], nx = b.st[1];
        if (nloc == 0u) { xcd_barrier_complete(bar, b.x, nloc, nx); b.st[0] = nloc; b.st[1] = nx; }
        const unsigned old = xb_add(&bar[XB_XSUB(b.x)], 1u);
        const unsigned gen = old / nloc;
        if (old + 1u == (gen + 1u) * nloc) {
            __builtin_amdgcn_fence(__ATOMIC_RELEASE, "agent");
            asm volatile("s_waitcnt vmcnt(0)" ::: "memory");
            const unsigned og = xb_add(&bar[XB_TOP], 1u);
            const unsigned tg = og / nx;
            if (og + 1u == (tg + 1u) * nx) xb_add(&bar[XB_TOPGEN], 1u);
            else XB_SPIN(xb_ld(&bar[XB_TOPGEN]) == tg, bar);
            __builtin_amdgcn_fence(__ATOMIC_ACQUIRE, "agent");
            xb_add(&bar[XB_XGEN(b.x)], 1u);
            asm volatile("s_waitcnt vmcnt(0)" ::: "memory");
        } else {
            XB_SPIN(xb_ld(&bar[XB_XGEN(b.x)]) == gen, bar);
            __builtin_amdgcn_fence(__ATOMIC_ACQUIRE, "agent");
            asm volatile("s_waitcnt vmcnt(0)" ::: "memory");
        }
    }
    __syncthreads();
}


DI u32x4 pack8(f32x4 a, f32x4 b) { u32x4 w; w.x = pk2(a[0], a[1]); w.y = pk2(a[2], a[3]); w.z = pk2(b[0], b[1]); w.w = pk2(b[2], b[3]); return w; }
DI f32x4 silu4(f32x4 v) { f32x4 o; o[0] = silu_f(v[0]); o[1] = silu_f(v[1]); o[2] = silu_f(v[2]); o[3] = silu_f(v[3]); return o; }

struct EpiProj {
    static constexpr bool PERM = true, AFTER_DRAIN = false;
    const float* rstd; bf16_t *U, *G, *QS, *KZ, *V, *SRG;
    DI void operator()(const f32x4 (&acc)[2][2][4][2], const pg8::Unit& u, int wr, int wc, int fr, int fq) const {
        const int pn = u.pn;
        const int row0 = u.pm * 256 + wr * 64 + fr;
        const int cw = wc * 32 + 8 * fq;
        if (pn < 8) {
            bf16_t* dst = (wc < 2 ? U : G) + pn * 64 + (cw & 63);
#pragma unroll
            for (int ai = 0; ai < 2; ++ai)
#pragma unroll
                for (int m = 0; m < 4; ++m) {
                    const int row = row0 + ai * 128 + m * 16; const float rs = rstd[row];
                    f32x4 a0 = acc[ai][0][m][0] * rs, a1 = acc[ai][0][m][1] * rs, b0 = acc[ai][1][m][0] * rs, b1 = acc[ai][1][m][1] * rs;
                    if (wc >= 2) { b0 = silu4(b0); b1 = silu4(b1); }
                    *(u32x4*)(dst + (size_t)row * 512) = pack8(a0 * b0, a1 * b1);
                }
        } else if (pn < 12) {
            const bool isq = pn < 10;
            const int head = 2 * ((pn - 8) & 1) + (wc >> 1);
            const int d0 = cw & 63;
            float fr8[8];
#pragma unroll
            for (int j = 0; j < 8; ++j) fr8[j] = rope_freq(d0 + j);
            const float lg = log2_gamma(head);
            bf16_t* dst = (isq ? QS : KZ) + head * 128 + d0;
#pragma unroll
            for (int ai = 0; ai < 2; ++ai)
#pragma unroll
                for (int m = 0; m < 4; ++m) {
                    const int row = row0 + ai * 128 + m * 16; const float rs = rstd[row];
                    const int t = row & (SEQ - 1), tl = t & 127; const float pos = (float)(NMETA + t);
                    const float sc = rs * (isq ? 0.08838834764831845f * exp2f((float)(tl - 127) * lg) : exp2f((float)(127 - tl) * lg));
                    f32x4 r1[2], r2[2];
#pragma unroll
                    for (int j = 0; j < 8; ++j) {
                        float s, c; sincos_rr(pos * fr8[j], s, c);
                        const float x1 = acc[ai][0][m][j >> 2][j & 3], x2 = acc[ai][1][m][j >> 2][j & 3];
                        r1[j >> 2][j & 3] = (x1 * c - x2 * s) * sc; r2[j >> 2][j & 3] = (x1 * s + x2 * c) * sc;
                    }
                    *(u32x4*)(dst + (size_t)row * 512) = pack8(r1[0], r1[1]);
                    *(u32x4*)(dst + (size_t)row * 512 + 64) = pack8(r2[0], r2[1]);
                }
        } else {
            const bool isv = pn < 14;
            bf16_t* dst = (isv ? V : SRG) + ((pn - 12) & 1) * 256 + cw;
#pragma unroll
            for (int ai = 0; ai < 2; ++ai)
#pragma unroll
                for (int m = 0; m < 4; ++m) {
                    const int row = row0 + ai * 128 + m * 16; const float rs = rstd[row];
#pragma unroll
                    for (int bj = 0; bj < 2; ++bj) {
                        f32x4 a0 = acc[ai][bj][m][0] * rs, a1 = acc[ai][bj][m][1] * rs;
                        if (!isv) { a0 = silu4(a0); a1 = silu4(a1); }
                        *(u32x4*)(dst + (size_t)row * 512 + bj * 128) = pack8(a0, a1);
                    }
                }
        }
    }
};

struct EpiOut {
    static constexpr bool PERM = true, AFTER_DRAIN = false;
    const float* x; float* out; float* part;
    DI void operator()(const f32x4 (&acc)[2][2][4][2], const pg8::Unit& u, int wr, int wc, int fr, int fq) const {
        const int row0 = u.pm * 256 + wr * 64 + fr, col0 = u.pn * 256 + wc * 32 + 8 * fq;
#pragma unroll
        for (int ai = 0; ai < 2; ++ai)
#pragma unroll
            for (int m = 0; m < 4; ++m) {
                const int row = row0 + ai * 128 + m * 16; float ss = 0.f;
#pragma unroll
                for (int bj = 0; bj < 2; ++bj) {
                    const size_t o = (size_t)row * DM + col0 + bj * 128;
                    const f32x4 y0 = acc[ai][bj][m][0] + *(const f32x4*)(x + o), y1 = acc[ai][bj][m][1] + *(const f32x4*)(x + o + 4);
                    ss += (y0[0] * y0[0] + y0[1] * y0[1]) + (y0[2] * y0[2] + y0[3] * y0[3]) + (y1[0] * y1[0] + y1[1] * y1[1]) + (y1[2] * y1[2] + y1[3] * y1[3]);
                    *(f32x4*)(out + o) = y0; *(f32x4*)(out + o + 4) = y1;
                }
                ss += __shfl_xor(ss, 16); ss += __shfl_xor(ss, 32);
                if (fq == 0) part[(size_t)(u.pn * 4 + wc) * M_TOK + row] = ss;
            }
    }
};


struct EpiOutNorm {
    static constexpr bool PERM = true, AFTER_DRAIN = true;
    const float* x; float* out; const float* gf; float* xch; unsigned* ctl;
    DI void fused(f32x4 (&acc)[2][2][4][2], const pg8::Unit& u, int wr, int wc, int fr, int fq, LAS unsigned char* lds, int wid, int lane) const {
        LAS float* P = (LAS float*)lds;
        LAS float* R = (LAS float*)(lds + 4096);
        const int row0 = u.pm * 256 + wr * 64 + fr, col0 = u.pn * 256 + wc * 32 + 8 * fq;
#pragma unroll
        for (int ai = 0; ai < 2; ++ai)
#pragma unroll
            for (int m = 0; m < 4; ++m) {
                const int row = row0 + ai * 128 + m * 16; float ss = 0.f;
#pragma unroll
                for (int bj = 0; bj < 2; ++bj) {
                    const size_t o = (size_t)row * DM + col0 + bj * 128;
                    const f32x4 y0 = acc[ai][bj][m][0] + *(const f32x4*)(x + o), y1 = acc[ai][bj][m][1] + *(const f32x4*)(x + o + 4);
                    ss += (y0[0] * y0[0] + y0[1] * y0[1]) + (y0[2] * y0[2] + y0[3] * y0[3]) + (y1[0] * y1[0] + y1[1] * y1[1]) + (y1[2] * y1[2] + y1[3] * y1[3]);
                    acc[ai][bj][m][0] = y0; acc[ai][bj][m][1] = y1;
                }
                ss += __shfl_xor(ss, 16); ss += __shfl_xor(ss, 32);
                if (fq == 0) P[(ai * 128 + wr * 64 + m * 16 + fr) * 4 + wc] = ss;
            }
        __syncthreads();
        const int tid = wid * 64 + lane;
        float* slot = xch + (size_t)(u.pm * 4) * 256;
        if (tid < 256) { const f32x4 pp = *(const LAS f32x4*)(P + tid * 4); const float v = (pp[0] + pp[1]) + (pp[2] + pp[3]);
            __hip_atomic_store(slot + u.pn * 256 + tid, v, __ATOMIC_RELAXED, __HIP_MEMORY_SCOPE_AGENT); }
        asm volatile("s_waitcnt vmcnt(0)" ::: "memory");
        __syncthreads();
        if (tid == 0) {
            unsigned* cnt = ctl + CW_PANEL + 64 * u.pm;
            __builtin_amdgcn_fence(__ATOMIC_RELEASE, "agent");
            asm volatile("s_waitcnt vmcnt(0)" ::: "memory");
            xb_add(cnt, 1u);
            unsigned sp = 0u;
            while (xb_ld(cnt) < 4u) { __builtin_amdgcn_s_sleep(1); if (++sp > (1u << 22)) break; }
            __builtin_amdgcn_fence(__ATOMIC_ACQUIRE, "agent");
            asm volatile("s_waitcnt vmcnt(0)" ::: "memory");
        }
        __syncthreads();
        if (tid < 256) { float s = 0.f;
#pragma unroll
            for (int q = 0; q < 4; ++q) s += __hip_atomic_load(slot + q * 256 + tid, __ATOMIC_RELAXED, __HIP_MEMORY_SCOPE_AGENT);
            R[tid] = 1.f / sqrtf(s * (1.f / 1024.f) + EPS); }
        __syncthreads();
        f32x4 gv[2][2];
#pragma unroll
        for (int bj = 0; bj < 2; ++bj) { gv[bj][0] = *(const f32x4*)(gf + col0 + bj * 128); gv[bj][1] = *(const f32x4*)(gf + col0 + bj * 128 + 4); }
#pragma unroll
        for (int ai = 0; ai < 2; ++ai)
#pragma unroll
            for (int m = 0; m < 4; ++m) {
                const int lrow = ai * 128 + wr * 64 + m * 16 + fr; const float rs = R[lrow];
#pragma unroll
                for (int bj = 0; bj < 2; ++bj) {
                    const size_t o = (size_t)(u.pm * 256 + lrow) * DM + col0 + bj * 128;
                    *(f32x4*)(out + o) = acc[ai][bj][m][0] * rs * gv[bj][0]; *(f32x4*)(out + o + 4) = acc[ai][bj][m][1] * rs * gv[bj][1];
                }
            }
    }
};

DI unsigned off_b(unsigned row, unsigned ch) { return 256u * row + 16u * (ch ^ (((row & 3) << 2) | ((row >> 2) & 3))); }
DI bf16x8 row_frag(const unsigned char* img, int rb, int s, int lane) {
    return *(const bf16x8*)(img + 8192 * rb + off_b(lane & 31, 2 * s + (lane >> 5)));
}
DI s16x4 tr_read(const unsigned char* p) { return __builtin_bit_cast(s16x4, __builtin_amdgcn_ds_read_tr16_b64_v4i16((LAS v4i16_t*)(const LAS unsigned char*)p)); }
template <bool PERMK> DI bf16x8 tr_frag(const unsigned char* img, int c, int rbase, int lane) {
    const int h = lane >> 5, blk = (lane >> 4) & 1, q = (lane & 15) >> 2, p = lane & 3;
    const int r0 = rbase + (PERMK ? 4 * h : 8 * h) + q, r1 = r0 + (PERMK ? 8 : 4);
    const unsigned ch = 4 * c + 2 * blk + (p >> 1), bo = 8 * (p & 1);
    const s16x4 lo = tr_read(img + off_b(r0, ch) + bo), hi = tr_read(img + off_b(r1, ch) + bo);
    return __builtin_shufflevector(lo, hi, 0, 1, 2, 3, 4, 5, 6, 7);
}
DI void load_tile(unsigned char* img, const bf16_t* src, int ld, int tid) {
#pragma unroll
    for (int i = 0; i < 4; ++i) { const int idx = tid + 512 * i, row = idx >> 4, ch = idx & 15;
        *(u32x4*)(img + off_b(row, ch)) = *(const u32x4*)(src + (size_t)row * ld + ch * 8); }
}
DI int crow(int reg, int h) { return (reg & 3) + 8 * (reg >> 2) + 4 * h; }
#define MFMA32(a, b, c) __builtin_amdgcn_mfma_f32_32x32x16_bf16((a), (b), (c), 0, 0, 0)

struct Params { const float *x, *meta, *g1, *w_in, *conv_w, *rg, *w_out, *gf; float* out; unsigned char* ws; };


DI int dest_pos(int n) {
    const int type = n >> 9, r = n & 511;
    if (type < 4) return (r >> 6) * 256 + type * 64 + (r & 63);
    if (type < 6) { const int h = r >> 7, d = r & 127; return (8 + (type - 4) * 2 + (h >> 1)) * 256 + (d >> 6) * 128 + (h & 1) * 64 + (d & 63); }
    return n;
}

DI void p0_transpose_item(const float* W, const float* gain, int K, int N, bf16_t* WT, bool perm, float* scr, int item, int lane) {
    const int nblk = N / 32, kb = item / nblk, nb = item % nblk, k0 = 64 * kb, n0 = 32 * nb;
#pragma unroll 8
    for (int i = 0; i < 32; ++i) { const int kk = 2 * i + (lane >> 5); float w = W[(size_t)(k0 + kk) * N + n0 + (lane & 31)]; if (gain) w *= gain[k0 + kk]; scr[kk * 33 + (lane & 31)] = w; }
    __builtin_amdgcn_s_waitcnt(0xc07f); asm volatile("" ::: "memory");
    const int c = lane & 7;
    const int nd0 = perm ? dest_pos(n0) : n0;
#pragma unroll
    for (int j = 0; j < 4; ++j) { const int n = (lane >> 3) + 8 * j; const float* s = scr + (8 * c) * 33 + n;
        u32x4 o; o.x = pk2(s[0 * 33], s[1 * 33]); o.y = pk2(s[2 * 33], s[3 * 33]); o.z = pk2(s[4 * 33], s[5 * 33]); o.w = pk2(s[6 * 33], s[7 * 33]);
        *(u32x4*)(WT + (size_t)(nd0 + n) * K + k0 + 8 * c) = o; }
    __builtin_amdgcn_s_waitcnt(0xc07f); asm volatile("" ::: "memory");
}

DI void phase0(const Params& p, unsigned char* lds) {
    const int tid = opaque_tid(), lane = tid & 63, wave = tid >> 6;
    unsigned char* ws = p.ws;
    float* rstd = (float*)(ws + WS_RSTD); float* MP = (float*)(ws + WS_MP);
    bf16_t* XB = (bf16_t*)(ws + WS_XB); bf16_t* WIN = (bf16_t*)(ws + WS_WIN); bf16_t* WOUT = (bf16_t*)(ws + WS_WOUT);
    {
        float* metaL = (float*)lds; float* red = (float*)(lds + 65536); float* rsL = (float*)(lds + 98304);
        for (int i = tid; i < 4096; i += 512) ((f32x4*)metaL)[i] = ((const f32x4*)p.meta)[i];
        __syncthreads();
#pragma unroll
        for (int rr = 0; rr < 2; ++rr) { const int m = 2 * wave + rr; float s = 0.f;
#pragma unroll
            for (int i = 0; i < 16; ++i) { const float v = metaL[m * 1024 + lane + 64 * i]; s += v * v; }
            s = wave_sum(s); if (lane == 0) rsL[m] = 1.f / sqrtf(s * (1.f / 1024.f) + EPS); }
        for (int cgp = blockIdx.x; cgp < 256; cgp += gridDim.x) {
            const int col = tid & 15, ks = tid >> 4, n = cgp * 16 + col;
            float a[16];
#pragma unroll
            for (int m = 0; m < 16; ++m) a[m] = 0.f;
#pragma unroll 4
            for (int kk = 0; kk < 32; ++kk) { const int k = kk * 32 + ks; const float w = p.w_in[(size_t)k * NPROJ + n] * p.g1[k];
#pragma unroll
                for (int m = 0; m < 16; ++m) a[m] = fmaf(metaL[m * 1024 + k], w, a[m]); }
#pragma unroll
            for (int m = 0; m < 16; ++m) red[(ks * 16 + m) * 16 + col] = a[m];
            __syncthreads();
            if (tid < 256) { const int m = tid >> 4, c = tid & 15; float s = 0.f;
#pragma unroll 8
                for (int k2 = 0; k2 < 32; ++k2) s += red[(k2 * 16 + m) * 16 + c];
                MP[m * NPROJ + cgp * 16 + c] = s * rsL[m]; }
            __syncthreads();
        }
    }
    __syncthreads();
    const int gw = blockIdx.x * 8 + wave, NGW = gridDim.x * 8;
    {
        float* scr = (float*)(lds + wave * 16384);
        constexpr int I_IN = (DM / 64) * (NPROJ / 32), I_OUT = (DM / 64) * (DM / 32);
        for (int it = gw; it < I_IN + I_OUT; it += NGW) {
            if (it < I_IN) p0_transpose_item(p.w_in, p.g1, DM, NPROJ, WIN, true, scr, it, lane);
            else p0_transpose_item(p.w_out, nullptr, DM, DM, WOUT, false, scr, it - I_IN, lane);
        }
    }
    for (int row = gw; row < M_TOK; row += 2 * NGW) {
        const int row2 = row + NGW;
        const f32x4* xr = (const f32x4*)(p.x + (size_t)row * DM) + lane; const f32x4* xr2 = (const f32x4*)(p.x + (size_t)row2 * DM) + lane;
        f32x4 v[4], v2[4]; float s = 0.f, s2 = 0.f;
#pragma unroll
        for (int j = 0; j < 4; ++j) { v[j] = __builtin_nontemporal_load(xr + 64 * j); v2[j] = __builtin_nontemporal_load(xr2 + 64 * j); }
#pragma unroll
        for (int j = 0; j < 4; ++j) { s += (v[j][0] * v[j][0] + v[j][1] * v[j][1]) + (v[j][2] * v[j][2] + v[j][3] * v[j][3]); s2 += (v2[j][0] * v2[j][0] + v2[j][1] * v2[j][1]) + (v2[j][2] * v2[j][2] + v2[j][3] * v2[j][3]); }
        s = wave_sum(s); s2 = wave_sum(s2);
        if (lane == 0) { rstd[row] = 1.f / sqrtf(s * (1.f / 1024.f) + EPS); rstd[row2] = 1.f / sqrtf(s2 * (1.f / 1024.f) + EPS); }
        u32x2* o = (u32x2*)(XB + (size_t)row * DM) + lane; u32x2* o2 = (u32x2*)(XB + (size_t)row2 * DM) + lane;
#pragma unroll
        for (int j = 0; j < 4; ++j) { u32x2 w; w.x = pk2(v[j][0], v[j][1]); w.y = pk2(v[j][2], v[j][3]); o[64 * j] = w; u32x2 w2; w2.x = pk2(v2[j][0], v2[j][1]); w2.y = pk2(v2[j][2], v2[j][3]); o2[64 * j] = w2; }
    }
}

DI void phase2(const Params& p, unsigned char* lds) {
    const int tid = opaque_tid(), lane = tid & 63, wave = tid >> 6, h5 = lane >> 5;
    const bf16_t* KZ = (const bf16_t*)(p.ws + WS_KZ); const bf16_t* V = (const bf16_t*)(p.ws + WS_V); float* UPD = (float*)(p.ws + WS_UPD);
    unsigned char* Kimg = lds; unsigned char* Vimg = lds + 32768;
    const int eb = wave & 3, dh = wave >> 2;
    for (int it = blockIdx.x; it < 8 * 63; it += gridDim.x) {
        const int bh = it / 63, n = 1 + it % 63, b = bh >> 2, h = bh & 3;
        const size_t row0 = (size_t)b * SEQ + (size_t)(n - 1) * 128;
        load_tile(Kimg, KZ + row0 * 512 + h * 128, 512, tid);
        load_tile(Vimg, V + row0 * 512 + h * 128, 512, tid);
        __syncthreads();
        f32x16 a0, a1;
#pragma unroll
        for (int i = 0; i < 16; ++i) { a0[i] = 0.f; a1[i] = 0.f; }
#pragma unroll
        for (int ks = 0; ks < 8; ++ks) {
            const bf16x8 av = tr_frag<false>(Vimg, eb, 16 * ks, lane);
            const bf16x8 b0 = tr_frag<false>(Kimg, 2 * dh, 16 * ks, lane), b1 = tr_frag<false>(Kimg, 2 * dh + 1, 16 * ks, lane);
            a0 = MFMA32(av, b0, a0); a1 = MFMA32(av, b1, a1);
        }
        float* dst = UPD + ((size_t)(bh * 64 + n) * 128 + 32 * eb) * 128 + 64 * dh + (lane & 31);
#pragma unroll
        for (int r = 0; r < 16; ++r) { const int e = crow(r, h5); dst[e * 128] = a0[r]; dst[e * 128 + 32] = a1[r]; }
        __syncthreads();
    }
}

DI void phase3(const Params& p) {
    const float* MP = (const float*)(p.ws + WS_MP); const float* UPD = (const float*)(p.ws + WS_UPD); bf16_t* TT = (bf16_t*)(p.ws + WS_TT);
    const int tid3 = opaque_tid();
    for (int gid = blockIdx.x * 512 + tid3; gid < 8 * 16384; gid += gridDim.x * 512) {
        const int bh = gid >> 14, idx = gid & 16383, e = idx >> 7, d = idx & 127, h = bh & 3;
        const float lg = log2_gamma(h), cdec = exp2f(128.f * lg);
        const int dl = d & 63; const float fq = rope_freq(dl);
        float s1 = 0.f;
#pragma unroll 4
        for (int m = 0; m < NMETA; ++m) {
            const float* mp = MP + m * NPROJ;
            const float x1 = mp[5 * 512 + h * 128 + dl], x2 = mp[5 * 512 + h * 128 + 64 + dl];
            float s, c; sincos_rr((float)m * fq, s, c);
            const float kr = (d < 64) ? (x1 * c - x2 * s) : (x1 * s + x2 * c);
            s1 = fmaf(mp[6 * 512 + h * 128 + e] * exp2f((float)(15 - m) * lg), kr, s1);
        }
        float T = cdec * s1;
        const float* up = UPD + (size_t)bh * 64 * 16384 + idx;
        bf16_t* tt = TT + (size_t)bh * 65 * 16384 + idx;
        tt[16384] = (bf16_t)(pk2(T, 0.f) & 0xffffu);
        float u[63];
#pragma unroll
        for (int i = 0; i < 63; ++i) u[i] = up[(size_t)(i + 1) * 16384];
#pragma unroll
        for (int i = 0; i < 63; ++i) { T = cdec * (T + u[i]); tt[(size_t)(i + 2) * 16384] = (bf16_t)(pk2(T, 0.f) & 0xffffu); }
    }
}

DI void phase4(const Params& p, unsigned char* lds) {
    const int tid = opaque_tid(), lane = tid & 63, wave = tid >> 6, h5 = lane >> 5;
    const bf16_t* QS = (const bf16_t*)(p.ws + WS_QS); const bf16_t* KZ = (const bf16_t*)(p.ws + WS_KZ); const bf16_t* V = (const bf16_t*)(p.ws + WS_V);
    const bf16_t* SRG = (const bf16_t*)(p.ws + WS_SRG); const bf16_t* TT = (const bf16_t*)(p.ws + WS_TT); bf16_t* MIX = (bf16_t*)(p.ws + WS_MIX);
    unsigned char* Qimg = lds; unsigned char* Kimg = lds + 32768; unsigned char* Vimg = lds + 65536; unsigned char* Timg = lds + 98304;
    float* OL = (float*)lds;
    const int ib = wave & 3, eh = wave >> 2;
    for (int it = blockIdx.x; it < 8 * 64; it += gridDim.x) {
        const int bh = it >> 6, n = 1 + (it & 63), b = bh >> 2, h = bh & 3;
        const size_t row0 = (size_t)b * SEQ + (size_t)(n - 1) * 128;
        load_tile(Qimg, QS + row0 * 512 + h * 128, 512, tid);
        load_tile(Kimg, KZ + row0 * 512 + h * 128, 512, tid);
        load_tile(Vimg, V + row0 * 512 + h * 128, 512, tid);
        load_tile(Timg, TT + ((size_t)bh * 65 + n) * 16384, 128, tid);
        __syncthreads();
        bf16x8 qf[8];
#pragma unroll
        for (int s = 0; s < 8; ++s) qf[s] = row_frag(Qimg, ib, s, lane);
        f32x16 O0, O1;
#pragma unroll
        for (int i = 0; i < 16; ++i) { O0[i] = 0.f; O1[i] = 0.f; }
#pragma unroll
        for (int jb = 0; jb < 4; ++jb) {
            if (jb <= ib) {
                f32x16 c;
#pragma unroll
                for (int i = 0; i < 16; ++i) c[i] = 0.f;
#pragma unroll
                for (int s = 0; s < 8; ++s) c = MFMA32(row_frag(Kimg, jb, s, lane), qf[s], c);
                if (jb == ib) {
#pragma unroll
                    for (int r = 0; r < 16; ++r) if (crow(r, h5) > (lane & 31)) c[r] = 0.f;
                }
#pragma unroll
                for (int s2 = 0; s2 < 2; ++s2) {
                    u32x4 pw; pw.x = pk2(c[8 * s2 + 0], c[8 * s2 + 1]); pw.y = pk2(c[8 * s2 + 2], c[8 * s2 + 3]); pw.z = pk2(c[8 * s2 + 4], c[8 * s2 + 5]); pw.w = pk2(c[8 * s2 + 6], c[8 * s2 + 7]);
                    const bf16x8 pa = __builtin_bit_cast(bf16x8, pw);
                    const bf16x8 v0 = tr_frag<true>(Vimg, 2 * eh, 32 * jb + 16 * s2, lane), v1 = tr_frag<true>(Vimg, 2 * eh + 1, 32 * jb + 16 * s2, lane);
                    O0 = MFMA32(pa, v0, O0); O1 = MFMA32(pa, v1, O1);
                }
            }
        }
#pragma unroll
        for (int s = 0; s < 8; ++s) { O0 = MFMA32(qf[s], row_frag(Timg, 2 * eh, s, lane), O0); O1 = MFMA32(qf[s], row_frag(Timg, 2 * eh + 1, s, lane), O1); }
        __syncthreads();
        {
            float* o = OL + (32 * ib) * 132 + 64 * eh + (lane & 31);
#pragma unroll
            for (int r = 0; r < 16; ++r) { const int i = crow(r, h5); o[i * 132] = O0[r]; o[i * 132 + 32] = O1[r]; }
        }
        __syncthreads();
        {
            const int row = tid >> 2, part = tid & 3;
            const float* o = OL + row * 132 + 32 * part;
            f32x4 v[8]; float s = 0.f;
#pragma unroll
            for (int k = 0; k < 8; ++k) { v[k] = *(const f32x4*)(o + 4 * k); s += (v[k][0] + v[k][1]) + (v[k][2] + v[k][3]); }
            s += __shfl_xor(s, 1); s += __shfl_xor(s, 2);
            const float mu = s * (1.f / 128.f); float q = 0.f;
#pragma unroll
            for (int k = 0; k < 8; ++k) { v[k] = v[k] - mu; q += (v[k][0] * v[k][0] + v[k][1] * v[k][1]) + (v[k][2] * v[k][2] + v[k][3] * v[k][3]); }
            q += __shfl_xor(q, 1); q += __shfl_xor(q, 2);
            const float rs = 1.f / sqrtf(q * (1.f / 128.f) + EPS);
            const size_t grow = row0 + row;
            const float* gp = p.rg + h * 128 + 32 * part;
            const u32x4* sp = (const u32x4*)(SRG + grow * 512 + h * 128 + 32 * part);
            u32x4* dp = (u32x4*)(MIX + grow * 1024 + 512 + h * 128 + 32 * part);
#pragma unroll
            for (int k2 = 0; k2 < 4; ++k2) {
                const u32x4 sg = sp[k2]; const f32x4 g0 = *(const f32x4*)(gp + 8 * k2), g1 = *(const f32x4*)(gp + 8 * k2 + 4);
                const f32x4 a = v[2 * k2], c2 = v[2 * k2 + 1];
                u32x4 w;
                w.x = pk2(a[0] * rs * g0[0] * bf_lo(sg.x), a[1] * rs * g0[1] * bf_hi(sg.x));
                w.y = pk2(a[2] * rs * g0[2] * bf_lo(sg.y), a[3] * rs * g0[3] * bf_hi(sg.y));
                w.z = pk2(c2[0] * rs * g1[0] * bf_lo(sg.z), c2[1] * rs * g1[1] * bf_hi(sg.z));
                w.w = pk2(c2[2] * rs * g1[2] * bf_lo(sg.w), c2[3] * rs * g1[3] * bf_hi(sg.w));
                dp[k2] = w;
            }
        }
        __syncthreads();
    }
    {
        const bf16_t* U = (const bf16_t*)(p.ws + WS_U); const bf16_t* G = (const bf16_t*)(p.ws + WS_G); const float* MP = (const float*)(p.ws + WS_MP);
        const int ch = (tid & 63) * 8, ts = tid >> 6;
        float w0[8], w1[8], w2[8];
#pragma unroll
        for (int j = 0; j < 8; ++j) { w0[j] = p.conv_w[ch + j]; w1[j] = p.conv_w[512 + ch + j]; w2[j] = p.conv_w[1024 + ch + j]; }
        for (int it = blockIdx.x; it < M_TOK / 32; it += gridDim.x) {
            const int rowb = it * 32 + ts * 4;
            float um2[8], um1[8];
#pragma unroll
            for (int k = 0; k < 2; ++k) {
                float* dstu = k ? um1 : um2; const int r = rowb - 2 + k; const int t = (rowb & (SEQ - 1)) - 2 + k;
                if (t >= 0) { const u32x4 w = *(const u32x4*)(U + (size_t)r * 512 + ch);
                    dstu[0] = bf_lo(w.x); dstu[1] = bf_hi(w.x); dstu[2] = bf_lo(w.y); dstu[3] = bf_hi(w.y); dstu[4] = bf_lo(w.z); dstu[5] = bf_hi(w.z); dstu[6] = bf_lo(w.w); dstu[7] = bf_hi(w.w);
                } else { const float* mp = MP + (NMETA + t) * NPROJ;
#pragma unroll
                    for (int j = 0; j < 8; ++j) dstu[j] = mp[ch + j] * mp[1024 + ch + j]; }
            }
#pragma unroll
            for (int i = 0; i < 4; ++i) {
                const size_t r = (size_t)(rowb + i);
                const u32x4 w = *(const u32x4*)(U + r * 512 + ch), gw = *(const u32x4*)(G + r * 512 + ch);
                float uc[8], gg[8];
                uc[0] = bf_lo(w.x); uc[1] = bf_hi(w.x); uc[2] = bf_lo(w.y); uc[3] = bf_hi(w.y); uc[4] = bf_lo(w.z); uc[5] = bf_hi(w.z); uc[6] = bf_lo(w.w); uc[7] = bf_hi(w.w);
                gg[0] = bf_lo(gw.x); gg[1] = bf_hi(gw.x); gg[2] = bf_lo(gw.y); gg[3] = bf_hi(gw.y); gg[4] = bf_lo(gw.z); gg[5] = bf_hi(gw.z); gg[6] = bf_lo(gw.w); gg[7] = bf_hi(gw.w);
                float o[8];
#pragma unroll
                for (int j = 0; j < 8; ++j) { o[j] = gg[j] * (w0[j] * um2[j] + w1[j] * um1[j] + w2[j] * uc[j]); um2[j] = um1[j]; um1[j] = uc[j]; }
                u32x4 ow; ow.x = pk2(o[0], o[1]); ow.y = pk2(o[2], o[3]); ow.z = pk2(o[4], o[5]); ow.w = pk2(o[6], o[7]);
                *(u32x4*)(MIX + r * 1024 + ch) = ow;
            }
        }
    }
}

DI void phase6(const Params& p) {
    const int tid = opaque_tid(), lane = tid & 63, wave = tid >> 6;
    const float* part = (const float*)(p.ws + WS_PART);
    const int gw = blockIdx.x * 8 + wave, NGW = gridDim.x * 8;
    f32x4 g[4];
#pragma unroll
    for (int j = 0; j < 4; ++j) g[j] = ((const f32x4*)p.gf)[lane + 64 * j];
    for (int row = gw; row < M_TOK; row += NGW) {
        float s = (lane < 16) ? part[(size_t)lane * M_TOK + row] : 0.f;
        s = wave_sum(s);
        const float rs = 1.f / sqrtf(s * (1.f / 1024.f) + EPS);
        f32x4* o = (f32x4*)(p.out + (size_t)row * DM) + lane;
#pragma unroll
        for (int j = 0; j < 4; ++j) { f32x4 v = o[64 * j]; v = v * rs * g[j]; o[64 * j] = v; }
    }
}

#ifndef DUP
#define DUP -1
#endif
#define REP(k) for (int rep_ = 0; rep_ < ((DUP == (k)) ? 2 : 1); ++rep_)
__global__ void __launch_bounds__(512, 2) hymba_fwd(Params p) {
    extern __shared__ __attribute__((aligned(16))) unsigned char lds[];
    cg::grid_group grid = cg::this_grid();
    unsigned char* ws = p.ws;
    unsigned* ctl = (unsigned*)ws;
    const bool fast = (gridDim.x == 256);
    volatile LAS unsigned* st = (volatile LAS unsigned*)((LAS unsigned char*)lds + 131072);
    if (threadIdx.x < 4) st[threadIdx.x] = 0u;
    __syncthreads();
    XcdBarrier bar = xcd_barrier_post(ctl, st);
#define SEAM() do { if (fast) xcd_barrier(bar); else grid.sync(); } while (0)
    REP(0) { phase0(p, lds); __syncthreads(); }
    SEAM();
    if (DUP == 7) { for (int i_ = 0; i_ < 6; ++i_) SEAM(); }
    REP(1) {
        pg8::Gemm g{(const bf16_t*)(ws + WS_XB), (const bf16_t*)(ws + WS_WIN), M_TOK, NPROJ, DM};
        pg8::StaticOrder S; S.init(M_TOK, NPROJ, (int)gridDim.x, (int)blockIdx.x);
        EpiProj E{(const float*)(ws + WS_RSTD), (bf16_t*)(ws + WS_U), (bf16_t*)(ws + WS_G), (bf16_t*)(ws + WS_QS), (bf16_t*)(ws + WS_KZ), (bf16_t*)(ws + WS_V), (bf16_t*)(ws + WS_SRG)};
        pg8::gemm_phase<EpiProj, pg8::StaticOrder, true, true>((LAS unsigned char*)lds, g, S, E);
    }
    SEAM();
    REP(2) phase2(p, lds);
    SEAM();
    REP(3) phase3(p);
    SEAM();
    REP(4) phase4(p, lds);
    SEAM();
    if (fast) {
        pg8::Gemm g{(const bf16_t*)(ws + WS_MIX), (const bf16_t*)(ws + WS_WOUT), M_TOK, DM, DM};
        pg8::StaticOrder S; S.init(M_TOK, DM, (int)gridDim.x, (int)blockIdx.x);
        EpiOutNorm E{p.x, p.out, p.gf, (float*)(ws + WS_PART), ctl};
        pg8::gemm_phase<EpiOutNorm, pg8::StaticOrder, false, true>((LAS unsigned char*)lds, g, S, E);
    } else {
        pg8::Gemm g{(const bf16_t*)(ws + WS_MIX), (const bf16_t*)(ws + WS_WOUT), M_TOK, DM, DM};
        pg8::StaticOrder S; S.init(M_TOK, DM, (int)gridDim.x, (int)blockIdx.x);
        EpiOut E{p.x, p.out, (float*)(ws + WS_PART)};
        pg8::gemm_phase<EpiOut, pg8::StaticOrder, true, true>((LAS unsigned char*)lds, g, S, E);
        grid.sync();
        phase6(p);
    }
}

extern "C" void kernel_launch(void* const* d_in, const int* in_sizes, int n_in, void* d_out, int out_size, void* d_ws, size_t ws_size, hipStream_t stream) {
    static int grid = 0;
    if (grid == 0) {
        if (n_in != 8 || in_sizes[0] != M_TOK * DM || out_size != M_TOK * DM || ws_size < WS_END) { fprintf(stderr, "kernel_launch: unexpected shapes (n_in %d, in0 %d, out %d, ws %zu)\n", n_in, n_in > 0 ? in_sizes[0] : -1, out_size, ws_size); grid = -1; return; }
        int dev = 0, cus = 0, per_cu = 0;
        hipGetDevice(&dev);
        hipDeviceGetAttribute(&cus, hipDeviceAttributeMultiprocessorCount, dev);
        if (hipFuncSetAttribute((const void*)hymba_fwd, hipFuncAttributeMaxDynamicSharedMemorySize, LDS_BYTES) != hipSuccess) { fprintf(stderr, "kernel_launch: hipFuncSetAttribute failed\n"); grid = -1; return; }
        if (hipOccupancyMaxActiveBlocksPerMultiprocessor(&per_cu, (const void*)hymba_fwd, 512, LDS_BYTES) != hipSuccess || per_cu < 1) { fprintf(stderr, "kernel_launch: occupancy query gave %d\n", per_cu); (void)hipGetLastError(); per_cu = 1; }
        grid = cus * per_cu;
        if (grid > 256) grid = 256;
    }
    if (grid < 0) return;
    Params p{};
    p.x = (const float*)d_in[0]; p.meta = (const float*)d_in[1]; p.g1 = (const float*)d_in[2]; p.w_in = (const float*)d_in[3];
    p.conv_w = (const float*)d_in[4]; p.rg = (const float*)d_in[5]; p.w_out = (const float*)d_in[6]; p.gf = (const float*)d_in[7];
    p.out = (float*)d_out; p.ws = (unsigned char*)d_ws;
    if (hipMemsetAsync(d_ws, 0, CTL_ZERO_BYTES, stream) != hipSuccess) { fprintf(stderr, "kernel_launch: hipMemsetAsync failed\n"); return; }
    void* args[] = {&p};
#ifdef PLAIN_LAUNCH
    (void)args; hipLaunchKernelGGL(hymba_fwd, dim3(grid), dim3(512), LDS_BYTES, stream, p); hipError_t e = hipPeekAtLastError();
#else
    hipError_t e = hipLaunchCooperativeKernel((const void*)hymba_fwd, dim3(grid), dim3(512), args, LDS_BYTES, stream);
#endif
    if (e != hipSuccess) fprintf(stderr, "cooperative launch failed: %s (grid %d)\n", hipGetErrorString(e), grid);
}
```

```cpp
#include <hip/hip_runtime.h>
#include <hip/hip_cooperative_groups.h>
#include <cstdio>
#include <cstdint>
namespace cg = cooperative_groups;

#define DI __device__ __forceinline__
#define LAS __attribute__((address_space(3)))
typedef unsigned short bf16_t;
typedef short bf16x8 __attribute__((ext_vector_type(8)));
typedef short s16x4 __attribute__((ext_vector_type(4)));
typedef short v4i16_t __attribute__((ext_vector_type(4)));
typedef float f32x2 __attribute__((ext_vector_type(2)));
typedef float f32x4 __attribute__((ext_vector_type(4)));
typedef float f32x16 __attribute__((ext_vector_type(16)));
typedef unsigned u32x2 __attribute__((ext_vector_type(2)));
typedef unsigned u32x4 __attribute__((ext_vector_type(4)));
typedef __bf16 bf16x2_t __attribute__((ext_vector_type(2)));

constexpr int M_TOK = 16384, DM = 1024, NPROJ = 4096, SEQ = 8192, NMETA = 16, NCHUNK = 64;
constexpr float EPS = 1e-6f;

constexpr size_t MiB = 1u << 20;
constexpr size_t WS_RSTD = 64 * 1024, WS_MP = 128 * 1024, WS_PART = 1 * MiB, WS_WIN = 2 * MiB, WS_WOUT = 10 * MiB, WS_XB = 16 * MiB;
constexpr size_t WS_U = 48 * MiB, WS_G = 64 * MiB, WS_QS = 80 * MiB, WS_KZ = 96 * MiB, WS_V = 112 * MiB, WS_SRG = 128 * MiB;
constexpr size_t WS_UPD = 144 * MiB, WS_TT = 176 * MiB, WS_MIX = 194 * MiB, WS_END = 226 * MiB;
constexpr int LDS_BYTES = 147456;

DI unsigned pk2(float lo, float hi) { f32x2 v = {lo, hi}; bf16x2_t b = __builtin_convertvector(v, bf16x2_t); return __builtin_bit_cast(unsigned, b); }
DI float bf_lo(unsigned u) { return __uint_as_float(u << 16); }
DI float bf_hi(unsigned u) { return __uint_as_float(u & 0xffff0000u); }
DI float silu_f(float x) { return x * __builtin_amdgcn_rcpf(1.f + __expf(-x)); }
DI float wave_sum(float v) {
#pragma unroll
    for (int o = 1; o < 64; o <<= 1) v += __shfl_xor(v, o);
    return v;
}
DI void sincos_rr(float ang, float& s, float& c) {
    const float k = rintf(ang * 0.15915494309189535f);
    float r = fmaf(-k, 6.2831854820251465f, ang);
    r = fmaf(-k, -1.7484555e-7f, r);
    const float rev = r * 0.15915494309189535f;
    s = __builtin_amdgcn_sinf(rev); c = __builtin_amdgcn_cosf(rev);
}
DI int opaque_tid() { int t = threadIdx.x; asm volatile("" : "+v"(t)); return t; }
DI float rope_freq(int d) { return exp2f(-(float)d * (13.287712379549449f / 64.f)); }
DI float log2_gamma(int h) { return log2f(1.f - exp2f(-5.f - (float)h)); }

namespace pg8 {
constexpr int BM = 256, BK = 64, HALF = 128, HTB = HALF * BK * 2, STAGE_BYTES = 8 * HTB, NXCD = 8, WGM = 8;
DI int lds_byte(int r, int c) { const int st = (r >> 4) * 2 + (c >> 5), rr = r & 15, cc = c & 31, ob = rr * 64 + cc * 2; return st * 1024 + (ob ^ (((ob >> 9) & 1) << 5)); }
DI void stage_rc(int b, int& R, int& C) { const int st = b / 1024, sb = b % 1024, swz = sb ^ (((sb >> 9) & 1) << 5); R = (st >> 1) * 16 + swz / 64; C = (st & 1) * 32 + (swz % 64) / 2; }
DI int perm32(int rho) { const int n = rho >> 4, i = rho & 15; return 8 * (i >> 2) + 4 * n + (i & 3); }
struct Unit { int pm, pn; };
struct Gemm { const bf16_t* A; const bf16_t* Bt; int M, N, K; };
struct StaticOrder {
    int nM, nN, nwg, G, c;
    DI void init(int M, int N, int G_, int c_) { nM = M / BM; nN = N / BM; nwg = nM * nN; G = G_; c = c_; }
    DI bool next(int i, Unit& u) const {
        const long L = (long)i * G + c; if (L >= nwg) return false;
        int wgid = (int)L; { const int q = nwg / NXCD, r = nwg % NXCD, xcd = wgid % NXCD, off = wgid / NXCD; wgid = (xcd < r ? xcd * (q + 1) : r * (q + 1) + (xcd - r) * q) + off; }
        const int nig = WGM * nN, gid = wgid / nig, fm = gid * WGM, gsz = (nM - fm) < WGM ? (nM - fm) : WGM;
        u.pm = fm + ((wgid % nig) % gsz); u.pn = (wgid % nig) / gsz; return true;
    }
    DI void a_ready(const Unit&) const {}
    DI void done(const Unit&) const {}
};

template <class Epi, class Sched, bool ALIGN_EPI = false, bool SP2 = false>
DI void gemm_phase(LAS unsigned char* lds, const Gemm g, const Sched& S, const Epi& E) {
    const int tid = opaque_tid(), wid = __builtin_amdgcn_readfirstlane(tid >> 6), lane = tid & 63, wr = wid >> 2, wc = wid & 3, fr = lane & 15, fq = lane >> 4;
    const int K = g.K, nt = K / BK;
    unsigned voffA[2], voffB[2];
#pragma unroll
    for (int i = 0; i < 2; ++i) { int R, C; stage_rc(tid * 16 + i * 8192, R, C); const int Rb = Epi::PERM ? ((R & ~31) + perm32(R & 31)) : R;
        voffA[i] = (unsigned)(R * K + C) * 2u; voffB[i] = (unsigned)(Rb * K + C) * 2u; }
    const size_t kstep = (size_t)(BK * 2);
    const size_t hstep = (size_t)HALF * K * 2;
    const size_t tstep = 2 * hstep;
    const unsigned ldsw = (unsigned)wid * 1024u;
    const int aoff = lds_byte(wr * 64 + fr, fq * 8), boff = lds_byte(wc * 32 + fr, fq * 8);
#define PG8_SA(b, h) (((b) * 2 + (h)) * HTB)
#define PG8_SB(b, h) ((4 + (b) * 2 + (h)) * HTB)
#define PG8_STAGE(bufoff, gbase, voff) do { _Pragma("unroll") for (int _i = 0; _i < 2; ++_i) \
        __builtin_amdgcn_global_load_lds((const unsigned*)((const char*)(gbase) + (voff)[_i]), (LAS unsigned*)(lds + (bufoff) + ldsw + _i * 8192), 16, 0, 0); } while (0)
#define PG8_LDA(dst, b, h) do { _Pragma("unroll") for (int m = 0; m < 4; ++m) _Pragma("unroll") for (int k = 0; k < 2; ++k) dst[m][k] = *(const LAS bf16x8*)(lds + PG8_SA(b, h) + aoff + m * 2048 + k * 1024); } while (0)
#define PG8_LDB(dst, b, h) do { _Pragma("unroll") for (int n = 0; n < 2; ++n) _Pragma("unroll") for (int k = 0; k < 2; ++k) dst[n][k] = *(const LAS bf16x8*)(lds + PG8_SB(b, h) + boff + n * 2048 + k * 1024); } while (0)
#define PG8_MMA(ai, bj, At, Bt) do { __builtin_amdgcn_s_setprio(1); _Pragma("unroll") for (int m = 0; m < 4; ++m) _Pragma("unroll") for (int n = 0; n < 2; ++n) _Pragma("unroll") for (int k = 0; k < 2; ++k) \
        acc[ai][bj][m][n] = __builtin_amdgcn_mfma_f32_16x16x32_bf16(Bt[n][k], At[m][k], acc[ai][bj][m][n], 0, 0, 0); __builtin_amdgcn_s_setprio(0); } while (0)
#define PG8_WAIT_V(n) asm volatile("s_waitcnt vmcnt(" #n ")" ::: "memory")
#define PG8_WAIT_L(n) asm volatile("s_waitcnt lgkmcnt(" #n ")" ::: "memory")
#define PG8_BAR __builtin_amdgcn_s_barrier()
#define PG8_SCHED __builtin_amdgcn_sched_barrier(0)
    Unit cur, nxt; int ui = 0;
    if (!S.next(0, cur)) return;
    f32x4 acc[2][2][4][2];
#pragma unroll
    for (int a = 0; a < 2; ++a)
#pragma unroll
        for (int b = 0; b < 2; ++b)
#pragma unroll
            for (int m = 0; m < 4; ++m)
#pragma unroll
                for (int n = 0; n < 2; ++n) acc[a][b][m][n] = (f32x4){0.f, 0.f, 0.f, 0.f};
    bf16x8 At[4][2], B0[2][2], B1[2][2];
    const char* cA = (const char*)g.A + (size_t)cur.pm * tstep; const char* cB = (const char*)g.Bt + (size_t)cur.pn * tstep;
    S.a_ready(cur);
    if constexpr (SP2) {
        PG8_STAGE(PG8_SB(0, 0), cB, voffB); PG8_STAGE(PG8_SB(0, 1), cB + hstep, voffB); PG8_STAGE(PG8_SA(0, 0), cA, voffA); PG8_STAGE(PG8_SA(0, 1), cA + hstep, voffA);
        if (wr == 1) PG8_BAR;
        PG8_WAIT_V(2); PG8_BAR;
        PG8_STAGE(PG8_SB(1, 0), cB + kstep, voffB); PG8_STAGE(PG8_SA(1, 0), cA + kstep, voffA); PG8_STAGE(PG8_SB(1, 1), cB + hstep + kstep, voffB);
        PG8_WAIT_V(6); PG8_BAR;
    } else {
        PG8_STAGE(PG8_SB(0, 0), cB, voffB); PG8_STAGE(PG8_SA(0, 0), cA, voffA); PG8_STAGE(PG8_SB(0, 1), cB + hstep, voffB); PG8_STAGE(PG8_SA(0, 1), cA + hstep, voffA);
        if (wr == 1) PG8_BAR;
        PG8_WAIT_V(4); PG8_BAR;
        PG8_STAGE(PG8_SB(1, 0), cB + kstep, voffB); PG8_STAGE(PG8_SA(1, 0), cA + kstep, voffA); PG8_STAGE(PG8_SB(1, 1), cB + hstep + kstep, voffB);
        PG8_WAIT_V(6); PG8_BAR;
    }
    for (;;) {
        const bool has_next = S.next(ui + 1, nxt);
        const char* nA = has_next ? (const char*)g.A + (size_t)nxt.pm * tstep : cA; const char* nB = has_next ? (const char*)g.Bt + (size_t)nxt.pn * tstep : cB;
        for (int t = 0; t < nt; t += 2) {
            const bool last = (t == nt - 2);
            const char* a1 = cA + (size_t)(t + 1) * kstep;
            const char* a2 = last ? nA : cA + (size_t)(t + 2) * kstep; const char* b2 = last ? nB : cB + (size_t)(t + 2) * kstep;
            const char* a3 = a2 + kstep; const char* b3 = b2 + kstep;
            if (last && has_next) S.a_ready(nxt);
            if constexpr (SP2) {
            PG8_LDB(B0, 0, 0); PG8_LDB(B1, 0, 1); PG8_SCHED; PG8_LDA(At, 0, 0); PG8_STAGE(PG8_SA(1, 1), a1 + hstep, voffA);
            PG8_WAIT_V(8); PG8_WAIT_L(0); PG8_BAR; PG8_MMA(0, 0, At, B0); PG8_MMA(0, 1, At, B1); PG8_BAR; PG8_SCHED;
            PG8_LDA(At, 0, 1); PG8_STAGE(PG8_SB(0, 0), b2, voffB); PG8_STAGE(PG8_SB(0, 1), b2 + hstep, voffB); PG8_STAGE(PG8_SA(0, 0), a2, voffA);
            PG8_WAIT_V(8); PG8_WAIT_L(0); PG8_BAR; PG8_MMA(1, 0, At, B0); PG8_MMA(1, 1, At, B1); PG8_BAR; PG8_SCHED;
            PG8_LDB(B0, 1, 0); PG8_LDB(B1, 1, 1); PG8_SCHED; PG8_LDA(At, 1, 0); PG8_STAGE(PG8_SA(0, 1), a2 + hstep, voffA);
            PG8_WAIT_V(8); PG8_WAIT_L(0); PG8_BAR; PG8_MMA(0, 0, At, B0); PG8_MMA(0, 1, At, B1); PG8_BAR; PG8_SCHED;
            PG8_LDA(At, 1, 1); PG8_STAGE(PG8_SB(1, 0), b3, voffB); PG8_STAGE(PG8_SB(1, 1), b3 + hstep, voffB); PG8_STAGE(PG8_SA(1, 0), a3, voffA);
            PG8_WAIT_V(8); PG8_WAIT_L(0); PG8_BAR; PG8_MMA(1, 0, At, B0); PG8_MMA(1, 1, At, B1); PG8_BAR; PG8_SCHED;
            } else {
            PG8_LDB(B0, 0, 0); PG8_SCHED; PG8_LDA(At, 0, 0); PG8_STAGE(PG8_SA(1, 1), a1 + hstep, voffA);
            PG8_WAIT_L(8); PG8_BAR; PG8_WAIT_L(0); PG8_MMA(0, 0, At, B0); PG8_BAR; PG8_SCHED;
            PG8_LDB(B1, 0, 1); PG8_STAGE(PG8_SB(0, 0), b2, voffB);
            PG8_BAR; PG8_WAIT_L(0); PG8_MMA(0, 1, At, B1); PG8_BAR;
            PG8_LDA(At, 0, 1); PG8_STAGE(PG8_SA(0, 0), a2, voffA);
            PG8_BAR; PG8_WAIT_L(0); PG8_MMA(1, 0, At, B0); PG8_BAR; PG8_SCHED;
            PG8_STAGE(PG8_SB(0, 1), b2 + hstep, voffB);
            PG8_WAIT_V(6); PG8_BAR; PG8_MMA(1, 1, At, B1); PG8_BAR;
            PG8_LDB(B0, 1, 0); PG8_SCHED; PG8_LDA(At, 1, 0); PG8_STAGE(PG8_SA(0, 1), a2 + hstep, voffA);
            PG8_WAIT_L(8); PG8_BAR; PG8_WAIT_L(0); PG8_MMA(0, 0, At, B0); PG8_BAR; PG8_SCHED;
            PG8_LDB(B1, 1, 1); PG8_STAGE(PG8_SB(1, 0), b3, voffB);
            PG8_BAR; PG8_WAIT_L(0); PG8_MMA(0, 1, At, B1); PG8_BAR;
            PG8_LDA(At, 1, 1); PG8_STAGE(PG8_SA(1, 0), a3, voffA);
            PG8_BAR; PG8_WAIT_L(0); PG8_MMA(1, 0, At, B0); PG8_BAR; PG8_SCHED;
            PG8_STAGE(PG8_SB(1, 1), b3 + hstep, voffB);
            PG8_WAIT_V(6); PG8_BAR; PG8_MMA(1, 1, At, B1); PG8_BAR;
            }
        }
        if constexpr (ALIGN_EPI) { if (wr == 0) PG8_BAR; }
        if constexpr (!Epi::AFTER_DRAIN) { E(acc, cur, wr, wc, fr, fq); S.done(cur); }
        if (!has_next) break;
#pragma unroll
        for (int a = 0; a < 2; ++a)
#pragma unroll
            for (int b = 0; b < 2; ++b)
#pragma unroll
                for (int m = 0; m < 4; ++m)
#pragma unroll
                    for (int n = 0; n < 2; ++n) acc[a][b][m][n] = (f32x4){0.f, 0.f, 0.f, 0.f};
        cur = nxt; cA = nA; cB = nB; ++ui;
        if constexpr (ALIGN_EPI) { if (wr == 1) PG8_BAR; }
    }
    PG8_WAIT_V(0);
    if constexpr (!ALIGN_EPI) { if (wr == 0) PG8_BAR; }
    PG8_BAR;
    if constexpr (Epi::AFTER_DRAIN) { E.fused(acc, cur, wr, wc, fr, fq, lds, wid, lane); S.done(cur); }
#undef PG8_SA
#undef PG8_SB
#undef PG8_STAGE
#undef PG8_LDA
#undef PG8_LDB
#undef PG8_MMA
#undef PG8_WAIT_V
#undef PG8_WAIT_L
#undef PG8_BAR
#undef PG8_SCHED
}
}


#define XB_TMO      128
#define XB_XCNT(j)  (256  + 64 * (j))
#define XB_XSUB(j)  (1280 + 64 * (j))
#define XB_XGEN(j)  (2304 + 64 * (j))
#define XB_TOP      3328
#define XB_TOPGEN   3392
#define XCD_BAR_WORDS 3456
#define XB_SPIN_CAP (1u << 18)
constexpr int CW_PANEL = 4096, CW_C2 = 8192, CW_C3 = 8192 + 512;
constexpr size_t CTL_ZERO_BYTES = 40960;
DI unsigned xb_ld(unsigned* p)              { return __hip_atomic_load(p, __ATOMIC_RELAXED, __HIP_MEMORY_SCOPE_AGENT); }
DI unsigned xb_add(unsigned* p, unsigned v) { return __hip_atomic_fetch_add(p, v, __ATOMIC_RELAXED, __HIP_MEMORY_SCOPE_AGENT); }
DI unsigned xb_xcc_id() { return (unsigned)__builtin_amdgcn_s_getreg((3 << 11) | 20) & 0xFu; }
#define XB_SPIN(cond, bar) do { unsigned _sp = 0; while (cond) { __builtin_amdgcn_s_sleep(1); \
    if ((++_sp & 255u) == 0u) { if (xb_ld(&(bar)[XB_TMO])) break; if (_sp > XB_SPIN_CAP) { atomicAdd(&(bar)[XB_TMO], 1u); break; } } } } while (0)
struct XcdBarrier { unsigned* bar; unsigned x; volatile LAS unsigned* st; };
DI XcdBarrier xcd_barrier_post(unsigned* bar, volatile LAS unsigned* st) {
    XcdBarrier b; b.bar = bar; b.x = xb_xcc_id(); b.st = st;
    if (threadIdx.x == 0) (void)xb_add(&bar[XB_XCNT(b.x)], 1u);
    return b;
}
DI void xcd_barrier_complete(unsigned* bar, unsigned x, unsigned& nloc, unsigned& nx) {
    const unsigned G = gridDim.x * gridDim.y * gridDim.z;
    unsigned sum, cnt, mine, sp = 0u;
    for (;;) {
        sum = 0u; cnt = 0u; mine = 0u;
#pragma unroll
        for (unsigned j = 0; j < 16; ++j) { const unsigned c = xb_ld(&bar[XB_XCNT(j)]); sum += c; cnt += (c > 0u) ? 1u : 0u; mine = (j == x) ? c : mine; }
        if (sum == G) break;
        __builtin_amdgcn_s_sleep(1);
        if ((++sp & 255u) == 0u) { if (xb_ld(&bar[XB_TMO])) break; if (sp > XB_SPIN_CAP) { atomicAdd(&bar[XB_TMO], 1u); break; } }
    }
    nloc = mine > 0u ? mine : 1u; nx = cnt > 0u ? cnt : 1u;
}
DI void xcd_barrier(const XcdBarrier& b) {
    asm volatile("s_waitcnt vmcnt(0)" ::: "memory");
    __syncthreads();
    if (threadIdx.x == 0) {
        unsigned* bar = b.bar;
        __builtin_amdgcn_s_waitcnt(0);
        unsigned nloc = b.st[0], nx = b.st[1];
        if (nloc == 0u) { xcd_barrier_complete(bar, b.x, nloc, nx); b.st[0] = nloc; b.st[1] = nx; }
        const unsigned old = xb_add(&bar[XB_XSUB(b.x)], 1u);
        const unsigned gen = old / nloc;
        if (old + 1u == (gen + 1u) * nloc) {
            __builtin_amdgcn_fence(__ATOMIC_RELEASE, "agent");
            asm volatile("s_waitcnt vmcnt(0)" ::: "memory");
            const unsigned og = xb_add(&bar[XB_TOP], 1u);
            const unsigned tg = og / nx;
            if (og + 1u == (tg + 1u) * nx) xb_add(&bar[XB_TOPGEN], 1u);
            else XB_SPIN(xb_ld(&bar[XB_TOPGEN]) == tg, bar);
            __builtin_amdgcn_fence(__ATOMIC_ACQUIRE, "agent");
            xb_add(&bar[XB_XGEN(b.x)], 1u);
            asm volatile("s_waitcnt vmcnt(0)" ::: "memory");
        } else {
            XB_SPIN(xb_ld(&bar[XB_XGEN(b.x)]) == gen, bar);
            __builtin_amdgcn_fence(__ATOMIC_ACQUIRE, "agent");
            asm volatile("s_waitcnt vmcnt(0)" ::: "memory");
        }
    }
    __syncthreads();
}


DI u32x4 pack8(f32x4 a, f32x4 b) { u32x4 w; w.x = pk2(a[0], a[1]); w.y = pk2(a[2], a[3]); w.z = pk2(b[0], b[1]); w.w = pk2(b[2], b[3]); return w; }
DI f32x4 silu4(f32x4 v) { f32x4 o; o[0] = silu_f(v[0]); o[1] = silu_f(v[1]); o[2] = silu_f(v[2]); o[3] = silu_f(v[3]); return o; }

struct EpiProj {
    static constexpr bool PERM = true, AFTER_DRAIN = false;
    const float* rstd; bf16_t *U, *G, *QS, *KZ, *V, *SRG;
    DI void operator()(const f32x4 (&acc)[2][2][4][2], const pg8::Unit& u, int wr, int wc, int fr, int fq) const {
        const int pn = u.pn;
        const int row0 = u.pm * 256 + wr * 64 + fr;
        const int cw = wc * 32 + 8 * fq;
        if (pn < 8) {
            bf16_t* dst = (wc < 2 ? U : G) + pn * 64 + (cw & 63);
#pragma unroll
            for (int ai = 0; ai < 2; ++ai)
#pragma unroll
                for (int m = 0; m < 4; ++m) {
                    const int row = row0 + ai * 128 + m * 16; const float rs = rstd[row];
                    f32x4 a0 = acc[ai][0][m][0] * rs, a1 = acc[ai][0][m][1] * rs, b0 = acc[ai][1][m][0] * rs, b1 = acc[ai][1][m][1] * rs;
                    if (wc >= 2) { b0 = silu4(b0); b1 = silu4(b1); }
                    *(u32x4*)(dst + (size_t)row * 512) = pack8(a0 * b0, a1 * b1);
                }
        } else if (pn < 12) {
            const bool isq = pn < 10;
            const int head = 2 * ((pn - 8) & 1) + (wc >> 1);
            const int d0 = cw & 63;
            float fr8[8];
#pragma unroll
            for (int j = 0; j < 8; ++j) fr8[j] = rope_freq(d0 + j);
            const float lg = log2_gamma(head);
            bf16_t* dst = (isq ? QS : KZ) + head * 128 + d0;
#pragma unroll
            for (int ai = 0; ai < 2; ++ai)
#pragma unroll
                for (int m = 0; m < 4; ++m) {
                    const int row = row0 + ai * 128 + m * 16; const float rs = rstd[row];
                    const int t = row & (SEQ - 1), tl = t & 127; const float pos = (float)(NMETA + t);
                    const float sc = rs * (isq ? 0.08838834764831845f * exp2f((float)(tl - 127) * lg) : exp2f((float)(127 - tl) * lg));
                    f32x4 r1[2], r2[2];
#pragma unroll
                    for (int j = 0; j < 8; ++j) {
                        float s, c; sincos_rr(pos * fr8[j], s, c);
                        const float x1 = acc[ai][0][m][j >> 2][j & 3], x2 = acc[ai][1][m][j >> 2][j & 3];
                        r1[j >> 2][j & 3] = (x1 * c - x2 * s) * sc; r2[j >> 2][j & 3] = (x1 * s + x2 * c) * sc;
                    }
                    *(u32x4*)(dst + (size_t)row * 512) = pack8(r1[0], r1[1]);
                    *(u32x4*)(dst + (size_t)row * 512 + 64) = pack8(r2[0], r2[1]);
                }
        } else {
            const bool isv = pn < 14;
            bf16_t* dst = (isv ? V : SRG) + ((pn - 12) & 1) * 256 + cw;
#pragma unroll
            for (int ai = 0; ai < 2; ++ai)
#pragma unroll
                for (int m = 0; m < 4; ++m) {
                    const int row = row0 + ai * 128 + m * 16; const float rs = rstd[row];
#pragma unroll
                    for (int bj = 0; bj < 2; ++bj) {
                        f32x4 a0 = acc[ai][bj][m][0] * rs, a1 = acc[ai][bj][m][1] * rs;
                        if (!isv) { a0 = silu4(a0); a1 = silu4(a1); }
                        *(u32x4*)(dst + (size_t)row * 512 + bj * 128) = pack8(a0, a1);
                    }
                }
        }
    }
};

struct EpiOut {
    static constexpr bool PERM = true, AFTER_DRAIN = false;
    const float* x; float* out; float* part;
    DI void operator()(const f32x4 (&acc)[2][2][4][2], const pg8::Unit& u, int wr, int wc, int fr, int fq) const {
        const int row0 = u.pm * 256 + wr * 64 + fr, col0 = u.pn * 256 + wc * 32 + 8 * fq;
#pragma unroll
        for (int ai = 0; ai < 2; ++ai)
#pragma unroll
            for (int m = 0; m < 4; ++m) {
                const int row = row0 + ai * 128 + m * 16; float ss = 0.f;
#pragma unroll
                for (int bj = 0; bj < 2; ++bj) {
                    const size_t o = (size_t)row * DM + col0 + bj * 128;
                    const f32x4 y0 = acc[ai][bj][m][0] + *(const f32x4*)(x + o), y1 = acc[ai][bj][m][1] + *(const f32x4*)(x + o + 4);
                    ss += (y0[0] * y0[0] + y0[1] * y0[1]) + (y0[2] * y0[2] + y0[3] * y0[3]) + (y1[0] * y1[0] + y1[1] * y1[1]) + (y1[2] * y1[2] + y1[3] * y1[3]);
                    *(f32x4*)(out + o) = y0; *(f32x4*)(out + o + 4) = y1;
                }
                ss += __shfl_xor(ss, 16); ss += __shfl_xor(ss, 32);
                if (fq == 0) part[(size_t)(u.pn * 4 + wc) * M_TOK + row] = ss;
            }
    }
};


struct EpiOutNorm {
    static constexpr bool PERM = true, AFTER_DRAIN = true;
    const float* x; float* out; const float* gf; float* xch; unsigned* ctl;
    DI void fused(f32x4 (&acc)[2][2][4][2], const pg8::Unit& u, int wr, int wc, int fr, int fq, LAS unsigned char* lds, int wid, int lane) const {
        LAS float* R = (LAS float*)(lds + 131072 + 1024);
        f32x4 y[2][16];
        float* slot = xch + (size_t)(u.pm * 4) * 256;
#pragma unroll
        for (int ai = 0; ai < 2; ++ai) {
            if (ai) __syncthreads();
#pragma unroll
            for (int m = 0; m < 4; ++m)
#pragma unroll
                for (int bj = 0; bj < 2; ++bj)
#pragma unroll
                    for (int n = 0; n < 2; ++n) { const int r = wr * 64 + m * 16 + fr, ch = 32 * bj + 8 * wc + 2 * fq + n;
                        *(LAS f32x4*)(lds + r * 1024 + ((ch ^ (r & 15)) << 4)) = acc[ai][bj][m][n]; }
            __syncthreads();
            f32x4 xv[16];
#pragma unroll
            for (int k = 0; k < 16; ++k) { const int r = wid + 8 * k; xv[k] = __builtin_nontemporal_load((const f32x4*)(x + (size_t)(u.pm * 256 + ai * 128 + r) * DM + u.pn * 256) + lane); }
#pragma unroll
            for (int k = 0; k < 16; ++k) { const int r = wid + 8 * k;
                const f32x4 v = *(const LAS f32x4*)(lds + r * 1024 + ((lane ^ (r & 15)) << 4)) + xv[k];
                y[ai][k] = v;
                const float ss = wave_sum((v[0] * v[0] + v[1] * v[1]) + (v[2] * v[2] + v[3] * v[3]));
                if (lane == 0) __hip_atomic_store(slot + u.pn * 256 + ai * 128 + r, ss, __ATOMIC_RELAXED, __HIP_MEMORY_SCOPE_AGENT); }
        }
        const int tid = wid * 64 + lane;
        asm volatile("s_waitcnt vmcnt(0)" ::: "memory");
        __syncthreads();
        if (tid == 0) {
            unsigned* cnt = ctl + CW_PANEL + 64 * u.pm;
            __builtin_amdgcn_fence(__ATOMIC_RELEASE, "agent");
            asm volatile("s_waitcnt vmcnt(0)" ::: "memory");
            xb_add(cnt, 1u);
            unsigned sp = 0u;
            while (xb_ld(cnt) < 4u) { __builtin_amdgcn_s_sleep(1); if (++sp > (1u << 22)) break; }
            __builtin_amdgcn_fence(__ATOMIC_ACQUIRE, "agent");
            asm volatile("s_waitcnt vmcnt(0)" ::: "memory");
        }
        __syncthreads();
        if (tid < 256) { float s = 0.f;
#pragma unroll
            for (int q = 0; q < 4; ++q) s += __hip_atomic_load(slot + q * 256 + tid, __ATOMIC_RELAXED, __HIP_MEMORY_SCOPE_AGENT);
            R[tid] = 1.f / sqrtf(s * (1.f / 1024.f) + EPS); }
        __syncthreads();
        const f32x4 gv = *((const f32x4*)(gf + u.pn * 256) + lane);
#pragma unroll
        for (int ai = 0; ai < 2; ++ai)
#pragma unroll
            for (int k = 0; k < 16; ++k) { const int r = ai * 128 + wid + 8 * k; const float rs = R[r];
                __builtin_nontemporal_store(y[ai][k] * rs * gv, (f32x4*)(out + (size_t)(u.pm * 256 + r) * DM + u.pn * 256) + lane); }
    }
};

DI unsigned off_b(unsigned row, unsigned ch) { return 256u * row + 16u * (ch ^ (((row & 3) << 2) | ((row >> 2) & 3))); }
DI bf16x8 row_frag(const unsigned char* img, int rb, int s, int lane) {
    return *(const bf16x8*)(img + 8192 * rb + off_b(lane & 31, 2 * s + (lane >> 5)));
}
DI s16x4 tr_read(const unsigned char* p) { return __builtin_bit_cast(s16x4, __builtin_amdgcn_ds_read_tr16_b64_v4i16((LAS v4i16_t*)(const LAS unsigned char*)p)); }
template <bool PERMK> DI bf16x8 tr_frag(const unsigned char* img, int c, int rbase, int lane) {
    const int h = lane >> 5, blk = (lane >> 4) & 1, q = (lane & 15) >> 2, p = lane & 3;
    const int r0 = rbase + (PERMK ? 4 * h : 8 * h) + q, r1 = r0 + (PERMK ? 8 : 4);
    const unsigned ch = 4 * c + 2 * blk + (p >> 1), bo = 8 * (p & 1);
    const s16x4 lo = tr_read(img + off_b(r0, ch) + bo), hi = tr_read(img + off_b(r1, ch) + bo);
    return __builtin_shufflevector(lo, hi, 0, 1, 2, 3, 4, 5, 6, 7);
}
DI void load_tile(unsigned char* img, const bf16_t* src, int ld, int tid) {
#pragma unroll
    for (int i = 0; i < 4; ++i) { const int idx = tid + 512 * i, row = idx >> 4, ch = idx & 15;
        *(u32x4*)(img + off_b(row, ch)) = *(const u32x4*)(src + (size_t)row * ld + ch * 8); }
}
DI int crow(int reg, int h) { return (reg & 3) + 8 * (reg >> 2) + 4 * h; }
#define MFMA32(a, b, c) __builtin_amdgcn_mfma_f32_32x32x16_bf16((a), (b), (c), 0, 0, 0)

struct Params { const float *x, *meta, *g1, *w_in, *conv_w, *rg, *w_out, *gf; float* out; unsigned char* ws; };


DI int dest_pos(int n) {
    const int type = n >> 9, r = n & 511;
    if (type < 4) return (r >> 6) * 256 + type * 64 + (r & 63);
    if (type < 6) { const int h = r >> 7, d = r & 127; return (8 + (type - 4) * 2 + (h >> 1)) * 256 + (d >> 6) * 128 + (h & 1) * 64 + (d & 63); }
    return n;
}

DI void p0_transpose_item(const float* W, const float* gain, int K, int N, bf16_t* WT, bool perm, float* scr, int item, int lane) {
    const int nblk = N / 32, kb = item / nblk, nb = item % nblk, k0 = 64 * kb, n0 = 32 * nb;
#pragma unroll
    for (int i = 0; i < 32; ++i) { const int kk = 2 * i + (lane >> 5); float w = W[(size_t)(k0 + kk) * N + n0 + (lane & 31)]; if (gain) w *= gain[k0 + kk]; scr[kk * 33 + (lane & 31)] = w; }
    __builtin_amdgcn_s_waitcnt(0xc07f); asm volatile("" ::: "memory");
    const int c = lane & 7;
    const int nd0 = perm ? dest_pos(n0) : n0;
#pragma unroll
    for (int j = 0; j < 4; ++j) { const int n = (lane >> 3) + 8 * j; const float* s = scr + (8 * c) * 33 + n;
        u32x4 o; o.x = pk2(s[0 * 33], s[1 * 33]); o.y = pk2(s[2 * 33], s[3 * 33]); o.z = pk2(s[4 * 33], s[5 * 33]); o.w = pk2(s[6 * 33], s[7 * 33]);
        *(u32x4*)(WT + (size_t)(nd0 + n) * K + k0 + 8 * c) = o; }
    __builtin_amdgcn_s_waitcnt(0xc07f); asm volatile("" ::: "memory");
}

DI void phase0(const Params& p, unsigned char* lds) {
    const int tid = opaque_tid(), lane = tid & 63, wave = tid >> 6;
    unsigned char* ws = p.ws;
    float* rstd = (float*)(ws + WS_RSTD); float* MP = (float*)(ws + WS_MP);
    bf16_t* XB = (bf16_t*)(ws + WS_XB); bf16_t* WIN = (bf16_t*)(ws + WS_WIN); bf16_t* WOUT = (bf16_t*)(ws + WS_WOUT);
    {
        float* metaL = (float*)lds; float* red = (float*)(lds + 65536); float* rsL = (float*)(lds + 98304);
        for (int i = tid; i < 4096; i += 512) ((f32x4*)metaL)[i] = ((const f32x4*)p.meta)[i];
        __syncthreads();
#pragma unroll
        for (int rr = 0; rr < 2; ++rr) { const int m = 2 * wave + rr; float s = 0.f;
#pragma unroll
            for (int i = 0; i < 16; ++i) { const float v = metaL[m * 1024 + lane + 64 * i]; s += v * v; }
            s = wave_sum(s); if (lane == 0) rsL[m] = 1.f / sqrtf(s * (1.f / 1024.f) + EPS); }
        for (int cgp = blockIdx.x; cgp < 256; cgp += gridDim.x) {
            const int col = tid & 15, ks = tid >> 4, n = cgp * 16 + col;
            float a[16], wv[32];
#pragma unroll
            for (int m = 0; m < 16; ++m) a[m] = 0.f;
#pragma unroll
            for (int kk = 0; kk < 32; ++kk) { const int k = kk * 32 + ks; wv[kk] = p.w_in[(size_t)k * NPROJ + n] * p.g1[k]; }
#pragma unroll
            for (int kk = 0; kk < 32; ++kk) { const int k = kk * 32 + ks;
#pragma unroll
                for (int m = 0; m < 16; ++m) a[m] = fmaf(metaL[m * 1024 + k], wv[kk], a[m]); }
#pragma unroll
            for (int m = 0; m < 16; ++m) red[(ks * 16 + m) * 16 + col] = a[m];
            __syncthreads();
            if (tid < 256) { const int m = tid >> 4, c = tid & 15; float s = 0.f;
#pragma unroll 8
                for (int k2 = 0; k2 < 32; ++k2) s += red[(k2 * 16 + m) * 16 + c];
                MP[m * NPROJ + cgp * 16 + c] = s * rsL[m]; }
            __syncthreads();
        }
    }
    __syncthreads();
    const int gw = blockIdx.x * 8 + wave, NGW = gridDim.x * 8;
    {
        float* scr = (float*)(lds + wave * 16384);
        constexpr int I_IN = (DM / 64) * (NPROJ / 32), I_OUT = (DM / 64) * (DM / 32);
        for (int it = gw; it < I_IN + I_OUT; it += NGW) {
            if (it < I_IN) p0_transpose_item(p.w_in, p.g1, DM, NPROJ, WIN, true, scr, it, lane);
            else p0_transpose_item(p.w_out, nullptr, DM, DM, WOUT, false, scr, it - I_IN, lane);
        }
    }
    for (int row = gw; row < M_TOK; row += 2 * NGW) {
        const int row2 = row + NGW;
        const f32x4* xr = (const f32x4*)(p.x + (size_t)row * DM) + lane; const f32x4* xr2 = (const f32x4*)(p.x + (size_t)row2 * DM) + lane;
        f32x4 v[4], v2[4]; float s = 0.f, s2 = 0.f;
#pragma unroll
        for (int j = 0; j < 4; ++j) { v[j] = __builtin_nontemporal_load(xr + 64 * j); v2[j] = __builtin_nontemporal_load(xr2 + 64 * j); }
#pragma unroll
        for (int j = 0; j < 4; ++j) { s += (v[j][0] * v[j][0] + v[j][1] * v[j][1]) + (v[j][2] * v[j][2] + v[j][3] * v[j][3]); s2 += (v2[j][0] * v2[j][0] + v2[j][1] * v2[j][1]) + (v2[j][2] * v2[j][2] + v2[j][3] * v2[j][3]); }
        s = wave_sum(s); s2 = wave_sum(s2);
        if (lane == 0) { rstd[row] = 1.f / sqrtf(s * (1.f / 1024.f) + EPS); rstd[row2] = 1.f / sqrtf(s2 * (1.f / 1024.f) + EPS); }
        u32x2* o = (u32x2*)(XB + (size_t)row * DM) + lane; u32x2* o2 = (u32x2*)(XB + (size_t)row2 * DM) + lane;
#pragma unroll
        for (int j = 0; j < 4; ++j) { u32x2 w; w.x = pk2(v[j][0], v[j][1]); w.y = pk2(v[j][2], v[j][3]); o[64 * j] = w; u32x2 w2; w2.x = pk2(v2[j][0], v2[j][1]); w2.y = pk2(v2[j][2], v2[j][3]); o2[64 * j] = w2; }
    }
}

template <bool FUSED> DI void phase2(const Params& p, unsigned char* lds, unsigned* ctl) {
    const int tid = opaque_tid(), lane = tid & 63, wave = tid >> 6, h5 = lane >> 5;
    const bf16_t* KZ = (const bf16_t*)(p.ws + WS_KZ); const bf16_t* V = (const bf16_t*)(p.ws + WS_V); float* UPD = (float*)(p.ws + WS_UPD);
    unsigned char* Kimg = lds; unsigned char* Vimg = lds + 32768;
    const int eb = wave & 3, dh = wave >> 2;
    for (int it = blockIdx.x; it < 8 * 63; it += gridDim.x) {
        const int bh = it / 63, n = 1 + it % 63, b = bh >> 2, h = bh & 3;
        const size_t row0 = (size_t)b * SEQ + (size_t)(n - 1) * 128;
        load_tile(Kimg, KZ + row0 * 512 + h * 128, 512, tid);
        load_tile(Vimg, V + row0 * 512 + h * 128, 512, tid);
        __syncthreads();
        f32x16 a0, a1;
#pragma unroll
        for (int i = 0; i < 16; ++i) { a0[i] = 0.f; a1[i] = 0.f; }
#pragma unroll
        for (int ks = 0; ks < 8; ++ks) {
            const bf16x8 av = tr_frag<false>(Vimg, eb, 16 * ks, lane);
            const bf16x8 b0 = tr_frag<false>(Kimg, 2 * dh, 16 * ks, lane), b1 = tr_frag<false>(Kimg, 2 * dh + 1, 16 * ks, lane);
            a0 = MFMA32(av, b0, a0); a1 = MFMA32(av, b1, a1);
        }
        float* dst = UPD + ((size_t)(bh * 64 + n) * 128 + 32 * eb) * 128 + 64 * dh + (lane & 31);
#pragma unroll
        for (int r = 0; r < 16; ++r) { const int e = crow(r, h5);
            if constexpr (FUSED) { __hip_atomic_store(dst + e * 128, a0[r], __ATOMIC_RELAXED, __HIP_MEMORY_SCOPE_AGENT); __hip_atomic_store(dst + e * 128 + 32, a1[r], __ATOMIC_RELAXED, __HIP_MEMORY_SCOPE_AGENT); }
            else { dst[e * 128] = a0[r]; dst[e * 128 + 32] = a1[r]; } }
        if constexpr (FUSED) asm volatile("s_waitcnt vmcnt(0)" ::: "memory");
        __syncthreads();
        if constexpr (FUSED) { if (tid == 0) xb_add(ctl + CW_C2 + 64 * bh, 1u); }
    }
}

template <bool FUSED> DI void phase3(const Params& p, unsigned* ctl) {
    const float* MP = (const float*)(p.ws + WS_MP); const float* UPD = (const float*)(p.ws + WS_UPD); bf16_t* TT = (bf16_t*)(p.ws + WS_TT);
    const int tid3 = opaque_tid();
    if constexpr (FUSED) {
        if (tid3 == 0) { unsigned* c2 = ctl + CW_C2 + 64 * (blockIdx.x >> 5); unsigned sp = 0u;
            while (xb_ld(c2) < 63u) { __builtin_amdgcn_s_sleep(1); if (++sp > (1u << 22)) break; }
            __builtin_amdgcn_fence(__ATOMIC_ACQUIRE, "agent"); asm volatile("s_waitcnt vmcnt(0)" ::: "memory"); }
        __syncthreads();
    }
    for (int gid = blockIdx.x * 512 + tid3; gid < 8 * 16384; gid += gridDim.x * 512) {
        const int bh = gid >> 14, idx = gid & 16383, e = idx >> 7, d = idx & 127, h = bh & 3;
        const float lg = log2_gamma(h), cdec = exp2f(128.f * lg);
        const int dl = d & 63; const float fq = rope_freq(dl);
        float s1 = 0.f;
#pragma unroll 4
        for (int m = 0; m < NMETA; ++m) {
            const float* mp = MP + m * NPROJ;
            const float x1 = mp[5 * 512 + h * 128 + dl], x2 = mp[5 * 512 + h * 128 + 64 + dl];
            float s, c; sincos_rr((float)m * fq, s, c);
            const float kr = (d < 64) ? (x1 * c - x2 * s) : (x1 * s + x2 * c);
            s1 = fmaf(mp[6 * 512 + h * 128 + e] * exp2f((float)(15 - m) * lg), kr, s1);
        }
        float T = cdec * s1;
        const float* up = UPD + (size_t)bh * 64 * 16384 + idx;
        bf16_t* tt = TT + (size_t)bh * 65 * 16384 + idx;
        if constexpr (FUSED) __hip_atomic_store(tt + 16384, (bf16_t)(pk2(T, 0.f) & 0xffffu), __ATOMIC_RELAXED, __HIP_MEMORY_SCOPE_AGENT); else tt[16384] = (bf16_t)(pk2(T, 0.f) & 0xffffu);
        float u[63];
#pragma unroll
        for (int i = 0; i < 63; ++i) u[i] = up[(size_t)(i + 1) * 16384];
#pragma unroll
        for (int i = 0; i < 63; ++i) { T = cdec * (T + u[i]); const bf16_t tv = (bf16_t)(pk2(T, 0.f) & 0xffffu);
            if constexpr (FUSED) __hip_atomic_store(tt + (size_t)(i + 2) * 16384, tv, __ATOMIC_RELAXED, __HIP_MEMORY_SCOPE_AGENT); else tt[(size_t)(i + 2) * 16384] = tv; }
    }
    if constexpr (FUSED) {
        asm volatile("s_waitcnt vmcnt(0)" ::: "memory");
        __syncthreads();
        if (tid3 == 0) xb_add(ctl + CW_C3 + 64 * (blockIdx.x >> 5), 1u);
    }
}

template <bool FUSED> DI void phase4(const Params& p, unsigned char* lds, unsigned* ctl) {
    const int tid = opaque_tid(), lane = tid & 63, wave = tid >> 6, h5 = lane >> 5;
    const bf16_t* QS = (const bf16_t*)(p.ws + WS_QS); const bf16_t* KZ = (const bf16_t*)(p.ws + WS_KZ); const bf16_t* V = (const bf16_t*)(p.ws + WS_V);
    const bf16_t* SRG = (const bf16_t*)(p.ws + WS_SRG); const bf16_t* TT = (const bf16_t*)(p.ws + WS_TT); bf16_t* MIX = (bf16_t*)(p.ws + WS_MIX);
    unsigned char* Qimg = lds; unsigned char* Kimg = lds + 32768; unsigned char* Vimg = lds + 65536; unsigned char* Timg = lds + 98304;
    float* OL = (float*)lds;
    const int ib = wave & 3, eh = wave >> 2;
    for (int it = blockIdx.x; it < 8 * 64; it += gridDim.x) {
        const int bh = it >> 6, n = 1 + (it & 63), b = bh >> 2, h = bh & 3;
        const size_t row0 = (size_t)b * SEQ + (size_t)(n - 1) * 128;
        load_tile(Qimg, QS + row0 * 512 + h * 128, 512, tid);
        load_tile(Kimg, KZ + row0 * 512 + h * 128, 512, tid);
        load_tile(Vimg, V + row0 * 512 + h * 128, 512, tid);
        if constexpr (!FUSED) load_tile(Timg, TT + ((size_t)bh * 65 + n) * 16384, 128, tid);
        __syncthreads();
        bf16x8 qf[8];
#pragma unroll
        for (int s = 0; s < 8; ++s) qf[s] = row_frag(Qimg, ib, s, lane);
        f32x16 O0, O1;
#pragma unroll
        for (int i = 0; i < 16; ++i) { O0[i] = 0.f; O1[i] = 0.f; }
#pragma unroll
        for (int jb = 0; jb < 4; ++jb) {
            if (jb <= ib) {
                f32x16 c;
#pragma unroll
                for (int i = 0; i < 16; ++i) c[i] = 0.f;
#pragma unroll
                for (int s = 0; s < 8; ++s) c = MFMA32(row_frag(Kimg, jb, s, lane), qf[s], c);
                if (jb == ib) {
#pragma unroll
                    for (int r = 0; r < 16; ++r) if (crow(r, h5) > (lane & 31)) c[r] = 0.f;
                }
#pragma unroll
                for (int s2 = 0; s2 < 2; ++s2) {
                    u32x4 pw; pw.x = pk2(c[8 * s2 + 0], c[8 * s2 + 1]); pw.y = pk2(c[8 * s2 + 2], c[8 * s2 + 3]); pw.z = pk2(c[8 * s2 + 4], c[8 * s2 + 5]); pw.w = pk2(c[8 * s2 + 6], c[8 * s2 + 7]);
                    const bf16x8 pa = __builtin_bit_cast(bf16x8, pw);
                    const bf16x8 v0 = tr_frag<true>(Vimg, 2 * eh, 32 * jb + 16 * s2, lane), v1 = tr_frag<true>(Vimg, 2 * eh + 1, 32 * jb + 16 * s2, lane);
                    O0 = MFMA32(pa, v0, O0); O1 = MFMA32(pa, v1, O1);
                }
            }
        }
        if constexpr (FUSED) {
            if (tid == 0) { unsigned* c3 = ctl + CW_C3 + 64 * bh; unsigned sp = 0u;
                while (xb_ld(c3) < 32u) { __builtin_amdgcn_s_sleep(1); if (++sp > (1u << 22)) break; }
                __builtin_amdgcn_fence(__ATOMIC_ACQUIRE, "agent"); asm volatile("s_waitcnt vmcnt(0)" ::: "memory"); }
            __syncthreads();
            load_tile(Timg, TT + ((size_t)bh * 65 + n) * 16384, 128, tid);
            __syncthreads();
        }
#pragma unroll
        for (int s = 0; s < 8; ++s) { O0 = MFMA32(qf[s], row_frag(Timg, 2 * eh, s, lane), O0); O1 = MFMA32(qf[s], row_frag(Timg, 2 * eh + 1, s, lane), O1); }
        __syncthreads();
        {
            float* o = OL + (32 * ib) * 132 + 64 * eh + (lane & 31);
#pragma unroll
            for (int r = 0; r < 16; ++r) { const int i = crow(r, h5); o[i * 132] = O0[r]; o[i * 132 + 32] = O1[r]; }
        }
        __syncthreads();
        {
            const int row = tid >> 2, part = tid & 3;
            const float* o = OL + row * 132 + 32 * part;
            f32x4 v[8]; float s = 0.f;
#pragma unroll
            for (int k = 0; k < 8; ++k) { v[k] = *(const f32x4*)(o + 4 * k); s += (v[k][0] + v[k][1]) + (v[k][2] + v[k][3]); }
            s += __shfl_xor(s, 1); s += __shfl_xor(s, 2);
            const float mu = s * (1.f / 128.f); float q = 0.f;
#pragma unroll
            for (int k = 0; k < 8; ++k) { v[k] = v[k] - mu; q += (v[k][0] * v[k][0] + v[k][1] * v[k][1]) + (v[k][2] * v[k][2] + v[k][3] * v[k][3]); }
            q += __shfl_xor(q, 1); q += __shfl_xor(q, 2);
            const float rs = 1.f / sqrtf(q * (1.f / 128.f) + EPS);
            const size_t grow = row0 + row;
            const float* gp = p.rg + h * 128 + 32 * part;
            const u32x4* sp = (const u32x4*)(SRG + grow * 512 + h * 128 + 32 * part);
            u32x4* dp = (u32x4*)(MIX + grow * 1024 + 512 + h * 128 + 32 * part);
#pragma unroll
            for (int k2 = 0; k2 < 4; ++k2) {
                const u32x4 sg = sp[k2]; const f32x4 g0 = *(const f32x4*)(gp + 8 * k2), g1 = *(const f32x4*)(gp + 8 * k2 + 4);
                const f32x4 a = v[2 * k2], c2 = v[2 * k2 + 1];
                u32x4 w;
                w.x = pk2(a[0] * rs * g0[0] * bf_lo(sg.x), a[1] * rs * g0[1] * bf_hi(sg.x));
                w.y = pk2(a[2] * rs * g0[2] * bf_lo(sg.y), a[3] * rs * g0[3] * bf_hi(sg.y));
                w.z = pk2(c2[0] * rs * g1[0] * bf_lo(sg.z), c2[1] * rs * g1[1] * bf_hi(sg.z));
                w.w = pk2(c2[2] * rs * g1[2] * bf_lo(sg.w), c2[3] * rs * g1[3] * bf_hi(sg.w));
                dp[k2] = w;
            }
        }
        __syncthreads();
    }
}

DI void phase_conv(const Params& p) {
    const int tid = opaque_tid();
    bf16_t* MIX = (bf16_t*)(p.ws + WS_MIX);
    {
        const bf16_t* U = (const bf16_t*)(p.ws + WS_U); const bf16_t* G = (const bf16_t*)(p.ws + WS_G); const float* MP = (const float*)(p.ws + WS_MP);
        const int ch = (tid & 63) * 8, ts = tid >> 6;
        float w0[8], w1[8], w2[8];
#pragma unroll
        for (int j = 0; j < 8; ++j) { w0[j] = p.conv_w[ch + j]; w1[j] = p.conv_w[512 + ch + j]; w2[j] = p.conv_w[1024 + ch + j]; }
        for (int it = blockIdx.x; it < M_TOK / 32; it += gridDim.x) {
            const int rowb = it * 32 + ts * 4;
            float um2[8], um1[8];
#pragma unroll
            for (int k = 0; k < 2; ++k) {
                float* dstu = k ? um1 : um2; const int r = rowb - 2 + k; const int t = (rowb & (SEQ - 1)) - 2 + k;
                if (t >= 0) { const u32x4 w = *(const u32x4*)(U + (size_t)r * 512 + ch);
                    dstu[0] = bf_lo(w.x); dstu[1] = bf_hi(w.x); dstu[2] = bf_lo(w.y); dstu[3] = bf_hi(w.y); dstu[4] = bf_lo(w.z); dstu[5] = bf_hi(w.z); dstu[6] = bf_lo(w.w); dstu[7] = bf_hi(w.w);
                } else { const float* mp = MP + (NMETA + t) * NPROJ;
#pragma unroll
                    for (int j = 0; j < 8; ++j) dstu[j] = mp[ch + j] * mp[1024 + ch + j]; }
            }
#pragma unroll
            for (int i = 0; i < 4; ++i) {
                const size_t r = (size_t)(rowb + i);
                const u32x4 w = *(const u32x4*)(U + r * 512 + ch), gw = *(const u32x4*)(G + r * 512 + ch);
                float uc[8], gg[8];
                uc[0] = bf_lo(w.x); uc[1] = bf_hi(w.x); uc[2] = bf_lo(w.y); uc[3] = bf_hi(w.y); uc[4] = bf_lo(w.z); uc[5] = bf_hi(w.z); uc[6] = bf_lo(w.w); uc[7] = bf_hi(w.w);
                gg[0] = bf_lo(gw.x); gg[1] = bf_hi(gw.x); gg[2] = bf_lo(gw.y); gg[3] = bf_hi(gw.y); gg[4] = bf_lo(gw.z); gg[5] = bf_hi(gw.z); gg[6] = bf_lo(gw.w); gg[7] = bf_hi(gw.w);
                float o[8];
#pragma unroll
                for (int j = 0; j < 8; ++j) { o[j] = gg[j] * (w0[j] * um2[j] + w1[j] * um1[j] + w2[j] * uc[j]); um2[j] = um1[j]; um1[j] = uc[j]; }
                u32x4 ow; ow.x = pk2(o[0], o[1]); ow.y = pk2(o[2], o[3]); ow.z = pk2(o[4], o[5]); ow.w = pk2(o[6], o[7]);
                *(u32x4*)(MIX + r * 1024 + ch) = ow;
            }
        }
    }
}

DI void phase6(const Params& p) {
    const int tid = opaque_tid(), lane = tid & 63, wave = tid >> 6;
    const float* part = (const float*)(p.ws + WS_PART);
    const int gw = blockIdx.x * 8 + wave, NGW = gridDim.x * 8;
    f32x4 g[4];
#pragma unroll
    for (int j = 0; j < 4; ++j) g[j] = ((const f32x4*)p.gf)[lane + 64 * j];
    for (int row = gw; row < M_TOK; row += NGW) {
        float s = (lane < 16) ? part[(size_t)lane * M_TOK + row] : 0.f;
        s = wave_sum(s);
        const float rs = 1.f / sqrtf(s * (1.f / 1024.f) + EPS);
        f32x4* o = (f32x4*)(p.out + (size_t)row * DM) + lane;
#pragma unroll
        for (int j = 0; j < 4; ++j) { f32x4 v = o[64 * j]; v = v * rs * g[j]; o[64 * j] = v; }
    }
}

#ifndef DUP
#define DUP -1
#endif
#define REP(k) for (int rep_ = 0; rep_ < ((DUP == (k)) ? 2 : 1); ++rep_)
__global__ void __launch_bounds__(512, 2) hymba_fwd(Params p) {
    extern __shared__ __attribute__((aligned(16))) unsigned char lds[];
    cg::grid_group grid = cg::this_grid();
    unsigned char* ws = p.ws;
    unsigned* ctl = (unsigned*)ws;
    const bool fast = (gridDim.x == 256);
    volatile LAS unsigned* st = (volatile LAS unsigned*)((LAS unsigned char*)lds + 131072);
    if (threadIdx.x < 4) st[threadIdx.x] = 0u;
    __syncthreads();
    XcdBarrier bar = xcd_barrier_post(ctl, st);
#define SEAM() do { if (fast) xcd_barrier(bar); else grid.sync(); } while (0)
    REP(0) { phase0(p, lds); __syncthreads(); }
    SEAM();
    if (DUP == 7) { for (int i_ = 0; i_ < 6; ++i_) SEAM(); }
    REP(1) {
        pg8::Gemm g{(const bf16_t*)(ws + WS_XB), (const bf16_t*)(ws + WS_WIN), M_TOK, NPROJ, DM};
        pg8::StaticOrder S; S.init(M_TOK, NPROJ, (int)gridDim.x, (int)blockIdx.x);
        EpiProj E{(const float*)(ws + WS_RSTD), (bf16_t*)(ws + WS_U), (bf16_t*)(ws + WS_G), (bf16_t*)(ws + WS_QS), (bf16_t*)(ws + WS_KZ), (bf16_t*)(ws + WS_V), (bf16_t*)(ws + WS_SRG)};
        pg8::gemm_phase<EpiProj, pg8::StaticOrder, true, true>((LAS unsigned char*)lds, g, S, E);
    }
    SEAM();
    if (fast) {
        phase2<true>(p, lds, ctl);
        phase_conv(p);
        phase3<true>(p, ctl);
        phase4<true>(p, lds, ctl);
    } else {
        phase2<false>(p, lds, ctl);
        grid.sync();
        phase3<false>(p, ctl);
        grid.sync();
        phase4<false>(p, lds, ctl);
        phase_conv(p);
    }
    SEAM();
    if (fast) REP(5) {
        pg8::Gemm g{(const bf16_t*)(ws + WS_MIX), (const bf16_t*)(ws + WS_WOUT), M_TOK, DM, DM};
        pg8::StaticOrder S; S.init(M_TOK, DM, (int)gridDim.x, (int)blockIdx.x);
        EpiOutNorm E{p.x, p.out, p.gf, (float*)(ws + WS_PART), ctl};
        pg8::gemm_phase<EpiOutNorm, pg8::StaticOrder, false, true>((LAS unsigned char*)lds, g, S, E);
    } else {
        pg8::Gemm g{(const bf16_t*)(ws + WS_MIX), (const bf16_t*)(ws + WS_WOUT), M_TOK, DM, DM};
        pg8::StaticOrder S; S.init(M_TOK, DM, (int)gridDim.x, (int)blockIdx.x);
        EpiOut E{p.x, p.out, (float*)(ws + WS_PART)};
        pg8::gemm_phase<EpiOut, pg8::StaticOrder, true, true>((LAS unsigned char*)lds, g, S, E);
        grid.sync();
        phase6(p);
    }
}

extern "C" void kernel_launch(void* const* d_in, const int* in_sizes, int n_in, void* d_out, int out_size, void* d_ws, size_t ws_size, hipStream_t stream) {
    static int grid = 0;
    if (grid == 0) {
        if (n_in != 8 || in_sizes[0] != M_TOK * DM || out_size != M_TOK * DM || ws_size < WS_END) { fprintf(stderr, "kernel_launch: unexpected shapes (n_in %d, in0 %d, out %d, ws %zu)\n", n_in, n_in > 0 ? in_sizes[0] : -1, out_size, ws_size); grid = -1; return; }
        int dev = 0, cus = 0, per_cu = 0;
        hipGetDevice(&dev);
        hipDeviceGetAttribute(&cus, hipDeviceAttributeMultiprocessorCount, dev);
        if (hipFuncSetAttribute((const void*)hymba_fwd, hipFuncAttributeMaxDynamicSharedMemorySize, LDS_BYTES) != hipSuccess) { fprintf(stderr, "kernel_launch: hipFuncSetAttribute failed\n"); grid = -1; return; }
        if (hipOccupancyMaxActiveBlocksPerMultiprocessor(&per_cu, (const void*)hymba_fwd, 512, LDS_BYTES) != hipSuccess || per_cu < 1) { fprintf(stderr, "kernel_launch: occupancy query gave %d\n", per_cu); (void)hipGetLastError(); per_cu = 1; }
        grid = cus * per_cu;
        if (grid > 256) grid = 256;
    }
    if (grid < 0) return;
    Params p{};
    p.x = (const float*)d_in[0]; p.meta = (const float*)d_in[1]; p.g1 = (const float*)d_in[2]; p.w_in = (const float*)d_in[3];
    p.conv_w = (const float*)d_in[4]; p.rg = (const float*)d_in[5]; p.w_out = (const float*)d_in[6]; p.gf = (const float*)d_in[7];
    p.out = (float*)d_out; p.ws = (unsigned char*)d_ws;
    if (hipMemsetAsync(d_ws, 0, CTL_ZERO_BYTES, stream) != hipSuccess) { fprintf(stderr, "kernel_launch: hipMemsetAsync failed\n"); return; }
    void* args[] = {&p};
#ifdef PLAIN_LAUNCH
    (void)args; hipLaunchKernelGGL(hymba_fwd, dim3(grid), dim3(512), LDS_BYTES, stream, p); hipError_t e = hipPeekAtLastError();
#else
    hipError_t e = hipLaunchCooperativeKernel((const void*)hymba_fwd, dim3(grid), dim3(512), args, LDS_BYTES, stream);
#endif
    if (e != hipSuccess) fprintf(stderr, "cooperative launch failed: %s (grid %d)\n", hipGetErrorString(e), grid);
}
```

```cpp
#include <hip/hip_runtime.h>
#include <hip/hip_cooperative_groups.h>
#include <cstdio>
#include <cstdint>
namespace cg = cooperative_groups;

#define DI __device__ __forceinline__
#define LAS __attribute__((address_space(3)))
typedef unsigned short bf16_t;
typedef short bf16x8 __attribute__((ext_vector_type(8)));
typedef short s16x4 __attribute__((ext_vector_type(4)));
typedef short v4i16_t __attribute__((ext_vector_type(4)));
typedef float f32x2 __attribute__((ext_vector_type(2)));
typedef float f32x4 __attribute__((ext_vector_type(4)));
typedef float f32x16 __attribute__((ext_vector_type(16)));
typedef unsigned u32x2 __attribute__((ext_vector_type(2)));
typedef unsigned u32x4 __attribute__((ext_vector_type(4)));
typedef __bf16 bf16x2_t __attribute__((ext_vector_type(2)));

constexpr int M_TOK = 16384, DM = 1024, NPROJ = 4096, SEQ = 8192, NMETA = 16, NCHUNK = 64;
constexpr float EPS = 1e-6f;

constexpr size_t MiB = 1u << 20;
constexpr size_t WS_RSTD = 64 * 1024, WS_MP = 128 * 1024, WS_PART = 1 * MiB, WS_WIN = 2 * MiB, WS_WOUT = 10 * MiB, WS_XB = 16 * MiB;
constexpr size_t WS_HALO = 12 * MiB;
constexpr size_t WS_U = 48 * MiB, WS_G = 64 * MiB, WS_QS = 80 * MiB, WS_KZ = 96 * MiB, WS_V = 112 * MiB, WS_SRG = 128 * MiB;
constexpr size_t WS_UPD = 144 * MiB, WS_TT = 176 * MiB, WS_MIX = 194 * MiB, WS_END = 226 * MiB;
constexpr int LDS_BYTES = 147456;

DI unsigned pk2(float lo, float hi) { f32x2 v = {lo, hi}; bf16x2_t b = __builtin_convertvector(v, bf16x2_t); return __builtin_bit_cast(unsigned, b); }
DI float bf_lo(unsigned u) { return __uint_as_float(u << 16); }
DI float bf_hi(unsigned u) { return __uint_as_float(u & 0xffff0000u); }
DI float silu_f(float x) { return x * __builtin_amdgcn_rcpf(1.f + __expf(-x)); }
DI float wave_sum(float v) {
#pragma unroll
    for (int o = 1; o < 64; o <<= 1) v += __shfl_xor(v, o);
    return v;
}
DI void sincos_rr(float ang, float& s, float& c) {
    const float k = rintf(ang * 0.15915494309189535f);
    float r = fmaf(-k, 6.2831854820251465f, ang);
    r = fmaf(-k, -1.7484555e-7f, r);
    const float rev = r * 0.15915494309189535f;
    s = __builtin_amdgcn_sinf(rev); c = __builtin_amdgcn_cosf(rev);
}
DI int opaque_tid() { int t = threadIdx.x; asm volatile("" : "+v"(t)); return t; }
DI float rope_freq(int d) { return exp2f(-(float)d * (13.287712379549449f / 64.f)); }
DI float log2_gamma(int h) { return log2f(1.f - exp2f(-5.f - (float)h)); }

namespace pg8 {
constexpr int BM = 256, BK = 64, HALF = 128, HTB = HALF * BK * 2, STAGE_BYTES = 8 * HTB, NXCD = 8, WGM = 8;
DI int lds_byte(int r, int c) { const int st = (r >> 4) * 2 + (c >> 5), rr = r & 15, cc = c & 31, ob = rr * 64 + cc * 2; return st * 1024 + (ob ^ (((ob >> 9) & 1) << 5)); }
DI void stage_rc(int b, int& R, int& C) { const int st = b / 1024, sb = b % 1024, swz = sb ^ (((sb >> 9) & 1) << 5); R = (st >> 1) * 16 + swz / 64; C = (st & 1) * 32 + (swz % 64) / 2; }
DI int perm32(int rho) { const int n = rho >> 4, i = rho & 15; return 8 * (i >> 2) + 4 * n + (i & 3); }
struct Unit { int pm, pn; };
struct Gemm { const bf16_t* A; const bf16_t* Bt; int M, N, K; };
struct StaticOrder {
    int nM, nN, nwg, G, c;
    DI void init(int M, int N, int G_, int c_) { nM = M / BM; nN = N / BM; nwg = nM * nN; G = G_; c = c_; }
    DI bool next(int i, Unit& u) const {
        const long L = (long)i * G + c; if (L >= nwg) return false;
        int wgid = (int)L; { const int q = nwg / NXCD, r = nwg % NXCD, xcd = wgid % NXCD, off = wgid / NXCD; wgid = (xcd < r ? xcd * (q + 1) : r * (q + 1) + (xcd - r) * q) + off; }
        const int nig = WGM * nN, gid = wgid / nig, fm = gid * WGM, gsz = (nM - fm) < WGM ? (nM - fm) : WGM;
        u.pm = fm + ((wgid % nig) % gsz); u.pn = (wgid % nig) / gsz; return true;
    }
    DI void a_ready(const Unit&) const {}
    DI void done(const Unit&) const {}
    DI void mid(const Unit&, int) const {}
};
struct PanelOrder : StaticOrder {
    unsigned* cnt;
    DI void mid(const Unit& u, int t) const {
        if (t == 6) { if ((threadIdx.x & 63) == 0) { unsigned* c5 = cnt + 64 * u.pm; unsigned sp = 0u;
            while ((__hip_atomic_load(c5, __ATOMIC_RELAXED, __HIP_MEMORY_SCOPE_AGENT) & 255u) < 8u) { __builtin_amdgcn_s_sleep(1); if (++sp > (1u << 22)) break; } } }
    }
};

template <class Epi, class Sched, bool ALIGN_EPI = false, bool SP2 = false, bool TOUCH = false>
DI void gemm_phase(LAS unsigned char* lds, const Gemm g, const Sched& S, const Epi& E, const char* tbase = nullptr, size_t tpitch = 0, unsigned dump_off = 0) {
    const int tid = opaque_tid(), wid = __builtin_amdgcn_readfirstlane(tid >> 6), lane = tid & 63, wr = wid >> 2, wc = wid & 3, fr = lane & 15, fq = lane >> 4;
    const int K = g.K, nt = K / BK;
    unsigned voffA[2], voffB[2];
#pragma unroll
    for (int i = 0; i < 2; ++i) { int R, C; stage_rc(tid * 16 + i * 8192, R, C); const int Rb = Epi::PERM ? ((R & ~31) + perm32(R & 31)) : R;
        voffA[i] = (unsigned)(R * K + C) * 2u; voffB[i] = (unsigned)(Rb * K + C) * 2u; }
    const size_t kstep = (size_t)(BK * 2);
    const size_t hstep = (size_t)HALF * K * 2;
    const size_t tstep = 2 * hstep;
    const unsigned ldsw = (unsigned)wid * 1024u;
    const int aoff = lds_byte(wr * 64 + fr, fq * 8), boff = lds_byte(wc * 32 + fr, fq * 8);
#define PG8_SA(b, h) (((b) * 2 + (h)) * HTB)
#define PG8_SB(b, h) ((4 + (b) * 2 + (h)) * HTB)
#define PG8_STAGE(bufoff, gbase, voff) do { _Pragma("unroll") for (int _i = 0; _i < 2; ++_i) \
        __builtin_amdgcn_global_load_lds((const unsigned*)((const char*)(gbase) + (voff)[_i]), (LAS unsigned*)(lds + (bufoff) + ldsw + _i * 8192), 16, 0, 0); } while (0)
#define PG8_LDA(dst, b, h) do { _Pragma("unroll") for (int m = 0; m < 4; ++m) _Pragma("unroll") for (int k = 0; k < 2; ++k) dst[m][k] = *(const LAS bf16x8*)(lds + PG8_SA(b, h) + aoff + m * 2048 + k * 1024); } while (0)
#define PG8_LDB(dst, b, h) do { _Pragma("unroll") for (int n = 0; n < 2; ++n) _Pragma("unroll") for (int k = 0; k < 2; ++k) dst[n][k] = *(const LAS bf16x8*)(lds + PG8_SB(b, h) + boff + n * 2048 + k * 1024); } while (0)
#define PG8_MMA(ai, bj, At, Bt) do { __builtin_amdgcn_s_setprio(1); _Pragma("unroll") for (int m = 0; m < 4; ++m) _Pragma("unroll") for (int n = 0; n < 2; ++n) _Pragma("unroll") for (int k = 0; k < 2; ++k) \
        acc[ai][bj][m][n] = __builtin_amdgcn_mfma_f32_16x16x32_bf16(Bt[n][k], At[m][k], acc[ai][bj][m][n], 0, 0, 0); __builtin_amdgcn_s_setprio(0); } while (0)
#define PG8_WAIT_V(n) asm volatile("s_waitcnt vmcnt(" #n ")" ::: "memory")
#define PG8_WAIT_SP() do { if constexpr (TOUCH) PG8_WAIT_V(10); else PG8_WAIT_V(8); } while (0)
#define PG8_TOUCH(j) do { if constexpr (TOUCH) __builtin_amdgcn_global_load_lds((const unsigned*)(tptr + (size_t)(j) * tpitch), (LAS unsigned*)(lds + dump_off + ldsw), 16, 0, 0); } while (0)
#define PG8_WAIT_L(n) asm volatile("s_waitcnt lgkmcnt(" #n ")" ::: "memory")
#define PG8_BAR __builtin_amdgcn_s_barrier()
#define PG8_SCHED __builtin_amdgcn_sched_barrier(0)
    Unit cur, nxt; int ui = 0;
    if (!S.next(0, cur)) return;
    const char* tptr = nullptr;
    if constexpr (TOUCH) tptr = tbase + ((size_t)cur.pm * 256 + (size_t)wid * 32) * tpitch + (size_t)cur.pn * 1024 + (size_t)lane * 16;
    f32x4 acc[2][2][4][2];
#pragma unroll
    for (int a = 0; a < 2; ++a)
#pragma unroll
        for (int b = 0; b < 2; ++b)
#pragma unroll
            for (int m = 0; m < 4; ++m)
#pragma unroll
                for (int n = 0; n < 2; ++n) acc[a][b][m][n] = (f32x4){0.f, 0.f, 0.f, 0.f};
    bf16x8 At[4][2], B0[2][2], B1[2][2];
    const char* cA = (const char*)g.A + (size_t)cur.pm * tstep; const char* cB = (const char*)g.Bt + (size_t)cur.pn * tstep;
    S.a_ready(cur);
    if constexpr (SP2) {
        PG8_STAGE(PG8_SB(0, 0), cB, voffB); PG8_STAGE(PG8_SB(0, 1), cB + hstep, voffB); PG8_STAGE(PG8_SA(0, 0), cA, voffA); PG8_STAGE(PG8_SA(0, 1), cA + hstep, voffA);
        if (wr == 1) PG8_BAR;
        PG8_WAIT_V(2); PG8_BAR;
        PG8_STAGE(PG8_SB(1, 0), cB + kstep, voffB); PG8_STAGE(PG8_SA(1, 0), cA + kstep, voffA); PG8_STAGE(PG8_SB(1, 1), cB + hstep + kstep, voffB);
        PG8_WAIT_V(6); PG8_BAR;
    } else {
        PG8_STAGE(PG8_SB(0, 0), cB, voffB); PG8_STAGE(PG8_SA(0, 0), cA, voffA); PG8_STAGE(PG8_SB(0, 1), cB + hstep, voffB); PG8_STAGE(PG8_SA(0, 1), cA + hstep, voffA);
        if (wr == 1) PG8_BAR;
        PG8_WAIT_V(4); PG8_BAR;
        PG8_STAGE(PG8_SB(1, 0), cB + kstep, voffB); PG8_STAGE(PG8_SA(1, 0), cA + kstep, voffA); PG8_STAGE(PG8_SB(1, 1), cB + hstep + kstep, voffB);
        PG8_WAIT_V(6); PG8_BAR;
    }
    for (;;) {
        const bool has_next = S.next(ui + 1, nxt);
        const char* nA = has_next ? (const char*)g.A + (size_t)nxt.pm * tstep : cA; const char* nB = has_next ? (const char*)g.Bt + (size_t)nxt.pn * tstep : cB;
        for (int t = 0; t < nt; t += 2) {
            S.mid(cur, t);
            const bool last = (t == nt - 2);
            const char* a1 = cA + (size_t)(t + 1) * kstep;
            const char* a2 = last ? nA : cA + (size_t)(t + 2) * kstep; const char* b2 = last ? nB : cB + (size_t)(t + 2) * kstep;
            const char* a3 = a2 + kstep; const char* b3 = b2 + kstep;
            if (last && has_next) S.a_ready(nxt);
            if constexpr (SP2) {
            PG8_LDB(B0, 0, 0); PG8_LDB(B1, 0, 1); PG8_SCHED; PG8_LDA(At, 0, 0); PG8_STAGE(PG8_SA(1, 1), a1 + hstep, voffA); PG8_TOUCH(2 * t);
            PG8_WAIT_SP(); PG8_WAIT_L(0); PG8_BAR; PG8_MMA(0, 0, At, B0); PG8_MMA(0, 1, At, B1); PG8_BAR; PG8_SCHED;
            PG8_LDA(At, 0, 1); PG8_STAGE(PG8_SB(0, 0), b2, voffB); PG8_STAGE(PG8_SB(0, 1), b2 + hstep, voffB); PG8_STAGE(PG8_SA(0, 0), a2, voffA); PG8_TOUCH(2 * t + 1);
            PG8_WAIT_SP(); PG8_WAIT_L(0); PG8_BAR; PG8_MMA(1, 0, At, B0); PG8_MMA(1, 1, At, B1); PG8_BAR; PG8_SCHED;
            PG8_LDB(B0, 1, 0); PG8_LDB(B1, 1, 1); PG8_SCHED; PG8_LDA(At, 1, 0); PG8_STAGE(PG8_SA(0, 1), a2 + hstep, voffA); PG8_TOUCH(2 * t + 2);
            PG8_WAIT_SP(); PG8_WAIT_L(0); PG8_BAR; PG8_MMA(0, 0, At, B0); PG8_MMA(0, 1, At, B1); PG8_BAR; PG8_SCHED;
            PG8_LDA(At, 1, 1); PG8_STAGE(PG8_SB(1, 0), b3, voffB); PG8_STAGE(PG8_SB(1, 1), b3 + hstep, voffB); PG8_STAGE(PG8_SA(1, 0), a3, voffA); PG8_TOUCH(2 * t + 3);
            PG8_WAIT_SP(); PG8_WAIT_L(0); PG8_BAR; PG8_MMA(1, 0, At, B0); PG8_MMA(1, 1, At, B1); PG8_BAR; PG8_SCHED;
            } else {
            PG8_LDB(B0, 0, 0); PG8_SCHED; PG8_LDA(At, 0, 0); PG8_STAGE(PG8_SA(1, 1), a1 + hstep, voffA);
            PG8_WAIT_L(8); PG8_BAR; PG8_WAIT_L(0); PG8_MMA(0, 0, At, B0); PG8_BAR; PG8_SCHED;
            PG8_LDB(B1, 0, 1); PG8_STAGE(PG8_SB(0, 0), b2, voffB);
            PG8_BAR; PG8_WAIT_L(0); PG8_MMA(0, 1, At, B1); PG8_BAR;
            PG8_LDA(At, 0, 1); PG8_STAGE(PG8_SA(0, 0), a2, voffA);
            PG8_BAR; PG8_WAIT_L(0); PG8_MMA(1, 0, At, B0); PG8_BAR; PG8_SCHED;
            PG8_STAGE(PG8_SB(0, 1), b2 + hstep, voffB);
            PG8_WAIT_V(6); PG8_BAR; PG8_MMA(1, 1, At, B1); PG8_BAR;
            PG8_LDB(B0, 1, 0); PG8_SCHED; PG8_LDA(At, 1, 0); PG8_STAGE(PG8_SA(0, 1), a2 + hstep, voffA);
            PG8_WAIT_L(8); PG8_BAR; PG8_WAIT_L(0); PG8_MMA(0, 0, At, B0); PG8_BAR; PG8_SCHED;
            PG8_LDB(B1, 1, 1); PG8_STAGE(PG8_SB(1, 0), b3, voffB);
            PG8_BAR; PG8_WAIT_L(0); PG8_MMA(0, 1, At, B1); PG8_BAR;
            PG8_LDA(At, 1, 1); PG8_STAGE(PG8_SA(1, 0), a3, voffA);
            PG8_BAR; PG8_WAIT_L(0); PG8_MMA(1, 0, At, B0); PG8_BAR; PG8_SCHED;
            PG8_STAGE(PG8_SB(1, 1), b3 + hstep, voffB);
            PG8_WAIT_V(6); PG8_BAR; PG8_MMA(1, 1, At, B1); PG8_BAR;
            }
        }
        if constexpr (ALIGN_EPI) { if (wr == 0) PG8_BAR; }
        if constexpr (!Epi::AFTER_DRAIN) { E(acc, cur, wr, wc, fr, fq); S.done(cur); }
        if (!has_next) break;
#pragma unroll
        for (int a = 0; a < 2; ++a)
#pragma unroll
            for (int b = 0; b < 2; ++b)
#pragma unroll
                for (int m = 0; m < 4; ++m)
#pragma unroll
                    for (int n = 0; n < 2; ++n) acc[a][b][m][n] = (f32x4){0.f, 0.f, 0.f, 0.f};
        cur = nxt; cA = nA; cB = nB; ++ui;
        if constexpr (ALIGN_EPI) { if (wr == 1) PG8_BAR; }
    }
    PG8_WAIT_V(0);
    if constexpr (!ALIGN_EPI) { if (wr == 0) PG8_BAR; }
    PG8_BAR;
    if constexpr (Epi::AFTER_DRAIN) { E.fused(acc, cur, wr, wc, fr, fq, lds, wid, lane); S.done(cur); }
#undef PG8_SA
#undef PG8_SB
#undef PG8_STAGE
#undef PG8_LDA
#undef PG8_LDB
#undef PG8_MMA
#undef PG8_WAIT_V
#undef PG8_WAIT_SP
#undef PG8_TOUCH
#undef PG8_WAIT_L
#undef PG8_BAR
#undef PG8_SCHED
}
}


#define XB_TMO      128
#define XB_XCNT(j)  (256  + 64 * (j))
#define XB_XSUB(j)  (1280 + 64 * (j))
#define XB_XGEN(j)  (2304 + 64 * (j))
#define XB_TOP      3328
#define XB_TOPGEN   3392
#define XCD_BAR_WORDS 3456
#define XB_SPIN_CAP (1u << 18)
constexpr int CW_PANEL = 4096, CW_C2 = 8192, CW_C3 = 8192 + 512, CW_P5 = 9216;
constexpr size_t CTL_ZERO_BYTES = 57344;
DI unsigned xb_ld(unsigned* p)              { return __hip_atomic_load(p, __ATOMIC_RELAXED, __HIP_MEMORY_SCOPE_AGENT); }
DI unsigned xb_add(unsigned* p, unsigned v) { return __hip_atomic_fetch_add(p, v, __ATOMIC_RELAXED, __HIP_MEMORY_SCOPE_AGENT); }
DI unsigned xb_xcc_id() { return (unsigned)__builtin_amdgcn_s_getreg((3 << 11) | 20) & 0xFu; }
#define XB_SPIN(cond, bar) do { unsigned _sp = 0; while (cond) { __builtin_amdgcn_s_sleep(1); \
    if ((++_sp & 255u) == 0u) { if (xb_ld(&(bar)[XB_TMO])) break; if (_sp > XB_SPIN_CAP) { atomicAdd(&(bar)[XB_TMO], 1u); break; } } } } while (0)
struct XcdBarrier { unsigned* bar; unsigned x; volatile LAS unsigned* st; };
DI XcdBarrier xcd_barrier_post(unsigned* bar, volatile LAS unsigned* st) {
    XcdBarrier b; b.bar = bar; b.x = xb_xcc_id(); b.st = st;
    if (threadIdx.x == 0) (void)xb_add(&bar[XB_XCNT(b.x)], 1u);
    return b;
}
DI void xcd_barrier_complete(unsigned* bar, unsigned x, unsigned& nloc, unsigned& nx) {
    const unsigned G = gridDim.x * gridDim.y * gridDim.z;
    unsigned sum, cnt, mine, sp = 0u;
    for (;;) {
        sum = 0u; cnt = 0u; mine = 0u;
#pragma unroll
        for (unsigned j = 0; j < 16; ++j) { const unsigned c = xb_ld(&bar[XB_XCNT(j)]); sum += c; cnt += (c > 0u) ? 1u : 0u; mine = (j == x) ? c : mine; }
        if (sum == G) break;
        __builtin_amdgcn_s_sleep(1);
        if ((++sp & 255u) == 0u) { if (xb_ld(&bar[XB_TMO])) break; if (sp > XB_SPIN_CAP) { atomicAdd(&bar[XB_TMO], 1u); break; } }
    }
    nloc = mine > 0u ? mine : 1u; nx = cnt > 0u ? cnt : 1u;
}
DI void xcd_barrier(const XcdBarrier& b) {
    asm volatile("s_waitcnt vmcnt(0)" ::: "memory");
    __syncthreads();
    if (threadIdx.x == 0) {
        unsigned* bar = b.bar;
        __builtin_amdgcn_s_waitcnt(0);
        unsigned nloc = b.st[0], nx = b.st[1];
        if (nloc == 0u) { xcd_barrier_complete(bar, b.x, nloc, nx); b.st[0] = nloc; b.st[1] = nx; }
        const unsigned old = xb_add(&bar[XB_XSUB(b.x)], 1u);
        const unsigned gen = old / nloc;
        if (old + 1u == (gen + 1u) * nloc) {
            __builtin_amdgcn_fence(__ATOMIC_RELEASE, "agent");
            asm volatile("s_waitcnt vmcnt(0)" ::: "memory");
            const unsigned og = xb_add(&bar[XB_TOP], 1u);
            const unsigned tg = og / nx;
            if (og + 1u == (tg + 1u) * nx) xb_add(&bar[XB_TOPGEN], 1u);
            else XB_SPIN(xb_ld(&bar[XB_TOPGEN]) == tg, bar);
            __builtin_amdgcn_fence(__ATOMIC_ACQUIRE, "agent");
            xb_add(&bar[XB_XGEN(b.x)], 1u);
            asm volatile("s_waitcnt vmcnt(0)" ::: "memory");
        } else {
            XB_SPIN(xb_ld(&bar[XB_XGEN(b.x)]) == gen, bar);
            __builtin_amdgcn_fence(__ATOMIC_ACQUIRE, "agent");
            asm volatile("s_waitcnt vmcnt(0)" ::: "memory");
        }
    }
    __syncthreads();
}


DI u32x4 pack8(f32x4 a, f32x4 b) { u32x4 w; w.x = pk2(a[0], a[1]); w.y = pk2(a[2], a[3]); w.z = pk2(b[0], b[1]); w.w = pk2(b[2], b[3]); return w; }
DI f32x4 silu4(f32x4 v) { f32x4 o; o[0] = silu_f(v[0]); o[1] = silu_f(v[1]); o[2] = silu_f(v[2]); o[3] = silu_f(v[3]); return o; }

DI void store16_sc1(void* ptr, u32x4 v) { asm volatile("global_store_dwordx4 %0, %1, off sc1\n\ts_nop 1" :: "v"(ptr), "v"(v) : "memory"); }

struct EpiProj {
    static constexpr bool PERM = true, AFTER_DRAIN = false;
    const float* rstd; bf16_t *MIX, *QS, *KZ, *V, *SRG; const float* convw; float* halo; LAS unsigned char* xlds;
    DI void operator()(const f32x4 (&acc)[2][2][4][2], const pg8::Unit& u, int wr, int wc, int fr, int fq) const {
        const int pn = u.pn;
        const int row0 = u.pm * 256 + wr * 64 + fr;
        const int cw = wc * 32 + 8 * fq;
        if (pn < 8) {
            const int ch0 = pn * 64 + 16 * wc + 4 * fq;
            const f32x4 w0 = *(const f32x4*)(convw + ch0), w1 = *(const f32x4*)(convw + 512 + ch0), w2 = *(const f32x4*)(convw + 1024 + ch0);
            f32x4 u3[2];
#pragma unroll
            for (int ai = 0; ai < 2; ++ai) { const float rs = rstd[row0 + ai * 128 + 48]; u3[ai] = (acc[ai][0][3][0] * rs) * (acc[ai][0][3][1] * rs); }
            LAS float* xb = (LAS float*)(xlds);
            if (fr >= 14) {
#pragma unroll
                for (int ai = 0; ai < 2; ++ai) *(LAS f32x4*)(xb + (((ai * 2 + wr) * 4 + wc) * 2 + (fr - 14)) * 16 + 4 * fq) = u3[ai];
                if (wr == 1) *(f32x4*)(halo + ((size_t)(u.pm * 3 + 2) * 2 + (fr - 14)) * 512 + ch0) = u3[1];
            }
            asm volatile("s_waitcnt lgkmcnt(0)" ::: "memory");
            __builtin_amdgcn_s_barrier();
#pragma unroll
            for (int ai = 0; ai < 2; ++ai) {
                f32x4 o1, o2, up = (f32x4){0.f, 0.f, 0.f, 0.f};
                bool havep = true;
                if (ai == 0 && wr == 0) { havep = false; o1 = (f32x4){0.f, 0.f, 0.f, 0.f}; o2 = o1; }
                else { const int pa = (wr == 1) ? ai : 0, pw = (wr == 1) ? 0 : 1;
                    const f32x4 p15 = *(const LAS f32x4*)(xb + (((pa * 2 + pw) * 4 + wc) * 2 + 1) * 16 + 4 * fq), p14 = *(const LAS f32x4*)(xb + (((pa * 2 + pw) * 4 + wc) * 2 + 0) * 16 + 4 * fq);
                    o1 = p15; o2 = (fr == 0) ? p14 : p15; }
#pragma unroll
                for (int m = 0; m < 4; ++m) {
                    const int row = row0 + ai * 128 + m * 16; const float rs = rstd[row];
                    const f32x4 uc = (acc[ai][0][m][0] * rs) * (acc[ai][0][m][1] * rs);
                    const int lane_ = fq * 16 + fr;
                    if (m > 0) {
#pragma unroll
                        for (int j = 0; j < 4; ++j) { o1[j] = __shfl(up[j], (lane_ & 48) + ((fr + 15) & 15)); o2[j] = __shfl(up[j], (lane_ & 48) + ((fr + 14) & 15)); }
                    }
                    f32x4 u1, u2;
#pragma unroll
                    for (int j = 0; j < 4; ++j) { const float s1 = __shfl(uc[j], (lane_ & 48) + ((fr + 15) & 15)), s2 = __shfl(uc[j], (lane_ & 48) + ((fr + 14) & 15));
                        u1[j] = (fr >= 1) ? s1 : o1[j]; u2[j] = (fr >= 2) ? s2 : o2[j]; }
                    const f32x4 cv3 = w0 * u2 + w1 * u1 + w2 * uc;
                    const f32x4 gate = (acc[ai][1][m][0] * rs) * silu4(acc[ai][1][m][1] * rs);
                    if (!havep && m == 0 && fr < 2) {
                        *(f32x4*)(halo + ((size_t)(u.pm * 3 + 0) * 2 + fr) * 512 + ch0) = cv3;
                        *(f32x4*)(halo + ((size_t)(u.pm * 3 + 1) * 2 + fr) * 512 + ch0) = gate;
                    } else {
                        const f32x4 o = gate * cv3; u32x2 w; w.x = pk2(o[0], o[1]); w.y = pk2(o[2], o[3]);
                        *(u32x2*)(MIX + (size_t)row * 1024 + ch0) = w;
                    }
                    up = uc;
                }
            }
        } else if (pn < 12) {
            const bool isq = pn < 10;
            const int head = 2 * ((pn - 8) & 1) + (wc >> 1);
            const int d0 = cw & 63;
            float fr8[8];
#pragma unroll
            for (int j = 0; j < 8; ++j) fr8[j] = rope_freq(d0 + j);
            const float lg = log2_gamma(head);
            bf16_t* dst = (isq ? QS : KZ) + head * 128 + d0;
#pragma unroll
            for (int ai = 0; ai < 2; ++ai)
#pragma unroll
                for (int m = 0; m < 4; ++m) {
                    const int row = row0 + ai * 128 + m * 16; const float rs = rstd[row];
                    const int t = row & (SEQ - 1), tl = t & 127; const float pos = (float)(NMETA + t);
                    const float sc = rs * (isq ? 0.08838834764831845f * exp2f((float)(tl - 127) * lg) : exp2f((float)(127 - tl) * lg));
                    f32x4 r1[2], r2[2];
#pragma unroll
                    for (int j = 0; j < 8; ++j) {
                        float s, c; sincos_rr(pos * fr8[j], s, c);
                        const float x1 = acc[ai][0][m][j >> 2][j & 3], x2 = acc[ai][1][m][j >> 2][j & 3];
                        r1[j >> 2][j & 3] = (x1 * c - x2 * s) * sc; r2[j >> 2][j & 3] = (x1 * s + x2 * c) * sc;
                    }
                    *(u32x4*)(dst + (size_t)row * 512) = pack8(r1[0], r1[1]);
                    *(u32x4*)(dst + (size_t)row * 512 + 64) = pack8(r2[0], r2[1]);
                }
        } else {
            const bool isv = pn < 14;
            bf16_t* dst = (isv ? V : SRG) + ((pn - 12) & 1) * 256 + cw;
#pragma unroll
            for (int ai = 0; ai < 2; ++ai)
#pragma unroll
                for (int m = 0; m < 4; ++m) {
                    const int row = row0 + ai * 128 + m * 16; const float rs = rstd[row];
#pragma unroll
                    for (int bj = 0; bj < 2; ++bj) {
                        f32x4 a0 = acc[ai][bj][m][0] * rs, a1 = acc[ai][bj][m][1] * rs;
                        if (!isv) { a0 = silu4(a0); a1 = silu4(a1); }
                        *(u32x4*)(dst + (size_t)row * 512 + bj * 128) = pack8(a0, a1);
                    }
                }
        }
    }
};

struct EpiOut {
    static constexpr bool PERM = true, AFTER_DRAIN = false;
    const float* x; float* out; float* part;
    DI void operator()(const f32x4 (&acc)[2][2][4][2], const pg8::Unit& u, int wr, int wc, int fr, int fq) const {
        const int row0 = u.pm * 256 + wr * 64 + fr, col0 = u.pn * 256 + wc * 32 + 8 * fq;
#pragma unroll
        for (int ai = 0; ai < 2; ++ai)
#pragma unroll
            for (int m = 0; m < 4; ++m) {
                const int row = row0 + ai * 128 + m * 16; float ss = 0.f;
#pragma unroll
                for (int bj = 0; bj < 2; ++bj) {
                    const size_t o = (size_t)row * DM + col0 + bj * 128;
                    const f32x4 y0 = acc[ai][bj][m][0] + *(const f32x4*)(x + o), y1 = acc[ai][bj][m][1] + *(const f32x4*)(x + o + 4);
                    ss += (y0[0] * y0[0] + y0[1] * y0[1]) + (y0[2] * y0[2] + y0[3] * y0[3]) + (y1[0] * y1[0] + y1[1] * y1[1]) + (y1[2] * y1[2] + y1[3] * y1[3]);
                    *(f32x4*)(out + o) = y0; *(f32x4*)(out + o + 4) = y1;
                }
                ss += __shfl_xor(ss, 16); ss += __shfl_xor(ss, 32);
                if (fq == 0) part[(size_t)(u.pn * 4 + wc) * M_TOK + row] = ss;
            }
    }
};


struct EpiOutNorm {
    static constexpr bool PERM = true, AFTER_DRAIN = true;
    const float* x; float* out; const float* gf; float* xch; unsigned* ctl;
    DI void fused(f32x4 (&acc)[2][2][4][2], const pg8::Unit& u, int wr, int wc, int fr, int fq, LAS unsigned char* lds, int wid, int lane) const {
        LAS float* R = (LAS float*)(lds + 131072 + 1024);
        f32x4 y[2][16];
        float* slot = xch + (size_t)(u.pm * 4) * 256;
#pragma unroll
        for (int ai = 0; ai < 2; ++ai) {
            if (ai) __syncthreads();
#pragma unroll
            for (int m = 0; m < 4; ++m)
#pragma unroll
                for (int bj = 0; bj < 2; ++bj)
#pragma unroll
                    for (int n = 0; n < 2; ++n) { const int r = wr * 64 + m * 16 + fr, ch = 32 * bj + 8 * wc + 2 * fq + n;
                        *(LAS f32x4*)(lds + r * 1024 + ((ch ^ (r & 15)) << 4)) = acc[ai][bj][m][n]; }
            __syncthreads();
            f32x4 xv[16];
#pragma unroll
            for (int k = 0; k < 16; ++k) { const int r = wid + 8 * k; xv[k] = __builtin_nontemporal_load((const f32x4*)(x + (size_t)(u.pm * 256 + ai * 128 + r) * DM + u.pn * 256) + lane); }
#pragma unroll
            for (int k = 0; k < 16; ++k) { const int r = wid + 8 * k;
                const f32x4 v = *(const LAS f32x4*)(lds + r * 1024 + ((lane ^ (r & 15)) << 4)) + xv[k];
                y[ai][k] = v;
                const float ss = wave_sum((v[0] * v[0] + v[1] * v[1]) + (v[2] * v[2] + v[3] * v[3]));
                if (lane == 0) __hip_atomic_store(slot + u.pn * 256 + ai * 128 + r, ss, __ATOMIC_RELAXED, __HIP_MEMORY_SCOPE_AGENT); }
        }
        const int tid = wid * 64 + lane;
        asm volatile("s_waitcnt vmcnt(0)" ::: "memory");
        __syncthreads();
        if (tid == 0) {
            unsigned* cnt = ctl + CW_PANEL + 64 * u.pm;
            xb_add(cnt, 1u);
            unsigned sp = 0u;
            while (xb_ld(cnt) < 4u) { __builtin_amdgcn_s_sleep(1); if (++sp > (1u << 22)) break; }
        }
        __syncthreads();
        if (tid < 256) { float s = 0.f;
#pragma unroll
            for (int q = 0; q < 4; ++q) s += __hip_atomic_load(slot + q * 256 + tid, __ATOMIC_RELAXED, __HIP_MEMORY_SCOPE_AGENT);
            R[tid] = 1.f / sqrtf(s * (1.f / 1024.f) + EPS); }
        __syncthreads();
        const f32x4 gv = *((const f32x4*)(gf + u.pn * 256) + lane);
#pragma unroll
        for (int ai = 0; ai < 2; ++ai)
#pragma unroll
            for (int k = 0; k < 16; ++k) { const int r = ai * 128 + wid + 8 * k; const float rs = R[r];
                __builtin_nontemporal_store(y[ai][k] * rs * gv, (f32x4*)(out + (size_t)(u.pm * 256 + r) * DM + u.pn * 256) + lane); }
    }
};

DI unsigned off_b(unsigned row, unsigned ch) { return 256u * row + 16u * (ch ^ (((row & 3) << 2) | ((row >> 2) & 3))); }
DI bf16x8 row_frag(const unsigned char* img, int rb, int s, int lane) {
    return *(const bf16x8*)(img + 8192 * rb + off_b(lane & 31, 2 * s + (lane >> 5)));
}
DI s16x4 tr_read(const unsigned char* p) { return __builtin_bit_cast(s16x4, __builtin_amdgcn_ds_read_tr16_b64_v4i16((LAS v4i16_t*)(const LAS unsigned char*)p)); }
template <bool PERMK> DI bf16x8 tr_frag(const unsigned char* img, int c, int rbase, int lane) {
    const int h = lane >> 5, blk = (lane >> 4) & 1, q = (lane & 15) >> 2, p = lane & 3;
    const int r0 = rbase + (PERMK ? 4 * h : 8 * h) + q, r1 = r0 + (PERMK ? 8 : 4);
    const unsigned ch = 4 * c + 2 * blk + (p >> 1), bo = 8 * (p & 1);
    const s16x4 lo = tr_read(img + off_b(r0, ch) + bo), hi = tr_read(img + off_b(r1, ch) + bo);
    return __builtin_shufflevector(lo, hi, 0, 1, 2, 3, 4, 5, 6, 7);
}
DI void load_tile(unsigned char* img, const bf16_t* src, int ld, int tid) {
#pragma unroll
    for (int i = 0; i < 4; ++i) { const int idx = tid + 512 * i, row = idx >> 4, ch = idx & 15;
        *(u32x4*)(img + off_b(row, ch)) = *(const u32x4*)(src + (size_t)row * ld + ch * 8); }
}
DI void tile_ld(u32x4 (&r)[4], const bf16_t* src, int ld, int tid) {
#pragma unroll
    for (int i = 0; i < 4; ++i) { const int idx = tid + 512 * i, row = idx >> 4, ch = idx & 15; r[i] = *(const u32x4*)(src + (size_t)row * ld + ch * 8); }
}
DI void tile_st(unsigned char* img, const u32x4 (&r)[4], int tid) {
#pragma unroll
    for (int i = 0; i < 4; ++i) { const int idx = tid + 512 * i, row = idx >> 4, ch = idx & 15; *(u32x4*)(img + off_b(row, ch)) = r[i]; }
}
DI int crow(int reg, int h) { return (reg & 3) + 8 * (reg >> 2) + 4 * h; }
#define MFMA32(a, b, c) __builtin_amdgcn_mfma_f32_32x32x16_bf16((a), (b), (c), 0, 0, 0)

struct Params { const float *x, *meta, *g1, *w_in, *conv_w, *rg, *w_out, *gf; float* out; unsigned char* ws; };


DI int dest_pos(int n) {
    const int type = n >> 9, r = n & 511;
    if (type < 4) {
        const int rr = r & 63, wc = rr >> 4, fq = (rr >> 2) & 3, j = rr & 3;
        const int bj = (type == 1 || type == 3) ? 1 : 0, nn = (type >= 2) ? 1 : 0;
        return (r >> 6) * 256 + 128 * bj + 32 * wc + 8 * fq + 4 * nn + j;
    }
    if (type < 6) { const int h = r >> 7, d = r & 127; return (8 + (type - 4) * 2 + (h >> 1)) * 256 + (d >> 6) * 128 + (h & 1) * 64 + (d & 63); }
    return n;
}

DI void p0_tr_load(float (&w)[32], const float* W, const float* gain, int N, int item, int lane) {
    const int nblk = N / 32, kb = item / nblk, nb = item % nblk, k0 = 64 * kb, n0 = 32 * nb;
#pragma unroll
    for (int i = 0; i < 32; ++i) { const int kk = 2 * i + (lane >> 5); w[i] = W[(size_t)(k0 + kk) * N + n0 + (lane & 31)]; if (gain) w[i] *= gain[k0 + kk]; }
}
DI void p0_tr_finish(const float (&w)[32], int K, int N, bf16_t* WT, bool perm, float* scr, int item, int lane) {
    const int nblk = N / 32, kb = item / nblk, nb = item % nblk, k0 = 64 * kb, n0 = 32 * nb;
#pragma unroll
    for (int i = 0; i < 32; ++i) { const int kk = 2 * i + (lane >> 5); scr[kk * 33 + (lane & 31)] = w[i]; }
    __builtin_amdgcn_s_waitcnt(0xc07f); asm volatile("" ::: "memory");
    const int c = lane & 7;
#pragma unroll
    for (int j = 0; j < 4; ++j) { const int n = (lane >> 3) + 8 * j; const float* s = scr + (8 * c) * 33 + n;
        u32x4 o; o.x = pk2(s[0 * 33], s[1 * 33]); o.y = pk2(s[2 * 33], s[3 * 33]); o.z = pk2(s[4 * 33], s[5 * 33]); o.w = pk2(s[6 * 33], s[7 * 33]);
        *(u32x4*)(WT + (size_t)(perm ? dest_pos(n0 + n) : n0 + n) * K + k0 + 8 * c) = o; }
    __builtin_amdgcn_s_waitcnt(0xc07f); asm volatile("" ::: "memory");
}

DI void phase0(const Params& p, unsigned char* lds) {
    const int tid = opaque_tid(), lane = tid & 63, wave = tid >> 6;
    unsigned char* ws = p.ws;
    float* rstd = (float*)(ws + WS_RSTD); float* MP = (float*)(ws + WS_MP);
    bf16_t* XB = (bf16_t*)(ws + WS_XB); bf16_t* WIN = (bf16_t*)(ws + WS_WIN); bf16_t* WOUT = (bf16_t*)(ws + WS_WOUT);
    {
        float* metaL = (float*)lds; float* red = (float*)(lds + 65536); float* rsL = (float*)(lds + 98304);
        for (int i = tid; i < 4096; i += 512) ((f32x4*)metaL)[i] = ((const f32x4*)p.meta)[i];
        __syncthreads();
#pragma unroll
        for (int rr = 0; rr < 2; ++rr) { const int m = 2 * wave + rr; float s = 0.f;
#pragma unroll
            for (int i = 0; i < 16; ++i) { const float v = metaL[m * 1024 + lane + 64 * i]; s += v * v; }
            s = wave_sum(s); if (lane == 0) rsL[m] = 1.f / sqrtf(s * (1.f / 1024.f) + EPS); }
        for (int cgp = blockIdx.x; cgp < 256; cgp += gridDim.x) {
            const int col = tid & 15, ks = tid >> 4, n = cgp * 16 + col;
            float a[16], wv[32];
#pragma unroll
            for (int m = 0; m < 16; ++m) a[m] = 0.f;
#pragma unroll
            for (int kk = 0; kk < 32; ++kk) { const int k = kk * 32 + ks; wv[kk] = p.w_in[(size_t)k * NPROJ + n] * p.g1[k]; }
#pragma unroll
            for (int kk = 0; kk < 32; ++kk) { const int k = kk * 32 + ks;
#pragma unroll
                for (int m = 0; m < 16; ++m) a[m] = fmaf(metaL[m * 1024 + k], wv[kk], a[m]); }
#pragma unroll
            for (int m = 0; m < 16; ++m) red[(ks * 16 + m) * 16 + col] = a[m];
            __syncthreads();
            if (tid < 256) { const int m = tid >> 4, c = tid & 15; float s = 0.f;
#pragma unroll 8
                for (int k2 = 0; k2 < 32; ++k2) s += red[(k2 * 16 + m) * 16 + c];
                MP[m * NPROJ + cgp * 16 + c] = s * rsL[m]; }
            __syncthreads();
        }
    }
    __syncthreads();
    const int gw = blockIdx.x * 8 + wave, NGW = gridDim.x * 8;
    {
        float* scr = (float*)(lds + wave * 16384);
        constexpr int I_IN = (DM / 64) * (NPROJ / 32), I_OUT = (DM / 64) * (DM / 32);
        for (int it = gw; it < I_IN + I_OUT; it += 2 * NGW) {
            const int it2 = it + NGW; const bool has2 = it2 < I_IN + I_OUT;
            float wa[32], wb[32];
            if (it < I_IN) p0_tr_load(wa, p.w_in, p.g1, NPROJ, it, lane); else p0_tr_load(wa, p.w_out, nullptr, DM, it - I_IN, lane);
            if (has2) { if (it2 < I_IN) p0_tr_load(wb, p.w_in, p.g1, NPROJ, it2, lane); else p0_tr_load(wb, p.w_out, nullptr, DM, it2 - I_IN, lane); }
            if (it < I_IN) p0_tr_finish(wa, DM, NPROJ, WIN, true, scr, it, lane); else p0_tr_finish(wa, DM, DM, WOUT, false, scr, it - I_IN, lane);
            if (has2) { if (it2 < I_IN) p0_tr_finish(wb, DM, NPROJ, WIN, true, scr, it2, lane); else p0_tr_finish(wb, DM, DM, WOUT, false, scr, it2 - I_IN, lane); }
        }
    }
    for (int row = gw; row < M_TOK; row += 4 * NGW) {
        f32x4 v[4][4]; float s[4];
#pragma unroll
        for (int q = 0; q < 4; ++q) { const f32x4* xr = (const f32x4*)(p.x + (size_t)(row + q * NGW) * DM) + lane;
#pragma unroll
            for (int j = 0; j < 4; ++j) v[q][j] = __builtin_nontemporal_load(xr + 64 * j); }
#pragma unroll
        for (int q = 0; q < 4; ++q) { float a = 0.f;
#pragma unroll
            for (int j = 0; j < 4; ++j) a += (v[q][j][0] * v[q][j][0] + v[q][j][1] * v[q][j][1]) + (v[q][j][2] * v[q][j][2] + v[q][j][3] * v[q][j][3]);
            s[q] = wave_sum(a); }
#pragma unroll
        for (int q = 0; q < 4; ++q) { const int r = row + q * NGW;
            if (lane == 0) rstd[r] = 1.f / sqrtf(s[q] * (1.f / 1024.f) + EPS);
            u32x2* o = (u32x2*)(XB + (size_t)r * DM) + lane;
#pragma unroll
            for (int j = 0; j < 4; ++j) { u32x2 w; w.x = pk2(v[q][j][0], v[q][j][1]); w.y = pk2(v[q][j][2], v[q][j][3]); o[64 * j] = w; } }
    }
}

template <bool FUSED> DI void phase2(const Params& p, unsigned char* lds, unsigned* ctl) {
    const int tid = opaque_tid(), lane = tid & 63, wave = tid >> 6, h5 = lane >> 5;
    const bf16_t* KZ = (const bf16_t*)(p.ws + WS_KZ); const bf16_t* V = (const bf16_t*)(p.ws + WS_V); bf16_t* UPD = (bf16_t*)(p.ws + WS_UPD);
    unsigned char* Kimg = lds; unsigned char* Vimg = lds + 32768;
    const int eb = wave & 3, dh = wave >> 2;
    u32x4 pk[4], pv[4];
    if (blockIdx.x < 8 * 63) { const int it = blockIdx.x, bh = it / 63, n = 1 + it % 63; const size_t row0 = (size_t)(bh >> 2) * SEQ + (size_t)(n - 1) * 128;
        tile_ld(pk, KZ + row0 * 512 + (bh & 3) * 128, 512, tid); tile_ld(pv, V + row0 * 512 + (bh & 3) * 128, 512, tid); }
    for (int it = blockIdx.x; it < 8 * 63; it += gridDim.x) {
        const int bh = it / 63, n = 1 + it % 63;
        tile_st(Kimg, pk, tid); tile_st(Vimg, pv, tid);
        __syncthreads();
        { const int it2 = it + gridDim.x; if (it2 < 8 * 63) { const int bh2 = it2 / 63, n2 = 1 + it2 % 63; const size_t row2 = (size_t)(bh2 >> 2) * SEQ + (size_t)(n2 - 1) * 128;
            tile_ld(pk, KZ + row2 * 512 + (bh2 & 3) * 128, 512, tid); tile_ld(pv, V + row2 * 512 + (bh2 & 3) * 128, 512, tid); } }
        f32x16 a0, a1;
#pragma unroll
        for (int i = 0; i < 16; ++i) { a0[i] = 0.f; a1[i] = 0.f; }
#pragma unroll
        for (int ks = 0; ks < 8; ++ks) {
            const bf16x8 av = tr_frag<false>(Vimg, eb, 16 * ks, lane);
            const bf16x8 b0 = tr_frag<false>(Kimg, 2 * dh, 16 * ks, lane), b1 = tr_frag<false>(Kimg, 2 * dh + 1, 16 * ks, lane);
            a0 = MFMA32(av, b0, a0); a1 = MFMA32(av, b1, a1);
        }
        bf16_t* dst = UPD + ((size_t)(bh * 64 + n) * 128 + 32 * eb) * 128 + 64 * dh + (lane & 31);
#pragma unroll
        for (int r = 0; r < 16; ++r) { const int e = crow(r, h5);
            const unsigned pw_ = pk2(a0[r], a1[r]); const bf16_t v0 = (bf16_t)(pw_ & 0xffffu), v1 = (bf16_t)(pw_ >> 16);
            if constexpr (FUSED) { __hip_atomic_store(dst + e * 128, v0, __ATOMIC_RELAXED, __HIP_MEMORY_SCOPE_AGENT); __hip_atomic_store(dst + e * 128 + 32, v1, __ATOMIC_RELAXED, __HIP_MEMORY_SCOPE_AGENT); }
            else { dst[e * 128] = v0; dst[e * 128 + 32] = v1; } }
        if constexpr (FUSED) asm volatile("s_waitcnt vmcnt(0)" ::: "memory");
        __syncthreads();
        if constexpr (FUSED) { if (tid == 0) xb_add(ctl + CW_C2 + 64 * bh, 1u); }
    }
}

#ifdef PROBE_T
#define DSTAMP(k) do { if (blockIdx.x == PROBE_B && threadIdx.x == 0) ((unsigned long long*)(p.ws + 49152))[k] = __builtin_amdgcn_s_memrealtime(); } while (0)
#else
#define DSTAMP(k) do {} while (0)
#endif
template <bool FUSED> DI void phase3(const Params& p, unsigned char* lds, unsigned* ctl) {
    const float* MP = (const float*)(p.ws + WS_MP); const bf16_t* UPD = (const bf16_t*)(p.ws + WS_UPD); bf16_t* TT = (bf16_t*)(p.ws + WS_TT);
    const int tid3 = opaque_tid();
    float* kzL = (float*)lds; float* vL = (float*)(lds + 8192);
    if constexpr (FUSED) {
        const int h = (blockIdx.x >> 5) & 3, e0 = (blockIdx.x & 31) * 4; const float lg = log2_gamma(h);
#pragma unroll
        for (int i = 0; i < 4; ++i) { const int idx = tid3 + 512 * i, m = idx >> 7, d = idx & 127, dl = d & 63;
            const float* mp = MP + m * NPROJ + 5 * 512 + h * 128;
            const float x1 = mp[dl], x2 = mp[64 + dl]; float sn, cs; sincos_rr((float)m * rope_freq(dl), sn, cs);
            kzL[idx] = ((d < 64) ? (x1 * cs - x2 * sn) : (x1 * sn + x2 * cs)) * exp2f((float)(15 - m) * lg); }
        if (tid3 < 64) vL[tid3] = MP[(tid3 >> 2) * NPROJ + 6 * 512 + h * 128 + e0 + (tid3 & 3)];
        if (tid3 == 0) { unsigned* c2 = ctl + CW_C2 + 64 * (blockIdx.x >> 5); unsigned sp = 0u;
            while (xb_ld(c2) < 63u) { __builtin_amdgcn_s_sleep(1); if (++sp > (1u << 22)) break; } }
        __syncthreads();
    }
    DSTAMP(0);
    for (int gid = blockIdx.x * 512 + tid3; gid < 8 * 16384; gid += gridDim.x * 512) {
        const int bh = gid >> 14, idx = gid & 16383, e = idx >> 7, d = idx & 127, h = bh & 3;
        const float lg = log2_gamma(h), cdec = exp2f(128.f * lg);
        const int dl = d & 63; const float fq = rope_freq(dl);
        float s1 = 0.f;
        if constexpr (FUSED) {
#pragma unroll
            for (int m = 0; m < NMETA; ++m) s1 = fmaf(vL[m * 4 + (e & 3)], kzL[m * 128 + d], s1);
        } else {
#pragma unroll 4
        for (int m = 0; m < NMETA; ++m) {
            const float* mp = MP + m * NPROJ;
            const float x1 = mp[5 * 512 + h * 128 + dl], x2 = mp[5 * 512 + h * 128 + 64 + dl];
            float s, c; sincos_rr((float)m * fq, s, c);
            const float kr = (d < 64) ? (x1 * c - x2 * s) : (x1 * s + x2 * c);
            s1 = fmaf(mp[6 * 512 + h * 128 + e] * exp2f((float)(15 - m) * lg), kr, s1);
        }
        }
        DSTAMP(1);
        float T = cdec * s1;
        const bf16_t* up = UPD + (size_t)bh * 64 * 16384 + idx;
        bf16_t* tt = TT + (size_t)bh * 65 * 16384 + idx;
        if constexpr (FUSED) __hip_atomic_store(tt + 16384, (bf16_t)(pk2(T, 0.f) & 0xffffu), __ATOMIC_RELAXED, __HIP_MEMORY_SCOPE_AGENT); else tt[16384] = (bf16_t)(pk2(T, 0.f) & 0xffffu);
        bf16_t u[63];
#pragma unroll
        for (int i = 0; i < 63; ++i) u[i] = up[(size_t)(i + 1) * 16384];
#pragma unroll
        for (int i = 0; i < 63; ++i) { T = cdec * (T + __uint_as_float((unsigned)u[i] << 16)); const bf16_t tv = (bf16_t)(pk2(T, 0.f) & 0xffffu);
            if constexpr (FUSED) __hip_atomic_store(tt + (size_t)(i + 2) * 16384, tv, __ATOMIC_RELAXED, __HIP_MEMORY_SCOPE_AGENT); else tt[(size_t)(i + 2) * 16384] = tv; }
    }
    DSTAMP(2);
    if constexpr (FUSED) {
        asm volatile("s_waitcnt vmcnt(0)" ::: "memory");
        __syncthreads();
        DSTAMP(3);
        if (tid3 == 0) xb_add(ctl + CW_C3 + 64 * (blockIdx.x >> 5), 1u);
    }
}

template <bool FUSED> DI void phase4(const Params& p, unsigned char* lds, unsigned* ctl) {
    const int tid = opaque_tid(), lane = tid & 63, wave = tid >> 6, h5 = lane >> 5;
    const bf16_t* QS = (const bf16_t*)(p.ws + WS_QS); const bf16_t* KZ = (const bf16_t*)(p.ws + WS_KZ); const bf16_t* V = (const bf16_t*)(p.ws + WS_V);
    const bf16_t* SRG = (const bf16_t*)(p.ws + WS_SRG); const bf16_t* TT = (const bf16_t*)(p.ws + WS_TT); bf16_t* MIX = (bf16_t*)(p.ws + WS_MIX);
    unsigned char* Qimg = lds; unsigned char* Kimg = lds + 32768; unsigned char* Vimg = lds + 65536; unsigned char* Timg = lds + 98304;
    float* OL = (float*)lds;
    const int ib = (wave < 4) ? wave : 7 - wave, eh = wave >> 2;
    u32x4 pq[4], pk[4], pv[4], pt[4];
    if (blockIdx.x < 8 * 64) { const int it = blockIdx.x, bh = it >> 6, n = 1 + (it & 63); const size_t row0 = (size_t)(bh >> 2) * SEQ + (size_t)(n - 1) * 128;
        tile_ld(pq, QS + row0 * 512 + (bh & 3) * 128, 512, tid); tile_ld(pk, KZ + row0 * 512 + (bh & 3) * 128, 512, tid); tile_ld(pv, V + row0 * 512 + (bh & 3) * 128, 512, tid);
        if constexpr (FUSED) {
            if (tid == 0) { unsigned* c3 = ctl + CW_C3 + 64 * bh; unsigned sp = 0u; while (xb_ld(c3) < 32u) { __builtin_amdgcn_s_sleep(1); if (++sp > (1u << 22)) break; } }
            __syncthreads();
        }
        tile_ld(pt, TT + ((size_t)bh * 65 + n) * 16384, 128, tid); }
    for (int it = blockIdx.x; it < 8 * 64; it += gridDim.x) {
        const int bh = it >> 6, n = 1 + (it & 63), b = bh >> 2, h = bh & 3;
        const size_t row0 = (size_t)b * SEQ + (size_t)(n - 1) * 128;
        const int it2 = it + gridDim.x;
        tile_st(Qimg, pq, tid); tile_st(Kimg, pk, tid); tile_st(Vimg, pv, tid); tile_st(Timg, pt, tid);
        if constexpr (FUSED) { if (it2 < 8 * 64 && tid == 0) { unsigned* c3 = ctl + CW_C3 + 64 * (it2 >> 6); unsigned sp = 0u; while (xb_ld(c3) < 32u) { __builtin_amdgcn_s_sleep(1); if (++sp > (1u << 22)) break; } } }
        u32x4 sgv[4];
        { const int rown = tid >> 2, partn = tid & 3;
            const u32x4* sp = (const u32x4*)(SRG + (row0 + rown) * 512 + h * 128 + 32 * partn);
#pragma unroll
            for (int k = 0; k < 4; ++k) sgv[k] = sp[k]; }
        __syncthreads();
        if (it2 < 8 * 64) { const int bh2 = it2 >> 6, n2 = 1 + (it2 & 63); const size_t row2 = (size_t)(bh2 >> 2) * SEQ + (size_t)(n2 - 1) * 128;
            tile_ld(pq, QS + row2 * 512 + (bh2 & 3) * 128, 512, tid); tile_ld(pk, KZ + row2 * 512 + (bh2 & 3) * 128, 512, tid); tile_ld(pv, V + row2 * 512 + (bh2 & 3) * 128, 512, tid);
            tile_ld(pt, TT + ((size_t)bh2 * 65 + n2) * 16384, 128, tid); }
        bf16x8 qf[8];
#pragma unroll
        for (int s = 0; s < 8; ++s) qf[s] = row_frag(Qimg, ib, s, lane);
        f32x16 O0, O1;
#pragma unroll
        for (int i = 0; i < 16; ++i) { O0[i] = 0.f; O1[i] = 0.f; }
#pragma unroll
        for (int jb = 0; jb < 4; ++jb) {
            if (jb <= ib) {
                f32x16 c;
#pragma unroll
                for (int i = 0; i < 16; ++i) c[i] = 0.f;
#pragma unroll
                for (int s = 0; s < 8; ++s) c = MFMA32(row_frag(Kimg, jb, s, lane), qf[s], c);
                if (jb == ib) {
#pragma unroll
                    for (int r = 0; r < 16; ++r) if (crow(r, h5) > (lane & 31)) c[r] = 0.f;
                }
#pragma unroll
                for (int s2 = 0; s2 < 2; ++s2) {
                    u32x4 pw; pw.x = pk2(c[8 * s2 + 0], c[8 * s2 + 1]); pw.y = pk2(c[8 * s2 + 2], c[8 * s2 + 3]); pw.z = pk2(c[8 * s2 + 4], c[8 * s2 + 5]); pw.w = pk2(c[8 * s2 + 6], c[8 * s2 + 7]);
                    const bf16x8 pa = __builtin_bit_cast(bf16x8, pw);
                    const bf16x8 v0 = tr_frag<true>(Vimg, 2 * eh, 32 * jb + 16 * s2, lane), v1 = tr_frag<true>(Vimg, 2 * eh + 1, 32 * jb + 16 * s2, lane);
                    O0 = MFMA32(pa, v0, O0); O1 = MFMA32(pa, v1, O1);
                }
            }
        }
#pragma unroll
        for (int s = 0; s < 8; ++s) { O0 = MFMA32(qf[s], row_frag(Timg, 2 * eh, s, lane), O0); O1 = MFMA32(qf[s], row_frag(Timg, 2 * eh + 1, s, lane), O1); }
        __syncthreads();
        {
            float* o = OL + (32 * ib) * 132 + 64 * eh + (lane & 31);
#pragma unroll
            for (int r = 0; r < 16; ++r) { const int i = crow(r, h5); o[i * 132] = O0[r]; o[i * 132 + 32] = O1[r]; }
        }
        __syncthreads();
        {
            const int row = tid >> 2, part = tid & 3;
            const float* o = OL + row * 132 + 32 * part;
            f32x4 v[8]; float s = 0.f;
#pragma unroll
            for (int k = 0; k < 8; ++k) { v[k] = *(const f32x4*)(o + 4 * k); s += (v[k][0] + v[k][1]) + (v[k][2] + v[k][3]); }
            s += __shfl_xor(s, 1); s += __shfl_xor(s, 2);
            const float mu = s * (1.f / 128.f); float q = 0.f;
#pragma unroll
            for (int k = 0; k < 8; ++k) { v[k] = v[k] - mu; q += (v[k][0] * v[k][0] + v[k][1] * v[k][1]) + (v[k][2] * v[k][2] + v[k][3] * v[k][3]); }
            q += __shfl_xor(q, 1); q += __shfl_xor(q, 2);
            const float rs = 1.f / sqrtf(q * (1.f / 128.f) + EPS);
            const size_t grow = row0 + row;
            u32x4* dp = (u32x4*)(MIX + grow * 1024 + 512 + h * 128 + 32 * part);
            const f32x4* gp = (const f32x4*)(p.rg + h * 128 + 32 * part);
#pragma unroll
            for (int k2 = 0; k2 < 4; ++k2) {
                const u32x4 sg = sgv[k2]; const f32x4 g0 = gp[2 * k2], g1 = gp[2 * k2 + 1];
                const f32x4 a = v[2 * k2], c2 = v[2 * k2 + 1];
                u32x4 w;
                w.x = pk2(a[0] * rs * g0[0] * bf_lo(sg.x), a[1] * rs * g0[1] * bf_hi(sg.x));
                w.y = pk2(a[2] * rs * g0[2] * bf_lo(sg.y), a[3] * rs * g0[3] * bf_hi(sg.y));
                w.z = pk2(c2[0] * rs * g1[0] * bf_lo(sg.z), c2[1] * rs * g1[1] * bf_hi(sg.z));
                w.w = pk2(c2[2] * rs * g1[2] * bf_lo(sg.w), c2[3] * rs * g1[3] * bf_hi(sg.w));
                if constexpr (FUSED) store16_sc1(dp + k2, w); else dp[k2] = w;
            }
        }
        if constexpr (FUSED) asm volatile("s_waitcnt vmcnt(0)" ::: "memory");
        __syncthreads();
        if constexpr (FUSED) { if (tid == 0) xb_add(ctl + CW_P5 + 64 * (b * 32 + ((n - 1) >> 1)), 1u); }
    }
}

DI void phase_convfix(const Params& p, unsigned* ctl) {
    const int tid = opaque_tid();
    const float* halo = (const float*)(p.ws + WS_HALO); const float* MP = (const float*)(p.ws + WS_MP); bf16_t* MIX = (bf16_t*)(p.ws + WS_MIX);
    for (int pm = blockIdx.x; pm < 64; pm += gridDim.x) {
        const int ch = tid;
        float um1, um2;
        if ((pm & 31) == 0) { um2 = MP[14 * NPROJ + ch] * MP[14 * NPROJ + 1024 + ch]; um1 = MP[15 * NPROJ + ch] * MP[15 * NPROJ + 1024 + ch]; }
        else { um2 = halo[((size_t)((pm - 1) * 3 + 2) * 2 + 0) * 512 + ch]; um1 = halo[((size_t)((pm - 1) * 3 + 2) * 2 + 1) * 512 + ch]; }
        const float w0 = p.conv_w[ch], w1 = p.conv_w[512 + ch];
        const float c0 = halo[((size_t)(pm * 3 + 0) * 2 + 0) * 512 + ch] + w0 * um2 + w1 * um1;
        const float c1 = halo[((size_t)(pm * 3 + 0) * 2 + 1) * 512 + ch] + w0 * um1;
        const float g0 = halo[((size_t)(pm * 3 + 1) * 2 + 0) * 512 + ch], g1 = halo[((size_t)(pm * 3 + 1) * 2 + 1) * 512 + ch];
        __hip_atomic_store(MIX + (size_t)(pm * 256) * 1024 + ch, (bf16_t)(pk2(g0 * c0, 0.f) & 0xffffu), __ATOMIC_RELAXED, __HIP_MEMORY_SCOPE_AGENT);
        __hip_atomic_store(MIX + (size_t)(pm * 256 + 1) * 1024 + ch, (bf16_t)(pk2(g1 * c1, 0.f) & 0xffffu), __ATOMIC_RELAXED, __HIP_MEMORY_SCOPE_AGENT);
        asm volatile("s_waitcnt vmcnt(0)" ::: "memory");
        __syncthreads();
        if (tid == 0) xb_add(ctl + CW_P5 + 64 * pm, 256u);
    }
}

DI void phase6(const Params& p) {
    const int tid = opaque_tid(), lane = tid & 63, wave = tid >> 6;
    const float* part = (const float*)(p.ws + WS_PART);
    const int gw = blockIdx.x * 8 + wave, NGW = gridDim.x * 8;
    f32x4 g[4];
#pragma unroll
    for (int j = 0; j < 4; ++j) g[j] = ((const f32x4*)p.gf)[lane + 64 * j];
    for (int row = gw; row < M_TOK; row += NGW) {
        float s = (lane < 16) ? part[(size_t)lane * M_TOK + row] : 0.f;
        s = wave_sum(s);
        const float rs = 1.f / sqrtf(s * (1.f / 1024.f) + EPS);
        f32x4* o = (f32x4*)(p.out + (size_t)row * DM) + lane;
#pragma unroll
        for (int j = 0; j < 4; ++j) { f32x4 v = o[64 * j]; v = v * rs * g[j]; o[64 * j] = v; }
    }
}

#ifndef DUP
#define DUP -1
#endif
#define REP(k) for (int rep_ = 0; rep_ < ((DUP == (k)) ? 2 : 1); ++rep_)
__global__ void __launch_bounds__(512, 2) hymba_fwd(Params p) {
    extern __shared__ __attribute__((aligned(16))) unsigned char lds[];
#ifdef USE_CG_FALLBACK
    cg::grid_group grid = cg::this_grid();
#endif
    unsigned char* ws = p.ws;
    unsigned* ctl = (unsigned*)ws;
    const bool fast = (gridDim.x == 256);
    volatile LAS unsigned* st = (volatile LAS unsigned*)((LAS unsigned char*)lds + 131072);
    if (threadIdx.x < 4) st[threadIdx.x] = 0u;
    __syncthreads();
    XcdBarrier bar = xcd_barrier_post(ctl, st);
#ifdef USE_CG_FALLBACK
#define GSYNC() grid.sync()
#else
#define GSYNC() xcd_barrier(bar)
#endif
#define SEAM() do { if (fast) xcd_barrier(bar); else GSYNC(); } while (0)
#ifdef PROBE_T
    unsigned long long ts_[12]; int nts_ = 0;
#define STAMP() do { ts_[nts_++] = __builtin_amdgcn_s_memrealtime(); } while (0)
#else
#define STAMP() do {} while (0)
#endif
    STAMP();
    for (int pass_ = 0; pass_ < ((DUP == 9) ? 2 : 1); ++pass_) {
    REP(0) { phase0(p, lds); __syncthreads(); }
    STAMP();
    SEAM();
    STAMP();
    if (DUP == 7) { for (int i_ = 0; i_ < 6; ++i_) SEAM(); }
    REP(1) {
        pg8::Gemm g{(const bf16_t*)(ws + WS_XB), (const bf16_t*)(ws + WS_WIN), M_TOK, NPROJ, DM};
        pg8::StaticOrder S; S.init(M_TOK, NPROJ, (int)gridDim.x, (int)blockIdx.x);
        EpiProj E{(const float*)(ws + WS_RSTD), (bf16_t*)(ws + WS_MIX), (bf16_t*)(ws + WS_QS), (bf16_t*)(ws + WS_KZ), (bf16_t*)(ws + WS_V), (bf16_t*)(ws + WS_SRG), p.conv_w, (float*)(ws + WS_HALO), (LAS unsigned char*)lds + 131072 + 2048};
        pg8::gemm_phase<EpiProj, pg8::StaticOrder, true, true>((LAS unsigned char*)lds, g, S, E);
    }
    STAMP();
    SEAM();
    STAMP();
    if (fast) {
        phase2<true>(p, lds, ctl);
        STAMP();
        phase_convfix(p, ctl);
        STAMP();
        phase3<true>(p, lds, ctl);
        STAMP();
        phase4<true>(p, lds, ctl);
    } else {
        phase2<false>(p, lds, ctl);
        GSYNC();
        phase3<false>(p, lds, ctl);
        GSYNC();
        phase4<false>(p, lds, ctl);
        phase_convfix(p, ctl);
    }
    STAMP();
    if (!fast) SEAM();
    STAMP();
    if (fast) REP(5) {
        pg8::Gemm g{(const bf16_t*)(ws + WS_MIX), (const bf16_t*)(ws + WS_WOUT), M_TOK, DM, DM};
        pg8::PanelOrder S; S.init(M_TOK, DM, (int)gridDim.x, (int)blockIdx.x); S.cnt = ctl + CW_P5;
        EpiOutNorm E{p.x, p.out, p.gf, (float*)(ws + WS_PART), ctl};
        {
            pg8::Unit u0; (void)S.next(0, u0);
            if (threadIdx.x == 0) { unsigned* c5 = ctl + CW_P5 + 64 * u0.pm; unsigned sp = 0u; while (xb_ld(c5) < 256u) { __builtin_amdgcn_s_sleep(1); if (++sp > (1u << 22)) break; } }
            __syncthreads();
        }
        pg8::gemm_phase<EpiOutNorm, pg8::PanelOrder, false, true, false>((LAS unsigned char*)lds, g, S, E);
    } else {
        pg8::Gemm g{(const bf16_t*)(ws + WS_MIX), (const bf16_t*)(ws + WS_WOUT), M_TOK, DM, DM};
        pg8::StaticOrder S; S.init(M_TOK, DM, (int)gridDim.x, (int)blockIdx.x);
        EpiOut E{p.x, p.out, (float*)(ws + WS_PART)};
        pg8::gemm_phase<EpiOut, pg8::StaticOrder, true, true>((LAS unsigned char*)lds, g, S, E);
        GSYNC();
        phase6(p);
    }
    if (DUP == 9) SEAM();
    }
#ifdef PROBE_T
    STAMP(); SEAM();
    if (blockIdx.x == PROBE_B && threadIdx.x == 0) { const unsigned long long* ds_ = (const unsigned long long*)(p.ws + 49152);
        p.out[0] = (PROBE_T >= 100) ? (float)(ds_[PROBE_T - 99] - ds_[PROBE_T - 100]) * 0.01f : (PROBE_T == 99) ? (float)(ds_[0] - ts_[6]) * 0.01f : (PROBE_T == 98) ? (float)(ts_[10] - ts_[0]) * 0.001f : (float)(ts_[PROBE_T + 1] - ts_[PROBE_T]) * 0.01f; }
#endif
}

extern "C" void kernel_launch(void* const* d_in, const int* in_sizes, int n_in, void* d_out, int out_size, void* d_ws, size_t ws_size, hipStream_t stream) {
    static int grid = 0;
    if (grid == 0) {
        if (n_in != 8 || in_sizes[0] != M_TOK * DM || out_size != M_TOK * DM || ws_size < WS_END) { fprintf(stderr, "kernel_launch: unexpected shapes (n_in %d, in0 %d, out %d, ws %zu)\n", n_in, n_in > 0 ? in_sizes[0] : -1, out_size, ws_size); grid = -1; return; }
        int dev = 0, cus = 0, per_cu = 0;
        hipGetDevice(&dev);
        hipDeviceGetAttribute(&cus, hipDeviceAttributeMultiprocessorCount, dev);
        if (hipFuncSetAttribute((const void*)hymba_fwd, hipFuncAttributeMaxDynamicSharedMemorySize, LDS_BYTES) != hipSuccess) { fprintf(stderr, "kernel_launch: hipFuncSetAttribute failed\n"); grid = -1; return; }
        if (hipOccupancyMaxActiveBlocksPerMultiprocessor(&per_cu, (const void*)hymba_fwd, 512, LDS_BYTES) != hipSuccess || per_cu < 1) { fprintf(stderr, "kernel_launch: occupancy query gave %d\n", per_cu); (void)hipGetLastError(); per_cu = 1; }
        grid = cus * per_cu;
        if (grid > 256) grid = 256;
    }
    if (grid < 0) return;
    Params p{};
    p.x = (const float*)d_in[0]; p.meta = (const float*)d_in[1]; p.g1 = (const float*)d_in[2]; p.w_in = (const float*)d_in[3];
    p.conv_w = (const float*)d_in[4]; p.rg = (const float*)d_in[5]; p.w_out = (const float*)d_in[6]; p.gf = (const float*)d_in[7];
    p.out = (float*)d_out; p.ws = (unsigned char*)d_ws;
    if (hipMemsetAsync(d_ws, 0, CTL_ZERO_BYTES, stream) != hipSuccess) { fprintf(stderr, "kernel_launch: hipMemsetAsync failed\n"); return; }
    void* args[] = {&p};
#ifdef PLAIN_LAUNCH
    (void)args; hipLaunchKernelGGL(hymba_fwd, dim3(grid), dim3(512), LDS_BYTES, stream, p); hipError_t e = hipPeekAtLastError();
#else
    hipError_t e = hipLaunchCooperativeKernel((const void*)hymba_fwd, dim3(grid), dim3(512), args, LDS_BYTES, stream);
#endif
    if (e != hipSuccess) fprintf(stderr, "cooperative launch failed: %s (grid %d)\n", hipGetErrorString(e), grid);
}
```

```cpp
#include <hip/hip_runtime.h>
#include <hip/hip_cooperative_groups.h>
#include <cstdio>
#include <cstdint>
namespace cg = cooperative_groups;

#define DI __device__ __forceinline__
#define LAS __attribute__((address_space(3)))
typedef unsigned short bf16_t;
typedef short bf16x8 __attribute__((ext_vector_type(8)));
typedef short s16x4 __attribute__((ext_vector_type(4)));
typedef short v4i16_t __attribute__((ext_vector_type(4)));
typedef float f32x2 __attribute__((ext_vector_type(2)));
typedef float f32x4 __attribute__((ext_vector_type(4)));
typedef float f32x16 __attribute__((ext_vector_type(16)));
typedef unsigned u32x2 __attribute__((ext_vector_type(2)));
typedef unsigned u32x4 __attribute__((ext_vector_type(4)));
typedef __bf16 bf16x2_t __attribute__((ext_vector_type(2)));

constexpr int M_TOK = 16384, DM = 1024, NPROJ = 4096, SEQ = 8192, NMETA = 16, NCHUNK = 64;
constexpr float EPS = 1e-6f;

constexpr size_t MiB = 1u << 20;
constexpr size_t WS_RSTD = 64 * 1024, WS_MP = 128 * 1024, WS_PART = 1 * MiB, WS_WIN = 2 * MiB, WS_WOUT = 10 * MiB, WS_XB = 16 * MiB;
constexpr size_t WS_HALO = 12 * MiB;
constexpr size_t WS_U = 48 * MiB, WS_G = 64 * MiB, WS_QS = 80 * MiB, WS_KZ = 96 * MiB, WS_V = 112 * MiB, WS_SRG = 128 * MiB;
constexpr size_t WS_UPD = 144 * MiB, WS_TT = 176 * MiB, WS_MIX = 194 * MiB, WS_END = 226 * MiB;
constexpr int LDS_BYTES = 147456;

DI unsigned pk2(float lo, float hi) { f32x2 v = {lo, hi}; bf16x2_t b = __builtin_convertvector(v, bf16x2_t); return __builtin_bit_cast(unsigned, b); }
DI float bf_lo(unsigned u) { return __uint_as_float(u << 16); }
DI float bf_hi(unsigned u) { return __uint_as_float(u & 0xffff0000u); }
DI float silu_f(float x) { return x * __builtin_amdgcn_rcpf(1.f + __expf(-x)); }
DI float wave_sum(float v) {
#pragma unroll
    for (int o = 1; o < 64; o <<= 1) v += __shfl_xor(v, o);
    return v;
}
DI void sincos_rr(float ang, float& s, float& c) {
    const float k = rintf(ang * 0.15915494309189535f);
    float r = fmaf(-k, 6.2831854820251465f, ang);
    r = fmaf(-k, -1.7484555e-7f, r);
    const float rev = r * 0.15915494309189535f;
    s = __builtin_amdgcn_sinf(rev); c = __builtin_amdgcn_cosf(rev);
}
DI int opaque_tid() { int t = threadIdx.x; asm volatile("" : "+v"(t)); return t; }
DI float rope_freq(int d) { return exp2f(-(float)d * (13.287712379549449f / 64.f)); }
DI float log2_gamma(int h) { return log2f(1.f - exp2f(-5.f - (float)h)); }

namespace pg8 {
constexpr int BM = 256, BK = 64, HALF = 128, HTB = HALF * BK * 2, STAGE_BYTES = 8 * HTB, NXCD = 8, WGM = 8;
DI int lds_byte(int r, int c) { const int st = (r >> 4) * 2 + (c >> 5), rr = r & 15, cc = c & 31, ob = rr * 64 + cc * 2; return st * 1024 + (ob ^ (((ob >> 9) & 1) << 5)); }
DI void stage_rc(int b, int& R, int& C) { const int st = b / 1024, sb = b % 1024, swz = sb ^ (((sb >> 9) & 1) << 5); R = (st >> 1) * 16 + swz / 64; C = (st & 1) * 32 + (swz % 64) / 2; }
DI int perm32(int rho) { const int n = rho >> 4, i = rho & 15; return 8 * (i >> 2) + 4 * n + (i & 3); }
struct Unit { int pm, pn; };
struct Gemm { const bf16_t* A; const bf16_t* Bt; int M, N, K; };
struct StaticOrder {
    int nM, nN, nwg, G, c;
    DI void init(int M, int N, int G_, int c_) { nM = M / BM; nN = N / BM; nwg = nM * nN; G = G_; c = c_; }
    DI bool next(int i, Unit& u) const {
        const long L = (long)i * G + c; if (L >= nwg) return false;
        int wgid = (int)L; { const int q = nwg / NXCD, r = nwg % NXCD, xcd = wgid % NXCD, off = wgid / NXCD; wgid = (xcd < r ? xcd * (q + 1) : r * (q + 1) + (xcd - r) * q) + off; }
        const int nig = WGM * nN, gid = wgid / nig, fm = gid * WGM, gsz = (nM - fm) < WGM ? (nM - fm) : WGM;
        u.pm = fm + ((wgid % nig) % gsz); u.pn = (wgid % nig) / gsz; return true;
    }
    DI void a_ready(const Unit&) const {}
    DI void done(const Unit&) const {}
    DI void mid(const Unit&, int) const {}
};
struct PanelOrder : StaticOrder {
    unsigned* cnt;
    DI void mid(const Unit& u, int t) const {
        if (t == 6) { if ((threadIdx.x & 63) == 0) { unsigned* c5 = cnt + 64 * u.pm; unsigned sp = 0u;
            while ((__hip_atomic_load(c5, __ATOMIC_RELAXED, __HIP_MEMORY_SCOPE_AGENT) & 255u) < 8u) { __builtin_amdgcn_s_sleep(1); if (++sp > (1u << 22)) break; } } }
    }
};

template <class Epi, class Sched, bool ALIGN_EPI = false, bool SP2 = false, bool TOUCH = false>
DI void gemm_phase(LAS unsigned char* lds, const Gemm g, const Sched& S, const Epi& E, const char* tbase = nullptr, size_t tpitch = 0, unsigned dump_off = 0) {
    const int tid = opaque_tid(), wid = __builtin_amdgcn_readfirstlane(tid >> 6), lane = tid & 63, wr = wid >> 2, wc = wid & 3, fr = lane & 15, fq = lane >> 4;
    const int K = g.K, nt = K / BK;
    unsigned voffA[2], voffB[2];
#pragma unroll
    for (int i = 0; i < 2; ++i) { int R, C; stage_rc(tid * 16 + i * 8192, R, C); const int Rb = Epi::PERM ? ((R & ~31) + perm32(R & 31)) : R;
        voffA[i] = (unsigned)(R * K + C) * 2u; voffB[i] = (unsigned)(Rb * K + C) * 2u; }
    const size_t kstep = (size_t)(BK * 2);
    const size_t hstep = (size_t)HALF * K * 2;
    const size_t tstep = 2 * hstep;
    const unsigned ldsw = (unsigned)wid * 1024u;
    const int aoff = lds_byte(wr * 64 + fr, fq * 8), boff = lds_byte(wc * 32 + fr, fq * 8);
#define PG8_SA(b, h) (((b) * 2 + (h)) * HTB)
#define PG8_SB(b, h) ((4 + (b) * 2 + (h)) * HTB)
#define PG8_STAGE(bufoff, gbase, voff) do { _Pragma("unroll") for (int _i = 0; _i < 2; ++_i) \
        __builtin_amdgcn_global_load_lds((const unsigned*)((const char*)(gbase) + (voff)[_i]), (LAS unsigned*)(lds + (bufoff) + ldsw + _i * 8192), 16, 0, 0); } while (0)
#define PG8_LDA(dst, b, h) do { _Pragma("unroll") for (int m = 0; m < 4; ++m) _Pragma("unroll") for (int k = 0; k < 2; ++k) dst[m][k] = *(const LAS bf16x8*)(lds + PG8_SA(b, h) + aoff + m * 2048 + k * 1024); } while (0)
#define PG8_LDB(dst, b, h) do { _Pragma("unroll") for (int n = 0; n < 2; ++n) _Pragma("unroll") for (int k = 0; k < 2; ++k) dst[n][k] = *(const LAS bf16x8*)(lds + PG8_SB(b, h) + boff + n * 2048 + k * 1024); } while (0)
#define PG8_MMA(ai, bj, At, Bt) do { __builtin_amdgcn_s_setprio(1); _Pragma("unroll") for (int m = 0; m < 4; ++m) _Pragma("unroll") for (int n = 0; n < 2; ++n) _Pragma("unroll") for (int k = 0; k < 2; ++k) \
        acc[ai][bj][m][n] = __builtin_amdgcn_mfma_f32_16x16x32_bf16(Bt[n][k], At[m][k], acc[ai][bj][m][n], 0, 0, 0); __builtin_amdgcn_s_setprio(0); } while (0)
#define PG8_WAIT_V(n) asm volatile("s_waitcnt vmcnt(" #n ")" ::: "memory")
#define PG8_WAIT_SP() do { if constexpr (TOUCH) PG8_WAIT_V(10); else PG8_WAIT_V(8); } while (0)
#define PG8_TOUCH(j) do { if constexpr (TOUCH) __builtin_amdgcn_global_load_lds((const unsigned*)(tptr + (size_t)(j) * tpitch), (LAS unsigned*)(lds + dump_off + ldsw), 16, 0, 0); } while (0)
#define PG8_WAIT_L(n) asm volatile("s_waitcnt lgkmcnt(" #n ")" ::: "memory")
#define PG8_BAR __builtin_amdgcn_s_barrier()
#define PG8_SCHED __builtin_amdgcn_sched_barrier(0)
    Unit cur, nxt; int ui = 0;
    if (!S.next(0, cur)) return;
    const char* tptr = nullptr;
    if constexpr (TOUCH) tptr = tbase + ((size_t)cur.pm * 256 + (size_t)wid * 32) * tpitch + (size_t)cur.pn * 1024 + (size_t)lane * 16;
    f32x4 acc[2][2][4][2];
#pragma unroll
    for (int a = 0; a < 2; ++a)
#pragma unroll
        for (int b = 0; b < 2; ++b)
#pragma unroll
            for (int m = 0; m < 4; ++m)
#pragma unroll
                for (int n = 0; n < 2; ++n) acc[a][b][m][n] = (f32x4){0.f, 0.f, 0.f, 0.f};
    bf16x8 At[4][2], B0[2][2], B1[2][2];
    const char* cA = (const char*)g.A + (size_t)cur.pm * tstep; const char* cB = (const char*)g.Bt + (size_t)cur.pn * tstep;
    S.a_ready(cur);
    if constexpr (SP2) {
        PG8_STAGE(PG8_SB(0, 0), cB, voffB); PG8_STAGE(PG8_SB(0, 1), cB + hstep, voffB); PG8_STAGE(PG8_SA(0, 0), cA, voffA); PG8_STAGE(PG8_SA(0, 1), cA + hstep, voffA);
        if (wr == 1) PG8_BAR;
        PG8_WAIT_V(2); PG8_BAR;
        PG8_STAGE(PG8_SB(1, 0), cB + kstep, voffB); PG8_STAGE(PG8_SA(1, 0), cA + kstep, voffA); PG8_STAGE(PG8_SB(1, 1), cB + hstep + kstep, voffB);
        PG8_WAIT_V(6); PG8_BAR;
    } else {
        PG8_STAGE(PG8_SB(0, 0), cB, voffB); PG8_STAGE(PG8_SA(0, 0), cA, voffA); PG8_STAGE(PG8_SB(0, 1), cB + hstep, voffB); PG8_STAGE(PG8_SA(0, 1), cA + hstep, voffA);
        if (wr == 1) PG8_BAR;
        PG8_WAIT_V(4); PG8_BAR;
        PG8_STAGE(PG8_SB(1, 0), cB + kstep, voffB); PG8_STAGE(PG8_SA(1, 0), cA + kstep, voffA); PG8_STAGE(PG8_SB(1, 1), cB + hstep + kstep, voffB);
        PG8_WAIT_V(6); PG8_BAR;
    }
    for (;;) {
        const bool has_next = S.next(ui + 1, nxt);
        const char* nA = has_next ? (const char*)g.A + (size_t)nxt.pm * tstep : cA; const char* nB = has_next ? (const char*)g.Bt + (size_t)nxt.pn * tstep : cB;
        for (int t = 0; t < nt; t += 2) {
            S.mid(cur, t);
            const bool last = (t == nt - 2);
            const char* a1 = cA + (size_t)(t + 1) * kstep;
            const char* a2 = last ? nA : cA + (size_t)(t + 2) * kstep; const char* b2 = last ? nB : cB + (size_t)(t + 2) * kstep;
            const char* a3 = a2 + kstep; const char* b3 = b2 + kstep;
            if (last && has_next) S.a_ready(nxt);
            if constexpr (SP2) {
            PG8_LDB(B0, 0, 0); PG8_LDB(B1, 0, 1); PG8_SCHED; PG8_LDA(At, 0, 0); PG8_STAGE(PG8_SA(1, 1), a1 + hstep, voffA); PG8_TOUCH(2 * t);
            PG8_WAIT_SP(); PG8_WAIT_L(0); PG8_BAR; PG8_MMA(0, 0, At, B0); PG8_MMA(0, 1, At, B1); PG8_BAR; PG8_SCHED;
            PG8_LDA(At, 0, 1); PG8_STAGE(PG8_SB(0, 0), b2, voffB); PG8_STAGE(PG8_SB(0, 1), b2 + hstep, voffB); PG8_STAGE(PG8_SA(0, 0), a2, voffA); PG8_TOUCH(2 * t + 1);
            PG8_WAIT_SP(); PG8_WAIT_L(0); PG8_BAR; PG8_MMA(1, 0, At, B0); PG8_MMA(1, 1, At, B1); PG8_BAR; PG8_SCHED;
            PG8_LDB(B0, 1, 0); PG8_LDB(B1, 1, 1); PG8_SCHED; PG8_LDA(At, 1, 0); PG8_STAGE(PG8_SA(0, 1), a2 + hstep, voffA); PG8_TOUCH(2 * t + 2);
            PG8_WAIT_SP(); PG8_WAIT_L(0); PG8_BAR; PG8_MMA(0, 0, At, B0); PG8_MMA(0, 1, At, B1); PG8_BAR; PG8_SCHED;
            PG8_LDA(At, 1, 1); PG8_STAGE(PG8_SB(1, 0), b3, voffB); PG8_STAGE(PG8_SB(1, 1), b3 + hstep, voffB); PG8_STAGE(PG8_SA(1, 0), a3, voffA); PG8_TOUCH(2 * t + 3);
            PG8_WAIT_SP(); PG8_WAIT_L(0); PG8_BAR; PG8_MMA(1, 0, At, B0); PG8_MMA(1, 1, At, B1); PG8_BAR; PG8_SCHED;
            } else {
            PG8_LDB(B0, 0, 0); PG8_SCHED; PG8_LDA(At, 0, 0); PG8_STAGE(PG8_SA(1, 1), a1 + hstep, voffA);
            PG8_WAIT_L(8); PG8_BAR; PG8_WAIT_L(0); PG8_MMA(0, 0, At, B0); PG8_BAR; PG8_SCHED;
            PG8_LDB(B1, 0, 1); PG8_STAGE(PG8_SB(0, 0), b2, voffB);
            PG8_BAR; PG8_WAIT_L(0); PG8_MMA(0, 1, At, B1); PG8_BAR;
            PG8_LDA(At, 0, 1); PG8_STAGE(PG8_SA(0, 0), a2, voffA);
            PG8_BAR; PG8_WAIT_L(0); PG8_MMA(1, 0, At, B0); PG8_BAR; PG8_SCHED;
            PG8_STAGE(PG8_SB(0, 1), b2 + hstep, voffB);
            PG8_WAIT_V(6); PG8_BAR; PG8_MMA(1, 1, At, B1); PG8_BAR;
            PG8_LDB(B0, 1, 0); PG8_SCHED; PG8_LDA(At, 1, 0); PG8_STAGE(PG8_SA(0, 1), a2 + hstep, voffA);
            PG8_WAIT_L(8); PG8_BAR; PG8_WAIT_L(0); PG8_MMA(0, 0, At, B0); PG8_BAR; PG8_SCHED;
            PG8_LDB(B1, 1, 1); PG8_STAGE(PG8_SB(1, 0), b3, voffB);
            PG8_BAR; PG8_WAIT_L(0); PG8_MMA(0, 1, At, B1); PG8_BAR;
            PG8_LDA(At, 1, 1); PG8_STAGE(PG8_SA(1, 0), a3, voffA);
            PG8_BAR; PG8_WAIT_L(0); PG8_MMA(1, 0, At, B0); PG8_BAR; PG8_SCHED;
            PG8_STAGE(PG8_SB(1, 1), b3 + hstep, voffB);
            PG8_WAIT_V(6); PG8_BAR; PG8_MMA(1, 1, At, B1); PG8_BAR;
            }
        }
        if constexpr (ALIGN_EPI) { if (wr == 0) PG8_BAR; }
        if constexpr (!Epi::AFTER_DRAIN) { E(acc, cur, wr, wc, fr, fq); S.done(cur); }
        if (!has_next) break;
#pragma unroll
        for (int a = 0; a < 2; ++a)
#pragma unroll
            for (int b = 0; b < 2; ++b)
#pragma unroll
                for (int m = 0; m < 4; ++m)
#pragma unroll
                    for (int n = 0; n < 2; ++n) acc[a][b][m][n] = (f32x4){0.f, 0.f, 0.f, 0.f};
        cur = nxt; cA = nA; cB = nB; ++ui;
        if constexpr (ALIGN_EPI) { if (wr == 1) PG8_BAR; }
    }
    PG8_WAIT_V(0);
    if constexpr (!ALIGN_EPI) { if (wr == 0) PG8_BAR; }
    PG8_BAR;
    if constexpr (Epi::AFTER_DRAIN) { E.fused(acc, cur, wr, wc, fr, fq, lds, wid, lane); S.done(cur); }
#undef PG8_SA
#undef PG8_SB
#undef PG8_STAGE
#undef PG8_LDA
#undef PG8_LDB
#undef PG8_MMA
#undef PG8_WAIT_V
#undef PG8_WAIT_SP
#undef PG8_TOUCH
#undef PG8_WAIT_L
#undef PG8_BAR
#undef PG8_SCHED
}
}


#define XB_TMO      128
#define XB_XCNT(j)  (256  + 64 * (j))
#define XB_XSUB(j)  (1280 + 64 * (j))
#define XB_XGEN(j)  (2304 + 64 * (j))
#define XB_TOP      3328
#define XB_TOPGEN   3392
#define XCD_BAR_WORDS 3456
#define XB_SPIN_CAP (1u << 18)
constexpr int CW_PANEL = 4096, CW_C2 = 8192, CW_C3 = 8192 + 512, CW_P5 = 9216;
constexpr size_t CTL_ZERO_BYTES = 57344;
DI unsigned xb_ld(unsigned* p)              { return __hip_atomic_load(p, __ATOMIC_RELAXED, __HIP_MEMORY_SCOPE_AGENT); }
DI unsigned xb_add(unsigned* p, unsigned v) { return __hip_atomic_fetch_add(p, v, __ATOMIC_RELAXED, __HIP_MEMORY_SCOPE_AGENT); }
DI unsigned xb_xcc_id() { return (unsigned)__builtin_amdgcn_s_getreg((3 << 11) | 20) & 0xFu; }
#define XB_SPIN(cond, bar) do { unsigned _sp = 0; while (cond) { __builtin_amdgcn_s_sleep(1); \
    if ((++_sp & 255u) == 0u) { if (xb_ld(&(bar)[XB_TMO])) break; if (_sp > XB_SPIN_CAP) { atomicAdd(&(bar)[XB_TMO], 1u); break; } } } } while (0)
struct XcdBarrier { unsigned* bar; unsigned x; volatile LAS unsigned* st; };
DI XcdBarrier xcd_barrier_post(unsigned* bar, volatile LAS unsigned* st) {
    XcdBarrier b; b.bar = bar; b.x = xb_xcc_id(); b.st = st;
    if (threadIdx.x == 0) (void)xb_add(&bar[XB_XCNT(b.x)], 1u);
    return b;
}
DI void xcd_barrier_complete(unsigned* bar, unsigned x, unsigned& nloc, unsigned& nx) {
    const unsigned G = gridDim.x * gridDim.y * gridDim.z;
    unsigned sum, cnt, mine, sp = 0u;
    for (;;) {
        sum = 0u; cnt = 0u; mine = 0u;
#pragma unroll
        for (unsigned j = 0; j < 16; ++j) { const unsigned c = xb_ld(&bar[XB_XCNT(j)]); sum += c; cnt += (c > 0u) ? 1u : 0u; mine = (j == x) ? c : mine; }
        if (sum == G) break;
        __builtin_amdgcn_s_sleep(1);
        if ((++sp & 255u) == 0u) { if (xb_ld(&bar[XB_TMO])) break; if (sp > XB_SPIN_CAP) { atomicAdd(&bar[XB_TMO], 1u); break; } }
    }
    nloc = mine > 0u ? mine : 1u; nx = cnt > 0u ? cnt : 1u;
}
DI void xcd_barrier(const XcdBarrier& b) {
    asm volatile("s_waitcnt vmcnt(0)" ::: "memory");
    __syncthreads();
    if (threadIdx.x == 0) {
        unsigned* bar = b.bar;
        __builtin_amdgcn_s_waitcnt(0);
        unsigned nloc = b.st[0], nx = b.st[1];
        if (nloc == 0u) { xcd_barrier_complete(bar, b.x, nloc, nx); b.st[0] = nloc; b.st[1] = nx; }
        const unsigned old = xb_add(&bar[XB_XSUB(b.x)], 1u);
        const unsigned gen = old / nloc;
        if (old + 1u == (gen + 1u) * nloc) {
            __builtin_amdgcn_fence(__ATOMIC_RELEASE, "agent");
            asm volatile("s_waitcnt vmcnt(0)" ::: "memory");
            const unsigned og = xb_add(&bar[XB_TOP], 1u);
            const unsigned tg = og / nx;
            if (og + 1u == (tg + 1u) * nx) xb_add(&bar[XB_TOPGEN], 1u);
            else XB_SPIN(xb_ld(&bar[XB_TOPGEN]) == tg, bar);
            __builtin_amdgcn_fence(__ATOMIC_ACQUIRE, "agent");
            xb_add(&bar[XB_XGEN(b.x)], 1u);
            asm volatile("s_waitcnt vmcnt(0)" ::: "memory");
        } else {
            XB_SPIN(xb_ld(&bar[XB_XGEN(b.x)]) == gen, bar);
            __builtin_amdgcn_fence(__ATOMIC_ACQUIRE, "agent");
            asm volatile("s_waitcnt vmcnt(0)" ::: "memory");
        }
    }
    __syncthreads();
}


DI u32x4 pack8(f32x4 a, f32x4 b) { u32x4 w; w.x = pk2(a[0], a[1]); w.y = pk2(a[2], a[3]); w.z = pk2(b[0], b[1]); w.w = pk2(b[2], b[3]); return w; }
DI f32x4 silu4(f32x4 v) { f32x4 o; o[0] = silu_f(v[0]); o[1] = silu_f(v[1]); o[2] = silu_f(v[2]); o[3] = silu_f(v[3]); return o; }

DI void store16_sc1(void* ptr, u32x4 v) { asm volatile("global_store_dwordx4 %0, %1, off sc1\n\ts_nop 1" :: "v"(ptr), "v"(v) : "memory"); }

struct EpiProj {
    static constexpr bool PERM = true, AFTER_DRAIN = false;
    const float* rstd; bf16_t *MIX, *QS, *KZ, *V, *SRG; const float* convw; float* halo; LAS unsigned char* xlds;
    DI void operator()(const f32x4 (&acc)[2][2][4][2], const pg8::Unit& u, int wr, int wc, int fr, int fq) const {
        const int pn = u.pn;
        const int row0 = u.pm * 256 + wr * 64 + fr;
        const int cw = wc * 32 + 8 * fq;
        if (pn < 8) {
            const int ch0 = pn * 64 + 16 * wc + 4 * fq;
            const f32x4 w0 = *(const f32x4*)(convw + ch0), w1 = *(const f32x4*)(convw + 512 + ch0), w2 = *(const f32x4*)(convw + 1024 + ch0);
            f32x4 u3[2];
#pragma unroll
            for (int ai = 0; ai < 2; ++ai) { const float rs = rstd[row0 + ai * 128 + 48]; u3[ai] = (acc[ai][0][3][0] * rs) * (acc[ai][0][3][1] * rs); }
            LAS float* xb = (LAS float*)(xlds);
            if (fr >= 14) {
#pragma unroll
                for (int ai = 0; ai < 2; ++ai) *(LAS f32x4*)(xb + (((ai * 2 + wr) * 4 + wc) * 2 + (fr - 14)) * 16 + 4 * fq) = u3[ai];
                if (wr == 1) *(f32x4*)(halo + ((size_t)(u.pm * 3 + 2) * 2 + (fr - 14)) * 512 + ch0) = u3[1];
            }
            asm volatile("s_waitcnt lgkmcnt(0)" ::: "memory");
            __builtin_amdgcn_s_barrier();
#pragma unroll
            for (int ai = 0; ai < 2; ++ai) {
                f32x4 o1, o2, up = (f32x4){0.f, 0.f, 0.f, 0.f};
                bool havep = true;
                if (ai == 0 && wr == 0) { havep = false; o1 = (f32x4){0.f, 0.f, 0.f, 0.f}; o2 = o1; }
                else { const int pa = (wr == 1) ? ai : 0, pw = (wr == 1) ? 0 : 1;
                    const f32x4 p15 = *(const LAS f32x4*)(xb + (((pa * 2 + pw) * 4 + wc) * 2 + 1) * 16 + 4 * fq), p14 = *(const LAS f32x4*)(xb + (((pa * 2 + pw) * 4 + wc) * 2 + 0) * 16 + 4 * fq);
                    o1 = p15; o2 = (fr == 0) ? p14 : p15; }
#pragma unroll
                for (int m = 0; m < 4; ++m) {
                    const int row = row0 + ai * 128 + m * 16; const float rs = rstd[row];
                    const f32x4 uc = (acc[ai][0][m][0] * rs) * (acc[ai][0][m][1] * rs);
                    const int lane_ = fq * 16 + fr;
                    if (m > 0) {
#pragma unroll
                        for (int j = 0; j < 4; ++j) { o1[j] = __shfl(up[j], (lane_ & 48) + ((fr + 15) & 15)); o2[j] = __shfl(up[j], (lane_ & 48) + ((fr + 14) & 15)); }
                    }
                    f32x4 u1, u2;
#pragma unroll
                    for (int j = 0; j < 4; ++j) { const float s1 = __shfl(uc[j], (lane_ & 48) + ((fr + 15) & 15)), s2 = __shfl(uc[j], (lane_ & 48) + ((fr + 14) & 15));
                        u1[j] = (fr >= 1) ? s1 : o1[j]; u2[j] = (fr >= 2) ? s2 : o2[j]; }
                    const f32x4 cv3 = w0 * u2 + w1 * u1 + w2 * uc;
                    const f32x4 gate = (acc[ai][1][m][0] * rs) * silu4(acc[ai][1][m][1] * rs);
                    if (!havep && m == 0 && fr < 2) {
                        *(f32x4*)(halo + ((size_t)(u.pm * 3 + 0) * 2 + fr) * 512 + ch0) = cv3;
                        *(f32x4*)(halo + ((size_t)(u.pm * 3 + 1) * 2 + fr) * 512 + ch0) = gate;
                    } else {
                        const f32x4 o = gate * cv3; u32x2 w; w.x = pk2(o[0], o[1]); w.y = pk2(o[2], o[3]);
                        *(u32x2*)(MIX + (size_t)row * 1024 + ch0) = w;
                    }
                    up = uc;
                }
            }
        } else if (pn < 12) {
            const bool isq = pn < 10;
            const int head = 2 * ((pn - 8) & 1) + (wc >> 1);
            const int d0 = cw & 63;
            float fr8[8];
#pragma unroll
            for (int j = 0; j < 8; ++j) fr8[j] = rope_freq(d0 + j);
            const float lg = log2_gamma(head);
            bf16_t* dst = (isq ? QS : KZ) + head * 128 + d0;
#pragma unroll
            for (int ai = 0; ai < 2; ++ai)
#pragma unroll
                for (int m = 0; m < 4; ++m) {
                    const int row = row0 + ai * 128 + m * 16; const float rs = rstd[row];
                    const int t = row & (SEQ - 1), tl = t & 127; const float pos = (float)(NMETA + t);
                    const float sc = rs * (isq ? 0.08838834764831845f * exp2f((float)(tl - 127) * lg) : exp2f((float)(127 - tl) * lg));
                    f32x4 r1[2], r2[2];
#pragma unroll
                    for (int j = 0; j < 8; ++j) {
                        float s, c; sincos_rr(pos * fr8[j], s, c);
                        const float x1 = acc[ai][0][m][j >> 2][j & 3], x2 = acc[ai][1][m][j >> 2][j & 3];
                        r1[j >> 2][j & 3] = (x1 * c - x2 * s) * sc; r2[j >> 2][j & 3] = (x1 * s + x2 * c) * sc;
                    }
                    *(u32x4*)(dst + (size_t)row * 512) = pack8(r1[0], r1[1]);
                    *(u32x4*)(dst + (size_t)row * 512 + 64) = pack8(r2[0], r2[1]);
                }
        } else {
            const bool isv = pn < 14;
            bf16_t* dst = (isv ? V : SRG) + ((pn - 12) & 1) * 256 + cw;
#pragma unroll
            for (int ai = 0; ai < 2; ++ai)
#pragma unroll
                for (int m = 0; m < 4; ++m) {
                    const int row = row0 + ai * 128 + m * 16; const float rs = rstd[row];
#pragma unroll
                    for (int bj = 0; bj < 2; ++bj) {
                        f32x4 a0 = acc[ai][bj][m][0] * rs, a1 = acc[ai][bj][m][1] * rs;
                        if (!isv) { a0 = silu4(a0); a1 = silu4(a1); }
                        *(u32x4*)(dst + (size_t)row * 512 + bj * 128) = pack8(a0, a1);
                    }
                }
        }
    }
};

struct EpiOut {
    static constexpr bool PERM = true, AFTER_DRAIN = false;
    const float* x; float* out; float* part;
    DI void operator()(const f32x4 (&acc)[2][2][4][2], const pg8::Unit& u, int wr, int wc, int fr, int fq) const {
        const int row0 = u.pm * 256 + wr * 64 + fr, col0 = u.pn * 256 + wc * 32 + 8 * fq;
#pragma unroll
        for (int ai = 0; ai < 2; ++ai)
#pragma unroll
            for (int m = 0; m < 4; ++m) {
                const int row = row0 + ai * 128 + m * 16; float ss = 0.f;
#pragma unroll
                for (int bj = 0; bj < 2; ++bj) {
                    const size_t o = (size_t)row * DM + col0 + bj * 128;
                    const f32x4 y0 = acc[ai][bj][m][0] + *(const f32x4*)(x + o), y1 = acc[ai][bj][m][1] + *(const f32x4*)(x + o + 4);
                    ss += (y0[0] * y0[0] + y0[1] * y0[1]) + (y0[2] * y0[2] + y0[3] * y0[3]) + (y1[0] * y1[0] + y1[1] * y1[1]) + (y1[2] * y1[2] + y1[3] * y1[3]);
                    *(f32x4*)(out + o) = y0; *(f32x4*)(out + o + 4) = y1;
                }
                ss += __shfl_xor(ss, 16); ss += __shfl_xor(ss, 32);
                if (fq == 0) part[(size_t)(u.pn * 4 + wc) * M_TOK + row] = ss;
            }
    }
};


struct EpiOutNorm {
    static constexpr bool PERM = true, AFTER_DRAIN = true;
    const float* x; float* out; const float* gf; float* xch; unsigned* ctl;
    DI void fused(f32x4 (&acc)[2][2][4][2], const pg8::Unit& u, int wr, int wc, int fr, int fq, LAS unsigned char* lds, int wid, int lane) const {
        LAS float* R = (LAS float*)(lds + 131072 + 1024);
        f32x4 y[2][16];
        float* slot = xch + (size_t)(u.pm * 4) * 256;
#pragma unroll
        for (int ai = 0; ai < 2; ++ai) {
            if (ai) __syncthreads();
#pragma unroll
            for (int m = 0; m < 4; ++m)
#pragma unroll
                for (int bj = 0; bj < 2; ++bj)
#pragma unroll
                    for (int n = 0; n < 2; ++n) { const int r = wr * 64 + m * 16 + fr, ch = 32 * bj + 8 * wc + 2 * fq + n;
                        *(LAS f32x4*)(lds + r * 1024 + ((ch ^ (r & 15)) << 4)) = acc[ai][bj][m][n]; }
            __syncthreads();
            f32x4 xv[16];
#pragma unroll
            for (int k = 0; k < 16; ++k) { const int r = wid + 8 * k; xv[k] = __builtin_nontemporal_load((const f32x4*)(x + (size_t)(u.pm * 256 + ai * 128 + r) * DM + u.pn * 256) + lane); }
#pragma unroll
            for (int k = 0; k < 16; ++k) { const int r = wid + 8 * k;
                const f32x4 v = *(const LAS f32x4*)(lds + r * 1024 + ((lane ^ (r & 15)) << 4)) + xv[k];
                y[ai][k] = v;
                const float ss = wave_sum((v[0] * v[0] + v[1] * v[1]) + (v[2] * v[2] + v[3] * v[3]));
                if (lane == 0) __hip_atomic_store(slot + u.pn * 256 + ai * 128 + r, ss, __ATOMIC_RELAXED, __HIP_MEMORY_SCOPE_AGENT); }
        }
        const int tid = wid * 64 + lane;
        asm volatile("s_waitcnt vmcnt(0)" ::: "memory");
        __syncthreads();
        if (tid == 0) {
            unsigned* cnt = ctl + CW_PANEL + 64 * u.pm;
            xb_add(cnt, 1u);
            unsigned sp = 0u;
            while (xb_ld(cnt) < 4u) { __builtin_amdgcn_s_sleep(1); if (++sp > (1u << 22)) break; }
        }
        __syncthreads();
        if (tid < 256) { float s = 0.f;
#pragma unroll
            for (int q = 0; q < 4; ++q) s += __hip_atomic_load(slot + q * 256 + tid, __ATOMIC_RELAXED, __HIP_MEMORY_SCOPE_AGENT);
            R[tid] = 1.f / sqrtf(s * (1.f / 1024.f) + EPS); }
        __syncthreads();
        const f32x4 gv = *((const f32x4*)(gf + u.pn * 256) + lane);
#pragma unroll
        for (int ai = 0; ai < 2; ++ai)
#pragma unroll
            for (int k = 0; k < 16; ++k) { const int r = ai * 128 + wid + 8 * k; const float rs = R[r];
                __builtin_nontemporal_store(y[ai][k] * rs * gv, (f32x4*)(out + (size_t)(u.pm * 256 + r) * DM + u.pn * 256) + lane); }
    }
};

DI unsigned off_b(unsigned row, unsigned ch) { return 256u * row + 16u * (ch ^ (((row & 3) << 2) | ((row >> 2) & 3))); }
DI bf16x8 row_frag(const unsigned char* img, int rb, int s, int lane) {
    return *(const bf16x8*)(img + 8192 * rb + off_b(lane & 31, 2 * s + (lane >> 5)));
}
DI s16x4 tr_read(const unsigned char* p) { return __builtin_bit_cast(s16x4, __builtin_amdgcn_ds_read_tr16_b64_v4i16((LAS v4i16_t*)(const LAS unsigned char*)p)); }
template <bool PERMK> DI bf16x8 tr_frag(const unsigned char* img, int c, int rbase, int lane) {
    const int h = lane >> 5, blk = (lane >> 4) & 1, q = (lane & 15) >> 2, p = lane & 3;
    const int r0 = rbase + (PERMK ? 4 * h : 8 * h) + q, r1 = r0 + (PERMK ? 8 : 4);
    const unsigned ch = 4 * c + 2 * blk + (p >> 1), bo = 8 * (p & 1);
    const s16x4 lo = tr_read(img + off_b(r0, ch) + bo), hi = tr_read(img + off_b(r1, ch) + bo);
    return __builtin_shufflevector(lo, hi, 0, 1, 2, 3, 4, 5, 6, 7);
}
DI void load_tile(unsigned char* img, const bf16_t* src, int ld, int tid) {
#pragma unroll
    for (int i = 0; i < 4; ++i) { const int idx = tid + 512 * i, row = idx >> 4, ch = idx & 15;
        *(u32x4*)(img + off_b(row, ch)) = *(const u32x4*)(src + (size_t)row * ld + ch * 8); }
}
DI void tile_ld(u32x4 (&r)[4], const bf16_t* src, int ld, int tid) {
#pragma unroll
    for (int i = 0; i < 4; ++i) { const int idx = tid + 512 * i, row = idx >> 4, ch = idx & 15; r[i] = *(const u32x4*)(src + (size_t)row * ld + ch * 8); }
}
DI void tile_st(unsigned char* img, const u32x4 (&r)[4], int tid) {
#pragma unroll
    for (int i = 0; i < 4; ++i) { const int idx = tid + 512 * i, row = idx >> 4, ch = idx & 15; *(u32x4*)(img + off_b(row, ch)) = r[i]; }
}
DI int crow(int reg, int h) { return (reg & 3) + 8 * (reg >> 2) + 4 * h; }
#define MFMA32(a, b, c) __builtin_amdgcn_mfma_f32_32x32x16_bf16((a), (b), (c), 0, 0, 0)

struct Params { const float *x, *meta, *g1, *w_in, *conv_w, *rg, *w_out, *gf; float* out; unsigned char* ws; };


DI int dest_pos(int n) {
    const int type = n >> 9, r = n & 511;
    if (type < 4) {
        const int rr = r & 63, wc = rr >> 4, fq = (rr >> 2) & 3, j = rr & 3;
        const int bj = (type == 1 || type == 3) ? 1 : 0, nn = (type >= 2) ? 1 : 0;
        return (r >> 6) * 256 + 128 * bj + 32 * wc + 8 * fq + 4 * nn + j;
    }
    if (type < 6) { const int h = r >> 7, d = r & 127; return (8 + (type - 4) * 2 + (h >> 1)) * 256 + (d >> 6) * 128 + (h & 1) * 64 + (d & 63); }
    return n;
}

DI void p0_tr_load(float (&w)[32], const float* W, const float* gain, int N, int item, int lane) {
    const int nblk = N / 32, kb = item / nblk, nb = item % nblk, k0 = 64 * kb, n0 = 32 * nb;
#pragma unroll
    for (int i = 0; i < 32; ++i) { const int kk = 2 * i + (lane >> 5); w[i] = W[(size_t)(k0 + kk) * N + n0 + (lane & 31)]; if (gain) w[i] *= gain[k0 + kk]; }
}
DI void p0_tr_finish(const float (&w)[32], int K, int N, bf16_t* WT, bool perm, float* scr, int item, int lane) {
    const int nblk = N / 32, kb = item / nblk, nb = item % nblk, k0 = 64 * kb, n0 = 32 * nb;
#pragma unroll
    for (int i = 0; i < 32; ++i) { const int kk = 2 * i + (lane >> 5); scr[kk * 33 + (lane & 31)] = w[i]; }
    __builtin_amdgcn_s_waitcnt(0xc07f); asm volatile("" ::: "memory");
    const int c = lane & 7;
#pragma unroll
    for (int j = 0; j < 4; ++j) { const int n = (lane >> 3) + 8 * j; const float* s = scr + (8 * c) * 33 + n;
        u32x4 o; o.x = pk2(s[0 * 33], s[1 * 33]); o.y = pk2(s[2 * 33], s[3 * 33]); o.z = pk2(s[4 * 33], s[5 * 33]); o.w = pk2(s[6 * 33], s[7 * 33]);
        *(u32x4*)(WT + (size_t)(perm ? dest_pos(n0 + n) : n0 + n) * K + k0 + 8 * c) = o; }
    __builtin_amdgcn_s_waitcnt(0xc07f); asm volatile("" ::: "memory");
}

DI void phase0(const Params& p, unsigned char* lds) {
    const int tid = opaque_tid(), lane = tid & 63, wave = tid >> 6;
    unsigned char* ws = p.ws;
    float* rstd = (float*)(ws + WS_RSTD); float* MP = (float*)(ws + WS_MP);
    bf16_t* XB = (bf16_t*)(ws + WS_XB); bf16_t* WIN = (bf16_t*)(ws + WS_WIN); bf16_t* WOUT = (bf16_t*)(ws + WS_WOUT);
    {
        float* metaL = (float*)lds; float* red = (float*)(lds + 65536); float* rsL = (float*)(lds + 98304);
        for (int i = tid; i < 4096; i += 512) ((f32x4*)metaL)[i] = ((const f32x4*)p.meta)[i];
        __syncthreads();
#pragma unroll
        for (int rr = 0; rr < 2; ++rr) { const int m = 2 * wave + rr; float s = 0.f;
#pragma unroll
            for (int i = 0; i < 16; ++i) { const float v = metaL[m * 1024 + lane + 64 * i]; s += v * v; }
            s = wave_sum(s); if (lane == 0) rsL[m] = 1.f / sqrtf(s * (1.f / 1024.f) + EPS); }
        for (int cgp = blockIdx.x; cgp < 256; cgp += gridDim.x) {
            const int col = tid & 15, ks = tid >> 4, n = cgp * 16 + col;
            float a[16], wv[32];
#pragma unroll
            for (int m = 0; m < 16; ++m) a[m] = 0.f;
#pragma unroll
            for (int kk = 0; kk < 32; ++kk) { const int k = kk * 32 + ks; wv[kk] = p.w_in[(size_t)k * NPROJ + n] * p.g1[k]; }
#pragma unroll
            for (int kk = 0; kk < 32; ++kk) { const int k = kk * 32 + ks;
#pragma unroll
                for (int m = 0; m < 16; ++m) a[m] = fmaf(metaL[m * 1024 + k], wv[kk], a[m]); }
#pragma unroll
            for (int m = 0; m < 16; ++m) red[(ks * 16 + m) * 16 + col] = a[m];
            __syncthreads();
            if (tid < 256) { const int m = tid >> 4, c = tid & 15; float s = 0.f;
#pragma unroll 8
                for (int k2 = 0; k2 < 32; ++k2) s += red[(k2 * 16 + m) * 16 + c];
                MP[m * NPROJ + cgp * 16 + c] = s * rsL[m]; }
            __syncthreads();
        }
    }
    __syncthreads();
    const int gw = blockIdx.x * 8 + wave, NGW = gridDim.x * 8;
    {
        float* scr = (float*)(lds + wave * 16384);
        constexpr int I_IN = (DM / 64) * (NPROJ / 32), I_OUT = (DM / 64) * (DM / 32);
        for (int it = gw; it < I_IN + I_OUT; it += 2 * NGW) {
            const int it2 = it + NGW; const bool has2 = it2 < I_IN + I_OUT;
            float wa[32], wb[32];
            if (it < I_IN) p0_tr_load(wa, p.w_in, p.g1, NPROJ, it, lane); else p0_tr_load(wa, p.w_out, nullptr, DM, it - I_IN, lane);
            if (has2) { if (it2 < I_IN) p0_tr_load(wb, p.w_in, p.g1, NPROJ, it2, lane); else p0_tr_load(wb, p.w_out, nullptr, DM, it2 - I_IN, lane); }
            if (it < I_IN) p0_tr_finish(wa, DM, NPROJ, WIN, true, scr, it, lane); else p0_tr_finish(wa, DM, DM, WOUT, false, scr, it - I_IN, lane);
            if (has2) { if (it2 < I_IN) p0_tr_finish(wb, DM, NPROJ, WIN, true, scr, it2, lane); else p0_tr_finish(wb, DM, DM, WOUT, false, scr, it2 - I_IN, lane); }
        }
    }
    for (int row = gw; row < M_TOK; row += 4 * NGW) {
        f32x4 v[4][4]; float s[4];
#pragma unroll
        for (int q = 0; q < 4; ++q) { const f32x4* xr = (const f32x4*)(p.x + (size_t)(row + q * NGW) * DM) + lane;
#pragma unroll
            for (int j = 0; j < 4; ++j) v[q][j] = __builtin_nontemporal_load(xr + 64 * j); }
#pragma unroll
        for (int q = 0; q < 4; ++q) { float a = 0.f;
#pragma unroll
            for (int j = 0; j < 4; ++j) a += (v[q][j][0] * v[q][j][0] + v[q][j][1] * v[q][j][1]) + (v[q][j][2] * v[q][j][2] + v[q][j][3] * v[q][j][3]);
            s[q] = wave_sum(a); }
#pragma unroll
        for (int q = 0; q < 4; ++q) { const int r = row + q * NGW;
            if (lane == 0) rstd[r] = 1.f / sqrtf(s[q] * (1.f / 1024.f) + EPS);
            u32x2* o = (u32x2*)(XB + (size_t)r * DM) + lane;
#pragma unroll
            for (int j = 0; j < 4; ++j) { u32x2 w; w.x = pk2(v[q][j][0], v[q][j][1]); w.y = pk2(v[q][j][2], v[q][j][3]); o[64 * j] = w; } }
    }
}

template <bool FUSED> DI void phase2(const Params& p, unsigned char* lds, unsigned* ctl) {
    const int tid = opaque_tid(), lane = tid & 63, wave = tid >> 6, h5 = lane >> 5;
    const bf16_t* KZ = (const bf16_t*)(p.ws + WS_KZ); const bf16_t* V = (const bf16_t*)(p.ws + WS_V); bf16_t* UPD = (bf16_t*)(p.ws + WS_UPD);
    unsigned char* Kimg = lds; unsigned char* Vimg = lds + 32768;
    const int eb = wave & 3, dh = wave >> 2;
    u32x4 pk[4], pv[4];
    if (blockIdx.x < 8 * 63) { const int it = blockIdx.x, bh = it / 63, n = 1 + it % 63; const size_t row0 = (size_t)(bh >> 2) * SEQ + (size_t)(n - 1) * 128;
        tile_ld(pk, KZ + row0 * 512 + (bh & 3) * 128, 512, tid); tile_ld(pv, V + row0 * 512 + (bh & 3) * 128, 512, tid); }
    for (int it = blockIdx.x; it < 8 * 63; it += gridDim.x) {
        const int bh = it / 63, n = 1 + it % 63;
        tile_st(Kimg, pk, tid); tile_st(Vimg, pv, tid);
        __syncthreads();
        { const int it2 = it + gridDim.x; if (it2 < 8 * 63) { const int bh2 = it2 / 63, n2 = 1 + it2 % 63; const size_t row2 = (size_t)(bh2 >> 2) * SEQ + (size_t)(n2 - 1) * 128;
            tile_ld(pk, KZ + row2 * 512 + (bh2 & 3) * 128, 512, tid); tile_ld(pv, V + row2 * 512 + (bh2 & 3) * 128, 512, tid); } }
        f32x16 a0, a1;
#pragma unroll
        for (int i = 0; i < 16; ++i) { a0[i] = 0.f; a1[i] = 0.f; }
#pragma unroll
        for (int ks = 0; ks < 8; ++ks) {
            const bf16x8 av = tr_frag<false>(Vimg, eb, 16 * ks, lane);
            const bf16x8 b0 = tr_frag<false>(Kimg, 2 * dh, 16 * ks, lane), b1 = tr_frag<false>(Kimg, 2 * dh + 1, 16 * ks, lane);
            a0 = MFMA32(av, b0, a0); a1 = MFMA32(av, b1, a1);
        }
        bf16_t* dst = UPD + ((size_t)(bh * 64 + n) * 128 + 32 * eb) * 128 + 64 * dh + (lane & 31);
#pragma unroll
        for (int r = 0; r < 16; ++r) { const int e = crow(r, h5);
            const unsigned pw_ = pk2(a0[r], a1[r]); const bf16_t v0 = (bf16_t)(pw_ & 0xffffu), v1 = (bf16_t)(pw_ >> 16);
            if constexpr (FUSED) { __hip_atomic_store(dst + e * 128, v0, __ATOMIC_RELAXED, __HIP_MEMORY_SCOPE_AGENT); __hip_atomic_store(dst + e * 128 + 32, v1, __ATOMIC_RELAXED, __HIP_MEMORY_SCOPE_AGENT); }
            else { dst[e * 128] = v0; dst[e * 128 + 32] = v1; } }
        if constexpr (FUSED) asm volatile("s_waitcnt vmcnt(0)" ::: "memory");
        __syncthreads();
        if constexpr (FUSED) { if (tid == 0) xb_add(ctl + CW_C2 + 64 * bh, 1u); }
    }
}

#ifdef PROBE_T
#define DSTAMP(k) do { if (blockIdx.x == PROBE_B && threadIdx.x == 0) ((unsigned long long*)(p.ws + 49152))[k] = __builtin_amdgcn_s_memrealtime(); } while (0)
#else
#define DSTAMP(k) do {} while (0)
#endif
template <bool FUSED> DI void phase3(const Params& p, unsigned char* lds, unsigned* ctl) {
    const float* MP = (const float*)(p.ws + WS_MP); const bf16_t* UPD = (const bf16_t*)(p.ws + WS_UPD); bf16_t* TT = (bf16_t*)(p.ws + WS_TT);
    const int tid3 = opaque_tid();
    float* kzL = (float*)lds; float* vL = (float*)(lds + 8192);
    if constexpr (FUSED) {
        const int h = (blockIdx.x >> 5) & 3, e0 = (blockIdx.x & 31) * 4; const float lg = log2_gamma(h);
#pragma unroll
        for (int i = 0; i < 4; ++i) { const int idx = tid3 + 512 * i, m = idx >> 7, d = idx & 127, dl = d & 63;
            const float* mp = MP + m * NPROJ + 5 * 512 + h * 128;
            const float x1 = mp[dl], x2 = mp[64 + dl]; float sn, cs; sincos_rr((float)m * rope_freq(dl), sn, cs);
            kzL[idx] = ((d < 64) ? (x1 * cs - x2 * sn) : (x1 * sn + x2 * cs)) * exp2f((float)(15 - m) * lg); }
        if (tid3 < 64) vL[tid3] = MP[(tid3 >> 2) * NPROJ + 6 * 512 + h * 128 + e0 + (tid3 & 3)];
        if (tid3 == 0) { unsigned* c2 = ctl + CW_C2 + 64 * (blockIdx.x >> 5); unsigned sp = 0u;
            while (xb_ld(c2) < 63u) { __builtin_amdgcn_s_sleep(1); if (++sp > (1u << 22)) break; } }
        __syncthreads();
    }
    DSTAMP(0);
    for (int gid = blockIdx.x * 512 + tid3; gid < 8 * 16384; gid += gridDim.x * 512) {
        const int bh = gid >> 14, idx = gid & 16383, e = idx >> 7, d = idx & 127, h = bh & 3;
        const float lg = log2_gamma(h), cdec = exp2f(128.f * lg);
        const int dl = d & 63; const float fq = rope_freq(dl);
        float s1 = 0.f;
        if constexpr (FUSED) {
#pragma unroll
            for (int m = 0; m < NMETA; ++m) s1 = fmaf(vL[m * 4 + (e & 3)], kzL[m * 128 + d], s1);
        } else {
#pragma unroll 4
        for (int m = 0; m < NMETA; ++m) {
            const float* mp = MP + m * NPROJ;
            const float x1 = mp[5 * 512 + h * 128 + dl], x2 = mp[5 * 512 + h * 128 + 64 + dl];
            float s, c; sincos_rr((float)m * fq, s, c);
            const float kr = (d < 64) ? (x1 * c - x2 * s) : (x1 * s + x2 * c);
            s1 = fmaf(mp[6 * 512 + h * 128 + e] * exp2f((float)(15 - m) * lg), kr, s1);
        }
        }
        DSTAMP(1);
        float T = cdec * s1;
        const bf16_t* up = UPD + (size_t)bh * 64 * 16384 + idx;
        bf16_t* tt = TT + (size_t)bh * 65 * 16384 + idx;
        if constexpr (FUSED) __hip_atomic_store(tt + 16384, (bf16_t)(pk2(T, 0.f) & 0xffffu), __ATOMIC_RELAXED, __HIP_MEMORY_SCOPE_AGENT); else tt[16384] = (bf16_t)(pk2(T, 0.f) & 0xffffu);
        bf16_t u[63];
#pragma unroll
        for (int i = 0; i < 63; ++i) u[i] = up[(size_t)(i + 1) * 16384];
#pragma unroll
        for (int i = 0; i < 63; ++i) { T = cdec * (T + __uint_as_float((unsigned)u[i] << 16)); const bf16_t tv = (bf16_t)(pk2(T, 0.f) & 0xffffu);
            if constexpr (FUSED) __hip_atomic_store(tt + (size_t)(i + 2) * 16384, tv, __ATOMIC_RELAXED, __HIP_MEMORY_SCOPE_AGENT); else tt[(size_t)(i + 2) * 16384] = tv; }
    }
    DSTAMP(2);
    if constexpr (FUSED) {
        asm volatile("s_waitcnt vmcnt(0)" ::: "memory");
        __syncthreads();
        DSTAMP(3);
        if (tid3 == 0) xb_add(ctl + CW_C3 + 64 * (blockIdx.x >> 5), 1u);
    }
}

template <bool FUSED> DI void phase4(const Params& p, unsigned char* lds, unsigned* ctl, int pm5) {
    const int tid = opaque_tid(), lane = tid & 63, wave = tid >> 6, h5 = lane >> 5;
    const bf16_t* QS = (const bf16_t*)(p.ws + WS_QS); const bf16_t* KZ = (const bf16_t*)(p.ws + WS_KZ); const bf16_t* V = (const bf16_t*)(p.ws + WS_V);
    const bf16_t* SRG = (const bf16_t*)(p.ws + WS_SRG); const bf16_t* TT = (const bf16_t*)(p.ws + WS_TT); bf16_t* MIX = (bf16_t*)(p.ws + WS_MIX);
    unsigned char* Qimg = lds; unsigned char* Kimg = lds + 32768; unsigned char* Vimg = lds + 65536; unsigned char* Timg = lds + 98304;
    float* OL = (float*)lds;
    const int ib = (wave < 4) ? wave : 7 - wave, eh = wave >> 2;
    u32x4 pq[4], pk[4], pv[4], pt[4];
    if (blockIdx.x < 8 * 64) { const int it = blockIdx.x, bh = it >> 6, n = 1 + (it & 63); const size_t row0 = (size_t)(bh >> 2) * SEQ + (size_t)(n - 1) * 128;
        tile_ld(pq, QS + row0 * 512 + (bh & 3) * 128, 512, tid); tile_ld(pk, KZ + row0 * 512 + (bh & 3) * 128, 512, tid); tile_ld(pv, V + row0 * 512 + (bh & 3) * 128, 512, tid);
        if constexpr (FUSED) {
            if (tid == 0) { unsigned* c3 = ctl + CW_C3 + 64 * bh; unsigned sp = 0u; while (xb_ld(c3) < 32u) { __builtin_amdgcn_s_sleep(1); if (++sp > (1u << 22)) break; }
                unsigned* c5 = ctl + CW_P5 + 64 * pm5; sp = 0u; while (xb_ld(c5) < 256u) { __builtin_amdgcn_s_sleep(1); if (++sp > (1u << 22)) break; } }
            __syncthreads();
        }
        tile_ld(pt, TT + ((size_t)bh * 65 + n) * 16384, 128, tid); }
    for (int it = blockIdx.x; it < 8 * 64; it += gridDim.x) {
        const int bh = it >> 6, n = 1 + (it & 63), b = bh >> 2, h = bh & 3;
        const size_t row0 = (size_t)b * SEQ + (size_t)(n - 1) * 128;
        const int it2 = it + gridDim.x;
        tile_st(Qimg, pq, tid); tile_st(Kimg, pk, tid); tile_st(Vimg, pv, tid); tile_st(Timg, pt, tid);
        if constexpr (FUSED) { if (it2 < 8 * 64 && tid == 0) { unsigned* c3 = ctl + CW_C3 + 64 * (it2 >> 6); unsigned sp = 0u; while (xb_ld(c3) < 32u) { __builtin_amdgcn_s_sleep(1); if (++sp > (1u << 22)) break; } } }
        u32x4 sgv[4];
        { const int rown = tid >> 2, partn = tid & 3;
            const u32x4* sp = (const u32x4*)(SRG + (row0 + rown) * 512 + h * 128 + 32 * partn);
#pragma unroll
            for (int k = 0; k < 4; ++k) sgv[k] = sp[k]; }
        __syncthreads();
        if (it2 < 8 * 64) { const int bh2 = it2 >> 6, n2 = 1 + (it2 & 63); const size_t row2 = (size_t)(bh2 >> 2) * SEQ + (size_t)(n2 - 1) * 128;
            tile_ld(pq, QS + row2 * 512 + (bh2 & 3) * 128, 512, tid); tile_ld(pk, KZ + row2 * 512 + (bh2 & 3) * 128, 512, tid); tile_ld(pv, V + row2 * 512 + (bh2 & 3) * 128, 512, tid);
            tile_ld(pt, TT + ((size_t)bh2 * 65 + n2) * 16384, 128, tid); }
        bf16x8 qf[8];
#pragma unroll
        for (int s = 0; s < 8; ++s) qf[s] = row_frag(Qimg, ib, s, lane);
        f32x16 O0, O1;
#pragma unroll
        for (int i = 0; i < 16; ++i) { O0[i] = 0.f; O1[i] = 0.f; }
#pragma unroll
        for (int jb = 0; jb < 4; ++jb) {
            if (jb <= ib) {
                f32x16 c;
#pragma unroll
                for (int i = 0; i < 16; ++i) c[i] = 0.f;
#pragma unroll
                for (int s = 0; s < 8; ++s) c = MFMA32(row_frag(Kimg, jb, s, lane), qf[s], c);
                if (jb == ib) {
#pragma unroll
                    for (int r = 0; r < 16; ++r) if (crow(r, h5) > (lane & 31)) c[r] = 0.f;
                }
#pragma unroll
                for (int s2 = 0; s2 < 2; ++s2) {
                    u32x4 pw; pw.x = pk2(c[8 * s2 + 0], c[8 * s2 + 1]); pw.y = pk2(c[8 * s2 + 2], c[8 * s2 + 3]); pw.z = pk2(c[8 * s2 + 4], c[8 * s2 + 5]); pw.w = pk2(c[8 * s2 + 6], c[8 * s2 + 7]);
                    const bf16x8 pa = __builtin_bit_cast(bf16x8, pw);
                    const bf16x8 v0 = tr_frag<true>(Vimg, 2 * eh, 32 * jb + 16 * s2, lane), v1 = tr_frag<true>(Vimg, 2 * eh + 1, 32 * jb + 16 * s2, lane);
                    O0 = MFMA32(pa, v0, O0); O1 = MFMA32(pa, v1, O1);
                }
            }
        }
#pragma unroll
        for (int s = 0; s < 8; ++s) { O0 = MFMA32(qf[s], row_frag(Timg, 2 * eh, s, lane), O0); O1 = MFMA32(qf[s], row_frag(Timg, 2 * eh + 1, s, lane), O1); }
        __syncthreads();
        {
            float* o = OL + (32 * ib) * 132 + 64 * eh + (lane & 31);
#pragma unroll
            for (int r = 0; r < 16; ++r) { const int i = crow(r, h5); o[i * 132] = O0[r]; o[i * 132 + 32] = O1[r]; }
        }
        __syncthreads();
        {
            const int row = tid >> 2, part = tid & 3;
            const float* o = OL + row * 132 + 32 * part;
            f32x4 v[8]; float s = 0.f;
#pragma unroll
            for (int k = 0; k < 8; ++k) { v[k] = *(const f32x4*)(o + 4 * k); s += (v[k][0] + v[k][1]) + (v[k][2] + v[k][3]); }
            s += __shfl_xor(s, 1); s += __shfl_xor(s, 2);
            const float mu = s * (1.f / 128.f); float q = 0.f;
#pragma unroll
            for (int k = 0; k < 8; ++k) { v[k] = v[k] - mu; q += (v[k][0] * v[k][0] + v[k][1] * v[k][1]) + (v[k][2] * v[k][2] + v[k][3] * v[k][3]); }
            q += __shfl_xor(q, 1); q += __shfl_xor(q, 2);
            const float rs = 1.f / sqrtf(q * (1.f / 128.f) + EPS);
            const size_t grow = row0 + row;
            u32x4* dp = (u32x4*)(MIX + grow * 1024 + 512 + h * 128 + 32 * part);
            const f32x4* gp = (const f32x4*)(p.rg + h * 128 + 32 * part);
#pragma unroll
            for (int k2 = 0; k2 < 4; ++k2) {
                const u32x4 sg = sgv[k2]; const f32x4 g0 = gp[2 * k2], g1 = gp[2 * k2 + 1];
                const f32x4 a = v[2 * k2], c2 = v[2 * k2 + 1];
                u32x4 w;
                w.x = pk2(a[0] * rs * g0[0] * bf_lo(sg.x), a[1] * rs * g0[1] * bf_hi(sg.x));
                w.y = pk2(a[2] * rs * g0[2] * bf_lo(sg.y), a[3] * rs * g0[3] * bf_hi(sg.y));
                w.z = pk2(c2[0] * rs * g1[0] * bf_lo(sg.z), c2[1] * rs * g1[1] * bf_hi(sg.z));
                w.w = pk2(c2[2] * rs * g1[2] * bf_lo(sg.w), c2[3] * rs * g1[3] * bf_hi(sg.w));
                if constexpr (FUSED) store16_sc1(dp + k2, w); else dp[k2] = w;
            }
        }
        if constexpr (FUSED) asm volatile("s_waitcnt vmcnt(0)" ::: "memory");
        __syncthreads();
        if constexpr (FUSED) { if (tid == 0) xb_add(ctl + CW_P5 + 64 * (b * 32 + ((n - 1) >> 1)), 1u); }
    }
}

DI void phase_convfix(const Params& p, unsigned* ctl) {
    const int tid = opaque_tid();
    const float* halo = (const float*)(p.ws + WS_HALO); const float* MP = (const float*)(p.ws + WS_MP); bf16_t* MIX = (bf16_t*)(p.ws + WS_MIX);
    for (int pm = blockIdx.x; pm < 64; pm += gridDim.x) {
        const int ch = tid;
        float um1, um2;
        if ((pm & 31) == 0) { um2 = MP[14 * NPROJ + ch] * MP[14 * NPROJ + 1024 + ch]; um1 = MP[15 * NPROJ + ch] * MP[15 * NPROJ + 1024 + ch]; }
        else { um2 = halo[((size_t)((pm - 1) * 3 + 2) * 2 + 0) * 512 + ch]; um1 = halo[((size_t)((pm - 1) * 3 + 2) * 2 + 1) * 512 + ch]; }
        const float w0 = p.conv_w[ch], w1 = p.conv_w[512 + ch];
        const float c0 = halo[((size_t)(pm * 3 + 0) * 2 + 0) * 512 + ch] + w0 * um2 + w1 * um1;
        const float c1 = halo[((size_t)(pm * 3 + 0) * 2 + 1) * 512 + ch] + w0 * um1;
        const float g0 = halo[((size_t)(pm * 3 + 1) * 2 + 0) * 512 + ch], g1 = halo[((size_t)(pm * 3 + 1) * 2 + 1) * 512 + ch];
        __hip_atomic_store(MIX + (size_t)(pm * 256) * 1024 + ch, (bf16_t)(pk2(g0 * c0, 0.f) & 0xffffu), __ATOMIC_RELAXED, __HIP_MEMORY_SCOPE_AGENT);
        __hip_atomic_store(MIX + (size_t)(pm * 256 + 1) * 1024 + ch, (bf16_t)(pk2(g1 * c1, 0.f) & 0xffffu), __ATOMIC_RELAXED, __HIP_MEMORY_SCOPE_AGENT);
        asm volatile("s_waitcnt vmcnt(0)" ::: "memory");
        __syncthreads();
        if (tid == 0) xb_add(ctl + CW_P5 + 64 * pm, 256u);
    }
}

DI void phase6(const Params& p) {
    const int tid = opaque_tid(), lane = tid & 63, wave = tid >> 6;
    const float* part = (const float*)(p.ws + WS_PART);
    const int gw = blockIdx.x * 8 + wave, NGW = gridDim.x * 8;
    f32x4 g[4];
#pragma unroll
    for (int j = 0; j < 4; ++j) g[j] = ((const f32x4*)p.gf)[lane + 64 * j];
    for (int row = gw; row < M_TOK; row += NGW) {
        float s = (lane < 16) ? part[(size_t)lane * M_TOK + row] : 0.f;
        s = wave_sum(s);
        const float rs = 1.f / sqrtf(s * (1.f / 1024.f) + EPS);
        f32x4* o = (f32x4*)(p.out + (size_t)row * DM) + lane;
#pragma unroll
        for (int j = 0; j < 4; ++j) { f32x4 v = o[64 * j]; v = v * rs * g[j]; o[64 * j] = v; }
    }
}

#ifndef DUP
#define DUP -1
#endif
#define REP(k) for (int rep_ = 0; rep_ < ((DUP == (k)) ? 2 : 1); ++rep_)
__global__ void __launch_bounds__(512, 2) hymba_fwd(Params p) {
    extern __shared__ __attribute__((aligned(16))) unsigned char lds[];
#ifdef USE_CG_FALLBACK
    cg::grid_group grid = cg::this_grid();
#endif
    unsigned char* ws = p.ws;
    unsigned* ctl = (unsigned*)ws;
    const bool fast = (gridDim.x == 256);
    volatile LAS unsigned* st = (volatile LAS unsigned*)((LAS unsigned char*)lds + 131072);
    if (threadIdx.x < 4) st[threadIdx.x] = 0u;
    __syncthreads();
    XcdBarrier bar = xcd_barrier_post(ctl, st);
#ifdef USE_CG_FALLBACK
#define GSYNC() grid.sync()
#else
#define GSYNC() xcd_barrier(bar)
#endif
#define SEAM() do { if (fast) xcd_barrier(bar); else GSYNC(); } while (0)
#ifdef PROBE_T
    unsigned long long ts_[12]; int nts_ = 0;
#define STAMP() do { ts_[nts_++] = __builtin_amdgcn_s_memrealtime(); } while (0)
#else
#define STAMP() do {} while (0)
#endif
    STAMP();
    for (int pass_ = 0; pass_ < ((DUP == 9) ? 2 : 1); ++pass_) {
    REP(0) { phase0(p, lds); __syncthreads(); }
    STAMP();
    SEAM();
    STAMP();
    if (DUP == 7) { for (int i_ = 0; i_ < 6; ++i_) SEAM(); }
    REP(1) {
        pg8::Gemm g{(const bf16_t*)(ws + WS_XB), (const bf16_t*)(ws + WS_WIN), M_TOK, NPROJ, DM};
        pg8::StaticOrder S; S.init(M_TOK, NPROJ, (int)gridDim.x, (int)blockIdx.x);
        EpiProj E{(const float*)(ws + WS_RSTD), (bf16_t*)(ws + WS_MIX), (bf16_t*)(ws + WS_QS), (bf16_t*)(ws + WS_KZ), (bf16_t*)(ws + WS_V), (bf16_t*)(ws + WS_SRG), p.conv_w, (float*)(ws + WS_HALO), (LAS unsigned char*)lds + 131072 + 2048};
        pg8::gemm_phase<EpiProj, pg8::StaticOrder, true, true>((LAS unsigned char*)lds, g, S, E);
    }
    STAMP();
    SEAM();
    STAMP();
    if (fast) {
        phase2<true>(p, lds, ctl);
        STAMP();
        phase_convfix(p, ctl);
        STAMP();
        phase3<true>(p, lds, ctl);
        STAMP();
        int pm5; { pg8::StaticOrder S5; S5.init(M_TOK, DM, (int)gridDim.x, (int)blockIdx.x); pg8::Unit u5; (void)S5.next(0, u5); pm5 = u5.pm; }
        phase4<true>(p, lds, ctl, pm5);
    } else {
        phase2<false>(p, lds, ctl);
        GSYNC();
        phase3<false>(p, lds, ctl);
        GSYNC();
        phase4<false>(p, lds, ctl, 0);
        phase_convfix(p, ctl);
    }
    STAMP();
    if (!fast) SEAM();
    STAMP();
    if (fast) REP(5) {
        pg8::Gemm g{(const bf16_t*)(ws + WS_MIX), (const bf16_t*)(ws + WS_WOUT), M_TOK, DM, DM};
        pg8::PanelOrder S; S.init(M_TOK, DM, (int)gridDim.x, (int)blockIdx.x); S.cnt = ctl + CW_P5;
        EpiOutNorm E{p.x, p.out, p.gf, (float*)(ws + WS_PART), ctl};
        pg8::gemm_phase<EpiOutNorm, pg8::PanelOrder, false, true, false>((LAS unsigned char*)lds, g, S, E);
    } else {
        pg8::Gemm g{(const bf16_t*)(ws + WS_MIX), (const bf16_t*)(ws + WS_WOUT), M_TOK, DM, DM};
        pg8::StaticOrder S; S.init(M_TOK, DM, (int)gridDim.x, (int)blockIdx.x);
        EpiOut E{p.x, p.out, (float*)(ws + WS_PART)};
        pg8::gemm_phase<EpiOut, pg8::StaticOrder, true, true>((LAS unsigned char*)lds, g, S, E);
        GSYNC();
        phase6(p);
    }
    if (DUP == 9) SEAM();
    }
#ifdef PROBE_T
    STAMP(); SEAM();
    if (blockIdx.x == PROBE_B && threadIdx.x == 0) { const unsigned long long* ds_ = (const unsigned long long*)(p.ws + 49152);
        p.out[0] = (PROBE_T >= 100) ? (float)(ds_[PROBE_T - 99] - ds_[PROBE_T - 100]) * 0.01f : (PROBE_T == 99) ? (float)(ds_[0] - ts_[6]) * 0.01f : (PROBE_T == 98) ? (float)(ts_[10] - ts_[0]) * 0.001f : (float)(ts_[PROBE_T + 1] - ts_[PROBE_T]) * 0.01f; }
#endif
}

extern "C" void kernel_launch(void* const* d_in, const int* in_sizes, int n_in, void* d_out, int out_size, void* d_ws, size_t ws_size, hipStream_t stream) {
    static int grid = 0;
    if (grid == 0) {
        if (n_in != 8 || in_sizes[0] != M_TOK * DM || out_size != M_TOK * DM || ws_size < WS_END) { fprintf(stderr, "kernel_launch: unexpected shapes (n_in %d, in0 %d, out %d, ws %zu)\n", n_in, n_in > 0 ? in_sizes[0] : -1, out_size, ws_size); grid = -1; return; }
        int dev = 0, cus = 0, per_cu = 0;
        hipGetDevice(&dev);
        hipDeviceGetAttribute(&cus, hipDeviceAttributeMultiprocessorCount, dev);
        if (hipFuncSetAttribute((const void*)hymba_fwd, hipFuncAttributeMaxDynamicSharedMemorySize, LDS_BYTES) != hipSuccess) { fprintf(stderr, "kernel_launch: hipFuncSetAttribute failed\n"); grid = -1; return; }
        if (hipOccupancyMaxActiveBlocksPerMultiprocessor(&per_cu, (const void*)hymba_fwd, 512, LDS_BYTES) != hipSuccess || per_cu < 1) { fprintf(stderr, "kernel_launch: occupancy query gave %d\n", per_cu); (void)hipGetLastError(); per_cu = 1; }
        grid = cus * per_cu;
        if (grid > 256) grid = 256;
    }
    if (grid < 0) return;
    Params p{};
    p.x = (const float*)d_in[0]; p.meta = (const float*)d_in[1]; p.g1 = (const float*)d_in[2]; p.w_in = (const float*)d_in[3];
    p.conv_w = (const float*)d_in[4]; p.rg = (const float*)d_in[5]; p.w_out = (const float*)d_in[6]; p.gf = (const float*)d_in[7];
    p.out = (float*)d_out; p.ws = (unsigned char*)d_ws;
    if (hipMemsetAsync(d_ws, 0, CTL_ZERO_BYTES, stream) != hipSuccess) { fprintf(stderr, "kernel_launch: hipMemsetAsync failed\n"); return; }
    void* args[] = {&p};
#ifdef PLAIN_LAUNCH
    (void)args; hipLaunchKernelGGL(hymba_fwd, dim3(grid), dim3(512), LDS_BYTES, stream, p); hipError_t e = hipPeekAtLastError();
#else
    hipError_t e = hipLaunchCooperativeKernel((const void*)hymba_fwd, dim3(grid), dim3(512), args, LDS_BYTES, stream);
#endif
    if (e != hipSuccess) fprintf(stderr, "cooperative launch failed: %s (grid %d)\n", hipGetErrorString(e), grid);
}
```

```cpp
#include <hip/hip_runtime.h>
#include <hip/hip_cooperative_groups.h>
#include <cstdio>
#include <cstdint>
namespace cg = cooperative_groups;

#define DI __device__ __forceinline__
#define LAS __attribute__((address_space(3)))
typedef unsigned short bf16_t;
typedef short bf16x8 __attribute__((ext_vector_type(8)));
typedef short s16x4 __attribute__((ext_vector_type(4)));
typedef short v4i16_t __attribute__((ext_vector_type(4)));
typedef float f32x2 __attribute__((ext_vector_type(2)));
typedef float f32x4 __attribute__((ext_vector_type(4)));
typedef float f32x16 __attribute__((ext_vector_type(16)));
typedef unsigned u32x2 __attribute__((ext_vector_type(2)));
typedef unsigned u32x4 __attribute__((ext_vector_type(4)));
typedef __bf16 bf16x2_t __attribute__((ext_vector_type(2)));

constexpr int M_TOK = 16384, DM = 1024, NPROJ = 4096, SEQ = 8192, NMETA = 16, NCHUNK = 64;
constexpr float EPS = 1e-6f;

constexpr size_t MiB = 1u << 20;
constexpr size_t WS_RSTD = 64 * 1024, WS_MP = 128 * 1024, WS_PART = 1 * MiB, WS_WIN = 2 * MiB, WS_WOUT = 10 * MiB, WS_XB = 16 * MiB;
constexpr size_t WS_HALO = 12 * MiB;
constexpr size_t WS_U = 48 * MiB, WS_G = 64 * MiB, WS_QS = 80 * MiB, WS_KZ = 96 * MiB, WS_V = 112 * MiB, WS_SRG = 128 * MiB;
constexpr size_t WS_UPD = 144 * MiB, WS_TT = 176 * MiB, WS_MIX = 194 * MiB, WS_END = 226 * MiB;
constexpr int LDS_BYTES = 147456;

DI unsigned pk2(float lo, float hi) { f32x2 v = {lo, hi}; bf16x2_t b = __builtin_convertvector(v, bf16x2_t); return __builtin_bit_cast(unsigned, b); }
DI float bf_lo(unsigned u) { return __uint_as_float(u << 16); }
DI float bf_hi(unsigned u) { return __uint_as_float(u & 0xffff0000u); }
DI float silu_f(float x) { return x * __builtin_amdgcn_rcpf(1.f + __expf(-x)); }
DI float wave_sum(float v) {
#pragma unroll
    for (int o = 1; o < 64; o <<= 1) v += __shfl_xor(v, o);
    return v;
}
DI void sincos_rr(float ang, float& s, float& c) {
    const float k = rintf(ang * 0.15915494309189535f);
    float r = fmaf(-k, 6.2831854820251465f, ang);
    r = fmaf(-k, -1.7484555e-7f, r);
    const float rev = r * 0.15915494309189535f;
    s = __builtin_amdgcn_sinf(rev); c = __builtin_amdgcn_cosf(rev);
}
DI int opaque_tid() { int t = threadIdx.x; asm volatile("" : "+v"(t)); return t; }
DI float rope_freq(int d) { return exp2f(-(float)d * (13.287712379549449f / 64.f)); }
DI float log2_gamma(int h) { return log2f(1.f - exp2f(-5.f - (float)h)); }

namespace pg8 {
constexpr int BM = 256, BK = 64, HALF = 128, HTB = HALF * BK * 2, STAGE_BYTES = 8 * HTB, NXCD = 8, WGM = 8;
DI int lds_byte(int r, int c) { const int st = (r >> 4) * 2 + (c >> 5), rr = r & 15, cc = c & 31, ob = rr * 64 + cc * 2; return st * 1024 + (ob ^ (((ob >> 9) & 1) << 5)); }
DI void stage_rc(int b, int& R, int& C) { const int st = b / 1024, sb = b % 1024, swz = sb ^ (((sb >> 9) & 1) << 5); R = (st >> 1) * 16 + swz / 64; C = (st & 1) * 32 + (swz % 64) / 2; }
DI int perm32(int rho) { const int n = rho >> 4, i = rho & 15; return 8 * (i >> 2) + 4 * n + (i & 3); }
struct Unit { int pm, pn; };
struct Gemm { const bf16_t* A; const bf16_t* Bt; int M, N, K; };
struct StaticOrder {
    int nM, nN, nwg, G, c;
    DI void init(int M, int N, int G_, int c_) { nM = M / BM; nN = N / BM; nwg = nM * nN; G = G_; c = c_; }
    DI bool next(int i, Unit& u) const {
        const long L = (long)i * G + c; if (L >= nwg) return false;
        int wgid = (int)L; { const int q = nwg / NXCD, r = nwg % NXCD, xcd = wgid % NXCD, off = wgid / NXCD; wgid = (xcd < r ? xcd * (q + 1) : r * (q + 1) + (xcd - r) * q) + off; }
        const int nig = WGM * nN, gid = wgid / nig, fm = gid * WGM, gsz = (nM - fm) < WGM ? (nM - fm) : WGM;
        u.pm = fm + ((wgid % nig) % gsz); u.pn = (wgid % nig) / gsz; return true;
    }
    DI void a_ready(const Unit&) const {}
    DI void done(const Unit&) const {}
    DI void mid(const Unit&, int) const {}
};
struct PanelOrder : StaticOrder {
    unsigned* cnt;
    DI void mid(const Unit& u, int t) const {
        if (t == 6) { if ((threadIdx.x & 63) == 0) { unsigned* c5 = cnt + 64 * u.pm; unsigned sp = 0u;
            while ((__hip_atomic_load(c5, __ATOMIC_RELAXED, __HIP_MEMORY_SCOPE_AGENT) & 255u) < 8u) { __builtin_amdgcn_s_sleep(1); if (++sp > (1u << 22)) break; } } }
    }
};

template <class Epi, class Sched, bool ALIGN_EPI = false, bool SP2 = false, bool TOUCH = false>
DI void gemm_phase(LAS unsigned char* lds, const Gemm g, const Sched& S, const Epi& E, const char* tbase = nullptr, size_t tpitch = 0, unsigned dump_off = 0) {
    const int tid = opaque_tid(), wid = __builtin_amdgcn_readfirstlane(tid >> 6), lane = tid & 63, wr = wid >> 2, wc = wid & 3, fr = lane & 15, fq = lane >> 4;
    const int K = g.K, nt = K / BK;
    unsigned voffA[2], voffB[2];
#pragma unroll
    for (int i = 0; i < 2; ++i) { int R, C; stage_rc(tid * 16 + i * 8192, R, C); const int Rb = Epi::PERM ? ((R & ~31) + perm32(R & 31)) : R;
        voffA[i] = (unsigned)(R * K + C) * 2u; voffB[i] = (unsigned)(Rb * K + C) * 2u; }
    const size_t kstep = (size_t)(BK * 2);
    const size_t hstep = (size_t)HALF * K * 2;
    const size_t tstep = 2 * hstep;
    const unsigned ldsw = (unsigned)wid * 1024u;
    const int aoff = lds_byte(wr * 64 + fr, fq * 8), boff = lds_byte(wc * 32 + fr, fq * 8);
#define PG8_SA(b, h) (((b) * 2 + (h)) * HTB)
#define PG8_SB(b, h) ((4 + (b) * 2 + (h)) * HTB)
#define PG8_STAGE(bufoff, gbase, voff) do { _Pragma("unroll") for (int _i = 0; _i < 2; ++_i) \
        __builtin_amdgcn_global_load_lds((const unsigned*)((const char*)(gbase) + (voff)[_i]), (LAS unsigned*)(lds + (bufoff) + ldsw + _i * 8192), 16, 0, 0); } while (0)
#define PG8_LDA(dst, b, h) do { _Pragma("unroll") for (int m = 0; m < 4; ++m) _Pragma("unroll") for (int k = 0; k < 2; ++k) dst[m][k] = *(const LAS bf16x8*)(lds + PG8_SA(b, h) + aoff + m * 2048 + k * 1024); } while (0)
#define PG8_LDB(dst, b, h) do { _Pragma("unroll") for (int n = 0; n < 2; ++n) _Pragma("unroll") for (int k = 0; k < 2; ++k) dst[n][k] = *(const LAS bf16x8*)(lds + PG8_SB(b, h) + boff + n * 2048 + k * 1024); } while (0)
#define PG8_MMA(ai, bj, At, Bt) do { __builtin_amdgcn_s_setprio(1); _Pragma("unroll") for (int m = 0; m < 4; ++m) _Pragma("unroll") for (int n = 0; n < 2; ++n) _Pragma("unroll") for (int k = 0; k < 2; ++k) \
        acc[ai][bj][m][n] = __builtin_amdgcn_mfma_f32_16x16x32_bf16(Bt[n][k], At[m][k], acc[ai][bj][m][n], 0, 0, 0); __builtin_amdgcn_s_setprio(0); } while (0)
#define PG8_WAIT_V(n) asm volatile("s_waitcnt vmcnt(" #n ")" ::: "memory")
#define PG8_WAIT_SP() do { if constexpr (TOUCH) PG8_WAIT_V(10); else PG8_WAIT_V(8); } while (0)
#define PG8_TOUCH(j) do { if constexpr (TOUCH) __builtin_amdgcn_global_load_lds((const unsigned*)(tptr + (size_t)(j) * tpitch), (LAS unsigned*)(lds + dump_off + ldsw), 16, 0, 0); } while (0)
#define PG8_WAIT_L(n) asm volatile("s_waitcnt lgkmcnt(" #n ")" ::: "memory")
#define PG8_BAR __builtin_amdgcn_s_barrier()
#define PG8_SCHED __builtin_amdgcn_sched_barrier(0)
    Unit cur, nxt; int ui = 0;
    if (!S.next(0, cur)) return;
    const char* tptr = nullptr;
    if constexpr (TOUCH) tptr = tbase + ((size_t)cur.pm * 256 + (size_t)wid * 32) * tpitch + (size_t)cur.pn * 1024 + (size_t)lane * 16;
    f32x4 acc[2][2][4][2];
#pragma unroll
    for (int a = 0; a < 2; ++a)
#pragma unroll
        for (int b = 0; b < 2; ++b)
#pragma unroll
            for (int m = 0; m < 4; ++m)
#pragma unroll
                for (int n = 0; n < 2; ++n) acc[a][b][m][n] = (f32x4){0.f, 0.f, 0.f, 0.f};
    bf16x8 At[4][2], B0[2][2], B1[2][2];
    const char* cA = (const char*)g.A + (size_t)cur.pm * tstep; const char* cB = (const char*)g.Bt + (size_t)cur.pn * tstep;
    S.a_ready(cur);
    if constexpr (SP2) {
        PG8_STAGE(PG8_SB(0, 0), cB, voffB); PG8_STAGE(PG8_SB(0, 1), cB + hstep, voffB); PG8_STAGE(PG8_SA(0, 0), cA, voffA); PG8_STAGE(PG8_SA(0, 1), cA + hstep, voffA);
        if (wr == 1) PG8_BAR;
        PG8_WAIT_V(2); PG8_BAR;
        PG8_STAGE(PG8_SB(1, 0), cB + kstep, voffB); PG8_STAGE(PG8_SA(1, 0), cA + kstep, voffA); PG8_STAGE(PG8_SB(1, 1), cB + hstep + kstep, voffB);
        PG8_WAIT_V(6); PG8_BAR;
    } else {
        PG8_STAGE(PG8_SB(0, 0), cB, voffB); PG8_STAGE(PG8_SA(0, 0), cA, voffA); PG8_STAGE(PG8_SB(0, 1), cB + hstep, voffB); PG8_STAGE(PG8_SA(0, 1), cA + hstep, voffA);
        if (wr == 1) PG8_BAR;
        PG8_WAIT_V(4); PG8_BAR;
        PG8_STAGE(PG8_SB(1, 0), cB + kstep, voffB); PG8_STAGE(PG8_SA(1, 0), cA + kstep, voffA); PG8_STAGE(PG8_SB(1, 1), cB + hstep + kstep, voffB);
        PG8_WAIT_V(6); PG8_BAR;
    }
    for (;;) {
        const bool has_next = S.next(ui + 1, nxt);
        const char* nA = has_next ? (const char*)g.A + (size_t)nxt.pm * tstep : cA; const char* nB = has_next ? (const char*)g.Bt + (size_t)nxt.pn * tstep : cB;
        for (int t = 0; t < nt; t += 2) {
            S.mid(cur, t);
            const bool last = (t == nt - 2);
            const char* a1 = cA + (size_t)(t + 1) * kstep;
            const char* a2 = last ? nA : cA + (size_t)(t + 2) * kstep; const char* b2 = last ? nB : cB + (size_t)(t + 2) * kstep;
            const char* a3 = a2 + kstep; const char* b3 = b2 + kstep;
            if (last && has_next) S.a_ready(nxt);
            if constexpr (SP2) {
            PG8_LDB(B0, 0, 0); PG8_LDB(B1, 0, 1); PG8_SCHED; PG8_LDA(At, 0, 0); PG8_STAGE(PG8_SA(1, 1), a1 + hstep, voffA); PG8_TOUCH(2 * t);
            PG8_WAIT_SP(); PG8_WAIT_L(0); PG8_BAR; PG8_MMA(0, 0, At, B0); PG8_MMA(0, 1, At, B1); PG8_BAR; PG8_SCHED;
            PG8_LDA(At, 0, 1); PG8_STAGE(PG8_SB(0, 0), b2, voffB); PG8_STAGE(PG8_SB(0, 1), b2 + hstep, voffB); PG8_STAGE(PG8_SA(0, 0), a2, voffA); PG8_TOUCH(2 * t + 1);
            PG8_WAIT_SP(); PG8_WAIT_L(0); PG8_BAR; PG8_MMA(1, 0, At, B0); PG8_MMA(1, 1, At, B1); PG8_BAR; PG8_SCHED;
            PG8_LDB(B0, 1, 0); PG8_LDB(B1, 1, 1); PG8_SCHED; PG8_LDA(At, 1, 0); PG8_STAGE(PG8_SA(0, 1), a2 + hstep, voffA); PG8_TOUCH(2 * t + 2);
            PG8_WAIT_SP(); PG8_WAIT_L(0); PG8_BAR; PG8_MMA(0, 0, At, B0); PG8_MMA(0, 1, At, B1); PG8_BAR; PG8_SCHED;
            PG8_LDA(At, 1, 1); PG8_STAGE(PG8_SB(1, 0), b3, voffB); PG8_STAGE(PG8_SB(1, 1), b3 + hstep, voffB); PG8_STAGE(PG8_SA(1, 0), a3, voffA); PG8_TOUCH(2 * t + 3);
            PG8_WAIT_SP(); PG8_WAIT_L(0); PG8_BAR; PG8_MMA(1, 0, At, B0); PG8_MMA(1, 1, At, B1); PG8_BAR; PG8_SCHED;
            } else {
            PG8_LDB(B0, 0, 0); PG8_SCHED; PG8_LDA(At, 0, 0); PG8_STAGE(PG8_SA(1, 1), a1 + hstep, voffA);
            PG8_WAIT_L(8); PG8_BAR; PG8_WAIT_L(0); PG8_MMA(0, 0, At, B0); PG8_BAR; PG8_SCHED;
            PG8_LDB(B1, 0, 1); PG8_STAGE(PG8_SB(0, 0), b2, voffB);
            PG8_BAR; PG8_WAIT_L(0); PG8_MMA(0, 1, At, B1); PG8_BAR;
            PG8_LDA(At, 0, 1); PG8_STAGE(PG8_SA(0, 0), a2, voffA);
            PG8_BAR; PG8_WAIT_L(0); PG8_MMA(1, 0, At, B0); PG8_BAR; PG8_SCHED;
            PG8_STAGE(PG8_SB(0, 1), b2 + hstep, voffB);
            PG8_WAIT_V(6); PG8_BAR; PG8_MMA(1, 1, At, B1); PG8_BAR;
            PG8_LDB(B0, 1, 0); PG8_SCHED; PG8_LDA(At, 1, 0); PG8_STAGE(PG8_SA(0, 1), a2 + hstep, voffA);
            PG8_WAIT_L(8); PG8_BAR; PG8_WAIT_L(0); PG8_MMA(0, 0, At, B0); PG8_BAR; PG8_SCHED;
            PG8_LDB(B1, 1, 1); PG8_STAGE(PG8_SB(1, 0), b3, voffB);
            PG8_BAR; PG8_WAIT_L(0); PG8_MMA(0, 1, At, B1); PG8_BAR;
            PG8_LDA(At, 1, 1); PG8_STAGE(PG8_SA(1, 0), a3, voffA);
            PG8_BAR; PG8_WAIT_L(0); PG8_MMA(1, 0, At, B0); PG8_BAR; PG8_SCHED;
            PG8_STAGE(PG8_SB(1, 1), b3 + hstep, voffB);
            PG8_WAIT_V(6); PG8_BAR; PG8_MMA(1, 1, At, B1); PG8_BAR;
            }
        }
        if constexpr (ALIGN_EPI) { if (wr == 0) PG8_BAR; }
        if constexpr (!Epi::AFTER_DRAIN) { E(acc, cur, wr, wc, fr, fq); S.done(cur); }
        if (!has_next) break;
#pragma unroll
        for (int a = 0; a < 2; ++a)
#pragma unroll
            for (int b = 0; b < 2; ++b)
#pragma unroll
                for (int m = 0; m < 4; ++m)
#pragma unroll
                    for (int n = 0; n < 2; ++n) acc[a][b][m][n] = (f32x4){0.f, 0.f, 0.f, 0.f};
        cur = nxt; cA = nA; cB = nB; ++ui;
        if constexpr (ALIGN_EPI) { if (wr == 1) PG8_BAR; }
    }
    PG8_WAIT_V(0);
    if constexpr (!ALIGN_EPI) { if (wr == 0) PG8_BAR; }
    PG8_BAR;
    if constexpr (Epi::AFTER_DRAIN) { E.fused(acc, cur, wr, wc, fr, fq, lds, wid, lane); S.done(cur); }
#undef PG8_SA
#undef PG8_SB
#undef PG8_STAGE
#undef PG8_LDA
#undef PG8_LDB
#undef PG8_MMA
#undef PG8_WAIT_V
#undef PG8_WAIT_SP
#undef PG8_TOUCH
#undef PG8_WAIT_L
#undef PG8_BAR
#undef PG8_SCHED
}
}


#define XB_TMO      128
#define XB_XCNT(j)  (256  + 64 * (j))
#define XB_XSUB(j)  (1280 + 64 * (j))
#define XB_XGEN(j)  (2304 + 64 * (j))
#define XB_TOP      3328
#define XB_TOPGEN   3392
#define XCD_BAR_WORDS 3456
#define XB_SPIN_CAP (1u << 18)
constexpr int CW_PANEL = 4096, CW_C2 = 8192, CW_C3 = 8192 + 512, CW_P5 = 9216;
constexpr size_t CTL_ZERO_BYTES = 57344;
DI unsigned xb_ld(unsigned* p)              { return __hip_atomic_load(p, __ATOMIC_RELAXED, __HIP_MEMORY_SCOPE_AGENT); }
DI unsigned xb_add(unsigned* p, unsigned v) { return __hip_atomic_fetch_add(p, v, __ATOMIC_RELAXED, __HIP_MEMORY_SCOPE_AGENT); }
DI unsigned xb_xcc_id() { return (unsigned)__builtin_amdgcn_s_getreg((3 << 11) | 20) & 0xFu; }
#define XB_SPIN(cond, bar) do { unsigned _sp = 0; while (cond) { __builtin_amdgcn_s_sleep(1); \
    if ((++_sp & 255u) == 0u) { if (xb_ld(&(bar)[XB_TMO])) break; if (_sp > XB_SPIN_CAP) { atomicAdd(&(bar)[XB_TMO], 1u); break; } } } } while (0)
struct XcdBarrier { unsigned* bar; unsigned x; volatile LAS unsigned* st; };
DI XcdBarrier xcd_barrier_post(unsigned* bar, volatile LAS unsigned* st) {
    XcdBarrier b; b.bar = bar; b.x = xb_xcc_id(); b.st = st;
    if (threadIdx.x == 0) (void)xb_add(&bar[XB_XCNT(b.x)], 1u);
    return b;
}
DI void xcd_barrier_complete(unsigned* bar, unsigned x, unsigned& nloc, unsigned& nx) {
    const unsigned G = gridDim.x * gridDim.y * gridDim.z;
    unsigned sum, cnt, mine, sp = 0u;
    for (;;) {
        sum = 0u; cnt = 0u; mine = 0u;
#pragma unroll
        for (unsigned j = 0; j < 16; ++j) { const unsigned c = xb_ld(&bar[XB_XCNT(j)]); sum += c; cnt += (c > 0u) ? 1u : 0u; mine = (j == x) ? c : mine; }
        if (sum == G) break;
        __builtin_amdgcn_s_sleep(1);
        if ((++sp & 255u) == 0u) { if (xb_ld(&bar[XB_TMO])) break; if (sp > XB_SPIN_CAP) { atomicAdd(&bar[XB_TMO], 1u); break; } }
    }
    nloc = mine > 0u ? mine : 1u; nx = cnt > 0u ? cnt : 1u;
}
DI void xcd_barrier(const XcdBarrier& b) {
    asm volatile("s_waitcnt vmcnt(0)" ::: "memory");
    __syncthreads();
    if (threadIdx.x == 0) {
        unsigned* bar = b.bar;
        __builtin_amdgcn_s_waitcnt(0);
        unsigned nloc = b.st[0], nx = b.st[1];
        if (nloc == 0u) { xcd_barrier_complete(bar, b.x, nloc, nx); b.st[0] = nloc; b.st[1] = nx; }
        const unsigned old = xb_add(&bar[XB_XSUB(b.x)], 1u);
        const unsigned gen = old / nloc;
        if (old + 1u == (gen + 1u) * nloc) {
            __builtin_amdgcn_fence(__ATOMIC_RELEASE, "agent");
            asm volatile("s_waitcnt vmcnt(0)" ::: "memory");
            const unsigned og = xb_add(&bar[XB_TOP], 1u);
            const unsigned tg = og / nx;
            if (og + 1u == (tg + 1u) * nx) xb_add(&bar[XB_TOPGEN], 1u);
            else XB_SPIN(xb_ld(&bar[XB_TOPGEN]) == tg, bar);
            __builtin_amdgcn_fence(__ATOMIC_ACQUIRE, "agent");
            xb_add(&bar[XB_XGEN(b.x)], 1u);
            asm volatile("s_waitcnt vmcnt(0)" ::: "memory");
        } else {
            XB_SPIN(xb_ld(&bar[XB_XGEN(b.x)]) == gen, bar);
            __builtin_amdgcn_fence(__ATOMIC_ACQUIRE, "agent");
            asm volatile("s_waitcnt vmcnt(0)" ::: "memory");
        }
    }
    __syncthreads();
}


DI u32x4 pack8(f32x4 a, f32x4 b) { u32x4 w; w.x = pk2(a[0], a[1]); w.y = pk2(a[2], a[3]); w.z = pk2(b[0], b[1]); w.w = pk2(b[2], b[3]); return w; }
DI f32x4 silu4(f32x4 v) { f32x4 o; o[0] = silu_f(v[0]); o[1] = silu_f(v[1]); o[2] = silu_f(v[2]); o[3] = silu_f(v[3]); return o; }

DI void store16_sc1(void* ptr, u32x4 v) { asm volatile("global_store_dwordx4 %0, %1, off sc1\n\ts_nop 1" :: "v"(ptr), "v"(v) : "memory"); }

struct EpiProj {
    static constexpr bool PERM = true, AFTER_DRAIN = false;
    const float* rstd; bf16_t *MIX, *QS, *KZ, *V, *SRG; const float* convw; float* halo; LAS unsigned char* xlds;
    DI void operator()(const f32x4 (&acc)[2][2][4][2], const pg8::Unit& u, int wr, int wc, int fr, int fq) const {
        const int pn = u.pn;
        const int row0 = u.pm * 256 + wr * 64 + fr;
        const int cw = wc * 32 + 8 * fq;
        if (pn < 8) {
            const int ch0 = pn * 64 + 16 * wc + 4 * fq;
            const f32x4 w0 = *(const f32x4*)(convw + ch0), w1 = *(const f32x4*)(convw + 512 + ch0), w2 = *(const f32x4*)(convw + 1024 + ch0);
            f32x4 u3[2];
#pragma unroll
            for (int ai = 0; ai < 2; ++ai) { const float rs = rstd[row0 + ai * 128 + 48]; u3[ai] = (acc[ai][0][3][0] * rs) * (acc[ai][0][3][1] * rs); }
            LAS float* xb = (LAS float*)(xlds);
            if (fr >= 14) {
#pragma unroll
                for (int ai = 0; ai < 2; ++ai) *(LAS f32x4*)(xb + (((ai * 2 + wr) * 4 + wc) * 2 + (fr - 14)) * 16 + 4 * fq) = u3[ai];
                if (wr == 1) *(f32x4*)(halo + ((size_t)(u.pm * 3 + 2) * 2 + (fr - 14)) * 512 + ch0) = u3[1];
            }
            asm volatile("s_waitcnt lgkmcnt(0)" ::: "memory");
            __builtin_amdgcn_s_barrier();
#pragma unroll
            for (int ai = 0; ai < 2; ++ai) {
                f32x4 o1, o2, up = (f32x4){0.f, 0.f, 0.f, 0.f};
                bool havep = true;
                if (ai == 0 && wr == 0) { havep = false; o1 = (f32x4){0.f, 0.f, 0.f, 0.f}; o2 = o1; }
                else { const int pa = (wr == 1) ? ai : 0, pw = (wr == 1) ? 0 : 1;
                    const f32x4 p15 = *(const LAS f32x4*)(xb + (((pa * 2 + pw) * 4 + wc) * 2 + 1) * 16 + 4 * fq), p14 = *(const LAS f32x4*)(xb + (((pa * 2 + pw) * 4 + wc) * 2 + 0) * 16 + 4 * fq);
                    o1 = p15; o2 = (fr == 0) ? p14 : p15; }
#pragma unroll
                for (int m = 0; m < 4; ++m) {
                    const int row = row0 + ai * 128 + m * 16; const float rs = rstd[row];
                    const f32x4 uc = (acc[ai][0][m][0] * rs) * (acc[ai][0][m][1] * rs);
                    const int lane_ = fq * 16 + fr;
                    if (m > 0) {
#pragma unroll
                        for (int j = 0; j < 4; ++j) { o1[j] = __shfl(up[j], (lane_ & 48) + ((fr + 15) & 15)); o2[j] = __shfl(up[j], (lane_ & 48) + ((fr + 14) & 15)); }
                    }
                    f32x4 u1, u2;
#pragma unroll
                    for (int j = 0; j < 4; ++j) { const float s1 = __shfl(uc[j], (lane_ & 48) + ((fr + 15) & 15)), s2 = __shfl(uc[j], (lane_ & 48) + ((fr + 14) & 15));
                        u1[j] = (fr >= 1) ? s1 : o1[j]; u2[j] = (fr >= 2) ? s2 : o2[j]; }
                    const f32x4 cv3 = w0 * u2 + w1 * u1 + w2 * uc;
                    const f32x4 gate = (acc[ai][1][m][0] * rs) * silu4(acc[ai][1][m][1] * rs);
                    if (!havep && m == 0 && fr < 2) {
                        *(f32x4*)(halo + ((size_t)(u.pm * 3 + 0) * 2 + fr) * 512 + ch0) = cv3;
                        *(f32x4*)(halo + ((size_t)(u.pm * 3 + 1) * 2 + fr) * 512 + ch0) = gate;
                    } else {
                        const f32x4 o = gate * cv3; u32x2 w; w.x = pk2(o[0], o[1]); w.y = pk2(o[2], o[3]);
                        *(u32x2*)(MIX + (size_t)row * 1024 + ch0) = w;
                    }
                    up = uc;
                }
            }
        } else if (pn < 12) {
            const bool isq = pn < 10;
            const int head = 2 * ((pn - 8) & 1) + (wc >> 1);
            const int d0 = cw & 63;
            float fr8[8];
#pragma unroll
            for (int j = 0; j < 8; ++j) fr8[j] = rope_freq(d0 + j);
            const float lg = log2_gamma(head);
            bf16_t* dst = (isq ? QS : KZ) + head * 128 + d0;
#pragma unroll
            for (int ai = 0; ai < 2; ++ai)
#pragma unroll
                for (int m = 0; m < 4; ++m) {
                    const int row = row0 + ai * 128 + m * 16; const float rs = rstd[row];
                    const int t = row & (SEQ - 1), tl = t & 127; const float pos = (float)(NMETA + t);
                    const float sc = rs * (isq ? 0.08838834764831845f * exp2f((float)(tl - 127) * lg) : exp2f((float)(127 - tl) * lg));
                    f32x4 r1[2], r2[2];
#pragma unroll
                    for (int j = 0; j < 8; ++j) {
                        float s, c; sincos_rr(pos * fr8[j], s, c);
                        const float x1 = acc[ai][0][m][j >> 2][j & 3], x2 = acc[ai][1][m][j >> 2][j & 3];
                        r1[j >> 2][j & 3] = (x1 * c - x2 * s) * sc; r2[j >> 2][j & 3] = (x1 * s + x2 * c) * sc;
                    }
                    *(u32x4*)(dst + (size_t)row * 512) = pack8(r1[0], r1[1]);
                    *(u32x4*)(dst + (size_t)row * 512 + 64) = pack8(r2[0], r2[1]);
                }
        } else {
            const bool isv = pn < 14;
            bf16_t* dst = (isv ? V : SRG) + ((pn - 12) & 1) * 256 + cw;
#pragma unroll
            for (int ai = 0; ai < 2; ++ai)
#pragma unroll
                for (int m = 0; m < 4; ++m) {
                    const int row = row0 + ai * 128 + m * 16; const float rs = rstd[row];
#pragma unroll
                    for (int bj = 0; bj < 2; ++bj) {
                        f32x4 a0 = acc[ai][bj][m][0] * rs, a1 = acc[ai][bj][m][1] * rs;
                        if (!isv) { a0 = silu4(a0); a1 = silu4(a1); }
                        *(u32x4*)(dst + (size_t)row * 512 + bj * 128) = pack8(a0, a1);
                    }
                }
        }
    }
};

struct EpiOut {
    static constexpr bool PERM = true, AFTER_DRAIN = false;
    const float* x; float* out; float* part;
    DI void operator()(const f32x4 (&acc)[2][2][4][2], const pg8::Unit& u, int wr, int wc, int fr, int fq) const {
        const int row0 = u.pm * 256 + wr * 64 + fr, col0 = u.pn * 256 + wc * 32 + 8 * fq;
#pragma unroll
        for (int ai = 0; ai < 2; ++ai)
#pragma unroll
            for (int m = 0; m < 4; ++m) {
                const int row = row0 + ai * 128 + m * 16; float ss = 0.f;
#pragma unroll
                for (int bj = 0; bj < 2; ++bj) {
                    const size_t o = (size_t)row * DM + col0 + bj * 128;
                    const f32x4 y0 = acc[ai][bj][m][0] + *(const f32x4*)(x + o), y1 = acc[ai][bj][m][1] + *(const f32x4*)(x + o + 4);
                    ss += (y0[0] * y0[0] + y0[1] * y0[1]) + (y0[2] * y0[2] + y0[3] * y0[3]) + (y1[0] * y1[0] + y1[1] * y1[1]) + (y1[2] * y1[2] + y1[3] * y1[3]);
                    *(f32x4*)(out + o) = y0; *(f32x4*)(out + o + 4) = y1;
                }
                ss += __shfl_xor(ss, 16); ss += __shfl_xor(ss, 32);
                if (fq == 0) part[(size_t)(u.pn * 4 + wc) * M_TOK + row] = ss;
            }
    }
};


struct EpiOutNorm {
    static constexpr bool PERM = true, AFTER_DRAIN = true;
    const float* x; float* out; const float* gf; float* xch; unsigned* ctl;
    DI void fused(f32x4 (&acc)[2][2][4][2], const pg8::Unit& u, int wr, int wc, int fr, int fq, LAS unsigned char* lds, int wid, int lane) const {
        LAS float* R = (LAS float*)(lds + 131072 + 1024);
        f32x4 y[2][16];
        float* slot = xch + (size_t)(u.pm * 4) * 256;
#pragma unroll
        for (int ai = 0; ai < 2; ++ai) {
            if (ai) __syncthreads();
#pragma unroll
            for (int m = 0; m < 4; ++m)
#pragma unroll
                for (int bj = 0; bj < 2; ++bj)
#pragma unroll
                    for (int n = 0; n < 2; ++n) { const int r = wr * 64 + m * 16 + fr, ch = 32 * bj + 8 * wc + 2 * fq + n;
                        *(LAS f32x4*)(lds + r * 1024 + ((ch ^ (r & 15)) << 4)) = acc[ai][bj][m][n]; }
            __syncthreads();
            f32x4 xv[16];
#pragma unroll
            for (int k = 0; k < 16; ++k) { const int r = wid + 8 * k; xv[k] = __builtin_nontemporal_load((const f32x4*)(x + (size_t)(u.pm * 256 + ai * 128 + r) * DM + u.pn * 256) + lane); }
#pragma unroll
            for (int k = 0; k < 16; ++k) { const int r = wid + 8 * k;
                const f32x4 v = *(const LAS f32x4*)(lds + r * 1024 + ((lane ^ (r & 15)) << 4)) + xv[k];
                y[ai][k] = v;
                const float ss = wave_sum((v[0] * v[0] + v[1] * v[1]) + (v[2] * v[2] + v[3] * v[3]));
                if (lane == 0) __hip_atomic_store(slot + u.pn * 256 + ai * 128 + r, ss, __ATOMIC_RELAXED, __HIP_MEMORY_SCOPE_AGENT); }
        }
        const int tid = wid * 64 + lane;
        asm volatile("s_waitcnt vmcnt(0)" ::: "memory");
        __syncthreads();
        if (tid == 0) {
            unsigned* cnt = ctl + CW_PANEL + 64 * u.pm;
            xb_add(cnt, 1u);
            unsigned sp = 0u;
            while (xb_ld(cnt) < 4u) { __builtin_amdgcn_s_sleep(1); if (++sp > (1u << 22)) break; }
        }
        __syncthreads();
        if (tid < 256) { float s = 0.f;
#pragma unroll
            for (int q = 0; q < 4; ++q) s += __hip_atomic_load(slot + q * 256 + tid, __ATOMIC_RELAXED, __HIP_MEMORY_SCOPE_AGENT);
            R[tid] = 1.f / sqrtf(s * (1.f / 1024.f) + EPS); }
        __syncthreads();
        const f32x4 gv = *((const f32x4*)(gf + u.pn * 256) + lane);
#pragma unroll
        for (int ai = 0; ai < 2; ++ai)
#pragma unroll
            for (int k = 0; k < 16; ++k) { const int r = ai * 128 + wid + 8 * k; const float rs = R[r];
                __builtin_nontemporal_store(y[ai][k] * rs * gv, (f32x4*)(out + (size_t)(u.pm * 256 + r) * DM + u.pn * 256) + lane); }
    }
};

DI unsigned off_b(unsigned row, unsigned ch) { return 256u * row + 16u * (ch ^ (((row & 3) << 2) | ((row >> 2) & 3))); }
DI bf16x8 row_frag(const unsigned char* img, int rb, int s, int lane) {
    return *(const bf16x8*)(img + 8192 * rb + off_b(lane & 31, 2 * s + (lane >> 5)));
}
DI s16x4 tr_read(const unsigned char* p) { return __builtin_bit_cast(s16x4, __builtin_amdgcn_ds_read_tr16_b64_v4i16((LAS v4i16_t*)(const LAS unsigned char*)p)); }
template <bool PERMK> DI bf16x8 tr_frag(const unsigned char* img, int c, int rbase, int lane) {
    const int h = lane >> 5, blk = (lane >> 4) & 1, q = (lane & 15) >> 2, p = lane & 3;
    const int r0 = rbase + (PERMK ? 4 * h : 8 * h) + q, r1 = r0 + (PERMK ? 8 : 4);
    const unsigned ch = 4 * c + 2 * blk + (p >> 1), bo = 8 * (p & 1);
    const s16x4 lo = tr_read(img + off_b(r0, ch) + bo), hi = tr_read(img + off_b(r1, ch) + bo);
    return __builtin_shufflevector(lo, hi, 0, 1, 2, 3, 4, 5, 6, 7);
}
DI void load_tile(unsigned char* img, const bf16_t* src, int ld, int tid) {
#pragma unroll
    for (int i = 0; i < 4; ++i) { const int idx = tid + 512 * i, row = idx >> 4, ch = idx & 15;
        *(u32x4*)(img + off_b(row, ch)) = *(const u32x4*)(src + (size_t)row * ld + ch * 8); }
}
DI void tile_ld(u32x4 (&r)[4], const bf16_t* src, int ld, int tid) {
#pragma unroll
    for (int i = 0; i < 4; ++i) { const int idx = tid + 512 * i, row = idx >> 4, ch = idx & 15; r[i] = *(const u32x4*)(src + (size_t)row * ld + ch * 8); }
}
DI void tile_st(unsigned char* img, const u32x4 (&r)[4], int tid) {
#pragma unroll
    for (int i = 0; i < 4; ++i) { const int idx = tid + 512 * i, row = idx >> 4, ch = idx & 15; *(u32x4*)(img + off_b(row, ch)) = r[i]; }
}
DI int crow(int reg, int h) { return (reg & 3) + 8 * (reg >> 2) + 4 * h; }
#define MFMA32(a, b, c) __builtin_amdgcn_mfma_f32_32x32x16_bf16((a), (b), (c), 0, 0, 0)

struct Params { const float *x, *meta, *g1, *w_in, *conv_w, *rg, *w_out, *gf; float* out; unsigned char* ws; };


DI int dest_pos(int n) {
    const int type = n >> 9, r = n & 511;
    if (type < 4) {
        const int rr = r & 63, wc = rr >> 4, fq = (rr >> 2) & 3, j = rr & 3;
        const int bj = (type == 1 || type == 3) ? 1 : 0, nn = (type >= 2) ? 1 : 0;
        return (r >> 6) * 256 + 128 * bj + 32 * wc + 8 * fq + 4 * nn + j;
    }
    if (type < 6) { const int h = r >> 7, d = r & 127; return (8 + (type - 4) * 2 + (h >> 1)) * 256 + (d >> 6) * 128 + (h & 1) * 64 + (d & 63); }
    return n;
}

DI void p0_tr_load(float (&w)[32], const float* W, const float* gain, int N, int item, int lane) {
    const int nblk = N / 32, kb = item / nblk, nb = item % nblk, k0 = 64 * kb, n0 = 32 * nb;
#pragma unroll
    for (int i = 0; i < 32; ++i) { const int kk = 2 * i + (lane >> 5); w[i] = __builtin_nontemporal_load(W + (size_t)(k0 + kk) * N + n0 + (lane & 31)); if (gain) w[i] *= gain[k0 + kk]; }
}
DI void p0_tr_finish(const float (&w)[32], int K, int N, bf16_t* WT, bool perm, float* scr, int item, int lane) {
    const int nblk = N / 32, kb = item / nblk, nb = item % nblk, k0 = 64 * kb, n0 = 32 * nb;
#pragma unroll
    for (int i = 0; i < 32; ++i) { const int kk = 2 * i + (lane >> 5); scr[kk * 33 + (lane & 31)] = w[i]; }
    __builtin_amdgcn_s_waitcnt(0xc07f); asm volatile("" ::: "memory");
    const int c = lane & 7;
#pragma unroll
    for (int j = 0; j < 4; ++j) { const int n = (lane >> 3) + 8 * j; const float* s = scr + (8 * c) * 33 + n;
        u32x4 o; o.x = pk2(s[0 * 33], s[1 * 33]); o.y = pk2(s[2 * 33], s[3 * 33]); o.z = pk2(s[4 * 33], s[5 * 33]); o.w = pk2(s[6 * 33], s[7 * 33]);
        *(u32x4*)(WT + (size_t)(perm ? dest_pos(n0 + n) : n0 + n) * K + k0 + 8 * c) = o; }
    __builtin_amdgcn_s_waitcnt(0xc07f); asm volatile("" ::: "memory");
}

DI void phase0(const Params& p, unsigned char* lds) {
    const int tid = opaque_tid(), lane = tid & 63, wave = tid >> 6;
    unsigned char* ws = p.ws;
    float* rstd = (float*)(ws + WS_RSTD); float* MP = (float*)(ws + WS_MP);
    bf16_t* XB = (bf16_t*)(ws + WS_XB); bf16_t* WIN = (bf16_t*)(ws + WS_WIN); bf16_t* WOUT = (bf16_t*)(ws + WS_WOUT);
    {
        float* metaL = (float*)lds; float* red = (float*)(lds + 65536); float* rsL = (float*)(lds + 98304);
        for (int i = tid; i < 4096; i += 512) ((f32x4*)metaL)[i] = ((const f32x4*)p.meta)[i];
        __syncthreads();
#pragma unroll
        for (int rr = 0; rr < 2; ++rr) { const int m = 2 * wave + rr; float s = 0.f;
#pragma unroll
            for (int i = 0; i < 16; ++i) { const float v = metaL[m * 1024 + lane + 64 * i]; s += v * v; }
            s = wave_sum(s); if (lane == 0) rsL[m] = 1.f / sqrtf(s * (1.f / 1024.f) + EPS); }
        for (int cgp = blockIdx.x; cgp < 256; cgp += gridDim.x) {
            const int col = tid & 15, ks = tid >> 4, n = cgp * 16 + col;
            float a[16], wv[32];
#pragma unroll
            for (int m = 0; m < 16; ++m) a[m] = 0.f;
#pragma unroll
            for (int kk = 0; kk < 32; ++kk) { const int k = kk * 32 + ks; wv[kk] = p.w_in[(size_t)k * NPROJ + n] * p.g1[k]; }
#pragma unroll
            for (int kk = 0; kk < 32; ++kk) { const int k = kk * 32 + ks;
#pragma unroll
                for (int m = 0; m < 16; ++m) a[m] = fmaf(metaL[m * 1024 + k], wv[kk], a[m]); }
#pragma unroll
            for (int m = 0; m < 16; ++m) red[(ks * 16 + m) * 16 + col] = a[m];
            __syncthreads();
            if (tid < 256) { const int m = tid >> 4, c = tid & 15; float s = 0.f;
#pragma unroll 8
                for (int k2 = 0; k2 < 32; ++k2) s += red[(k2 * 16 + m) * 16 + c];
                MP[m * NPROJ + cgp * 16 + c] = s * rsL[m]; }
            __syncthreads();
        }
    }
    __syncthreads();
    const int gw = blockIdx.x * 8 + wave, NGW = gridDim.x * 8;
    {
        float* scr = (float*)(lds + wave * 16384);
        constexpr int I_IN = (DM / 64) * (NPROJ / 32), I_OUT = (DM / 64) * (DM / 32);
        for (int it = gw; it < I_IN + I_OUT; it += 2 * NGW) {
            const int it2 = it + NGW; const bool has2 = it2 < I_IN + I_OUT;
            float wa[32], wb[32];
            if (it < I_IN) p0_tr_load(wa, p.w_in, p.g1, NPROJ, it, lane); else p0_tr_load(wa, p.w_out, nullptr, DM, it - I_IN, lane);
            if (has2) { if (it2 < I_IN) p0_tr_load(wb, p.w_in, p.g1, NPROJ, it2, lane); else p0_tr_load(wb, p.w_out, nullptr, DM, it2 - I_IN, lane); }
            if (it < I_IN) p0_tr_finish(wa, DM, NPROJ, WIN, true, scr, it, lane); else p0_tr_finish(wa, DM, DM, WOUT, false, scr, it - I_IN, lane);
            if (has2) { if (it2 < I_IN) p0_tr_finish(wb, DM, NPROJ, WIN, true, scr, it2, lane); else p0_tr_finish(wb, DM, DM, WOUT, false, scr, it2 - I_IN, lane); }
        }
    }
    for (int row = gw; row < M_TOK; row += 4 * NGW) {
        f32x4 v[4][4]; float s[4];
#pragma unroll
        for (int q = 0; q < 4; ++q) { const f32x4* xr = (const f32x4*)(p.x + (size_t)(row + q * NGW) * DM) + lane;
#pragma unroll
            for (int j = 0; j < 4; ++j) v[q][j] = __builtin_nontemporal_load(xr + 64 * j); }
#pragma unroll
        for (int q = 0; q < 4; ++q) { float a = 0.f;
#pragma unroll
            for (int j = 0; j < 4; ++j) a += (v[q][j][0] * v[q][j][0] + v[q][j][1] * v[q][j][1]) + (v[q][j][2] * v[q][j][2] + v[q][j][3] * v[q][j][3]);
            s[q] = wave_sum(a); }
#pragma unroll
        for (int q = 0; q < 4; ++q) { const int r = row + q * NGW;
            if (lane == 0) rstd[r] = 1.f / sqrtf(s[q] * (1.f / 1024.f) + EPS);
            u32x2* o = (u32x2*)(XB + (size_t)r * DM) + lane;
#pragma unroll
            for (int j = 0; j < 4; ++j) { u32x2 w; w.x = pk2(v[q][j][0], v[q][j][1]); w.y = pk2(v[q][j][2], v[q][j][3]); o[64 * j] = w; } }
    }
}

template <bool FUSED> DI void phase2(const Params& p, unsigned char* lds, unsigned* ctl) {
    const int tid = opaque_tid(), lane = tid & 63, wave = tid >> 6, h5 = lane >> 5;
    const bf16_t* KZ = (const bf16_t*)(p.ws + WS_KZ); const bf16_t* V = (const bf16_t*)(p.ws + WS_V); bf16_t* UPD = (bf16_t*)(p.ws + WS_UPD);
    unsigned char* Kimg = lds; unsigned char* Vimg = lds + 32768;
    const int eb = wave & 3, dh = wave >> 2;
    u32x4 pk[4], pv[4];
    if (blockIdx.x < 8 * 63) { const int it = blockIdx.x, bh = it / 63, n = 1 + it % 63; const size_t row0 = (size_t)(bh >> 2) * SEQ + (size_t)(n - 1) * 128;
        tile_ld(pk, KZ + row0 * 512 + (bh & 3) * 128, 512, tid); tile_ld(pv, V + row0 * 512 + (bh & 3) * 128, 512, tid); }
    for (int it = blockIdx.x; it < 8 * 63; it += gridDim.x) {
        const int bh = it / 63, n = 1 + it % 63;
        tile_st(Kimg, pk, tid); tile_st(Vimg, pv, tid);
        __syncthreads();
        { const int it2 = it + gridDim.x; if (it2 < 8 * 63) { const int bh2 = it2 / 63, n2 = 1 + it2 % 63; const size_t row2 = (size_t)(bh2 >> 2) * SEQ + (size_t)(n2 - 1) * 128;
            tile_ld(pk, KZ + row2 * 512 + (bh2 & 3) * 128, 512, tid); tile_ld(pv, V + row2 * 512 + (bh2 & 3) * 128, 512, tid); } }
        f32x16 a0, a1;
#pragma unroll
        for (int i = 0; i < 16; ++i) { a0[i] = 0.f; a1[i] = 0.f; }
#pragma unroll
        for (int ks = 0; ks < 8; ++ks) {
            const bf16x8 av = tr_frag<false>(Vimg, eb, 16 * ks, lane);
            const bf16x8 b0 = tr_frag<false>(Kimg, 2 * dh, 16 * ks, lane), b1 = tr_frag<false>(Kimg, 2 * dh + 1, 16 * ks, lane);
            a0 = MFMA32(av, b0, a0); a1 = MFMA32(av, b1, a1);
        }
        bf16_t* dst = UPD + ((size_t)(bh * 64 + n) * 128 + 32 * eb) * 128 + 64 * dh + (lane & 31);
#pragma unroll
        for (int r = 0; r < 16; ++r) { const int e = crow(r, h5);
            const unsigned pw_ = pk2(a0[r], a1[r]); const bf16_t v0 = (bf16_t)(pw_ & 0xffffu), v1 = (bf16_t)(pw_ >> 16);
            if constexpr (FUSED) { __hip_atomic_store(dst + e * 128, v0, __ATOMIC_RELAXED, __HIP_MEMORY_SCOPE_AGENT); __hip_atomic_store(dst + e * 128 + 32, v1, __ATOMIC_RELAXED, __HIP_MEMORY_SCOPE_AGENT); }
            else { dst[e * 128] = v0; dst[e * 128 + 32] = v1; } }
        if constexpr (FUSED) asm volatile("s_waitcnt vmcnt(0)" ::: "memory");
        __syncthreads();
        if constexpr (FUSED) { if (tid == 0) xb_add(ctl + CW_C2 + 64 * bh, 1u); }
    }
}

#ifdef PROBE_T
#define DSTAMP(k) do { if (blockIdx.x == PROBE_B && threadIdx.x == 0) ((unsigned long long*)(p.ws + 49152))[k] = __builtin_amdgcn_s_memrealtime(); } while (0)
#else
#define DSTAMP(k) do {} while (0)
#endif
template <bool FUSED> DI void phase3(const Params& p, unsigned char* lds, unsigned* ctl) {
    const float* MP = (const float*)(p.ws + WS_MP); const bf16_t* UPD = (const bf16_t*)(p.ws + WS_UPD); bf16_t* TT = (bf16_t*)(p.ws + WS_TT);
    const int tid3 = opaque_tid();
    float* kzL = (float*)lds; float* vL = (float*)(lds + 8192);
    if constexpr (FUSED) {
        const int h = (blockIdx.x >> 5) & 3, e0 = (blockIdx.x & 31) * 4; const float lg = log2_gamma(h);
#pragma unroll
        for (int i = 0; i < 4; ++i) { const int idx = tid3 + 512 * i, m = idx >> 7, d = idx & 127, dl = d & 63;
            const float* mp = MP + m * NPROJ + 5 * 512 + h * 128;
            const float x1 = mp[dl], x2 = mp[64 + dl]; float sn, cs; sincos_rr((float)m * rope_freq(dl), sn, cs);
            kzL[idx] = ((d < 64) ? (x1 * cs - x2 * sn) : (x1 * sn + x2 * cs)) * exp2f((float)(15 - m) * lg); }
        if (tid3 < 64) vL[tid3] = MP[(tid3 >> 2) * NPROJ + 6 * 512 + h * 128 + e0 + (tid3 & 3)];
        if (tid3 == 0) { unsigned* c2 = ctl + CW_C2 + 64 * (blockIdx.x >> 5); unsigned sp = 0u;
            while (xb_ld(c2) < 63u) { __builtin_amdgcn_s_sleep(1); if (++sp > (1u << 22)) break; } }
        __syncthreads();
    }
    DSTAMP(0);
    for (int gid = blockIdx.x * 512 + tid3; gid < 8 * 16384; gid += gridDim.x * 512) {
        const int bh = gid >> 14, idx = gid & 16383, e = idx >> 7, d = idx & 127, h = bh & 3;
        const float lg = log2_gamma(h), cdec = exp2f(128.f * lg);
        const int dl = d & 63; const float fq = rope_freq(dl);
        float s1 = 0.f;
        if constexpr (FUSED) {
#pragma unroll
            for (int m = 0; m < NMETA; ++m) s1 = fmaf(vL[m * 4 + (e & 3)], kzL[m * 128 + d], s1);
        } else {
#pragma unroll 4
        for (int m = 0; m < NMETA; ++m) {
            const float* mp = MP + m * NPROJ;
            const float x1 = mp[5 * 512 + h * 128 + dl], x2 = mp[5 * 512 + h * 128 + 64 + dl];
            float s, c; sincos_rr((float)m * fq, s, c);
            const float kr = (d < 64) ? (x1 * c - x2 * s) : (x1 * s + x2 * c);
            s1 = fmaf(mp[6 * 512 + h * 128 + e] * exp2f((float)(15 - m) * lg), kr, s1);
        }
        }
        DSTAMP(1);
        float T = cdec * s1;
        const bf16_t* up = UPD + (size_t)bh * 64 * 16384 + idx;
        bf16_t* tt = TT + (size_t)bh * 65 * 16384 + idx;
        if constexpr (FUSED) __hip_atomic_store(tt + 16384, (bf16_t)(pk2(T, 0.f) & 0xffffu), __ATOMIC_RELAXED, __HIP_MEMORY_SCOPE_AGENT); else tt[16384] = (bf16_t)(pk2(T, 0.f) & 0xffffu);
        bf16_t u[63];
#pragma unroll
        for (int i = 0; i < 63; ++i) u[i] = up[(size_t)(i + 1) * 16384];
#pragma unroll
        for (int i = 0; i < 63; ++i) { T = cdec * (T + __uint_as_float((unsigned)u[i] << 16)); const bf16_t tv = (bf16_t)(pk2(T, 0.f) & 0xffffu);
            if constexpr (FUSED) __hip_atomic_store(tt + (size_t)(i + 2) * 16384, tv, __ATOMIC_RELAXED, __HIP_MEMORY_SCOPE_AGENT); else tt[(size_t)(i + 2) * 16384] = tv; }
    }
    DSTAMP(2);
    if constexpr (FUSED) {
        asm volatile("s_waitcnt vmcnt(0)" ::: "memory");
        __syncthreads();
        DSTAMP(3);
        if (tid3 == 0) xb_add(ctl + CW_C3 + 64 * (blockIdx.x >> 5), 1u);
    }
}

template <bool FUSED> DI void phase4(const Params& p, unsigned char* lds, unsigned* ctl, int pm5) {
    const int tid = opaque_tid(), lane = tid & 63, wave = tid >> 6, h5 = lane >> 5;
    const bf16_t* QS = (const bf16_t*)(p.ws + WS_QS); const bf16_t* KZ = (const bf16_t*)(p.ws + WS_KZ); const bf16_t* V = (const bf16_t*)(p.ws + WS_V);
    const bf16_t* SRG = (const bf16_t*)(p.ws + WS_SRG); const bf16_t* TT = (const bf16_t*)(p.ws + WS_TT); bf16_t* MIX = (bf16_t*)(p.ws + WS_MIX);
    unsigned char* Qimg = lds; unsigned char* Kimg = lds + 32768; unsigned char* Vimg = lds + 65536; unsigned char* Timg = lds + 98304;
    float* OL = (float*)lds;
    const int ib = (wave < 4) ? wave : 7 - wave, eh = wave >> 2;
    u32x4 pq[4], pk[4], pv[4], pt[4];
    if (blockIdx.x < 8 * 64) { const int it = blockIdx.x, bh = it >> 6, n = 1 + (it & 63); const size_t row0 = (size_t)(bh >> 2) * SEQ + (size_t)(n - 1) * 128;
        tile_ld(pq, QS + row0 * 512 + (bh & 3) * 128, 512, tid); tile_ld(pk, KZ + row0 * 512 + (bh & 3) * 128, 512, tid); tile_ld(pv, V + row0 * 512 + (bh & 3) * 128, 512, tid);
        if constexpr (FUSED) {
            if (tid == 0) { unsigned* c3 = ctl + CW_C3 + 64 * bh; unsigned sp = 0u; while (xb_ld(c3) < 32u) { __builtin_amdgcn_s_sleep(1); if (++sp > (1u << 22)) break; }
                unsigned* c5 = ctl + CW_P5 + 64 * pm5; sp = 0u; while (xb_ld(c5) < 256u) { __builtin_amdgcn_s_sleep(1); if (++sp > (1u << 22)) break; } }
            __syncthreads();
        }
        tile_ld(pt, TT + ((size_t)bh * 65 + n) * 16384, 128, tid); }
    for (int it = blockIdx.x; it < 8 * 64; it += gridDim.x) {
        const int bh = it >> 6, n = 1 + (it & 63), b = bh >> 2, h = bh & 3;
        const size_t row0 = (size_t)b * SEQ + (size_t)(n - 1) * 128;
        const int it2 = it + gridDim.x;
        tile_st(Qimg, pq, tid); tile_st(Kimg, pk, tid); tile_st(Vimg, pv, tid); tile_st(Timg, pt, tid);
        if constexpr (FUSED) { if (it2 < 8 * 64 && tid == 0) { unsigned* c3 = ctl + CW_C3 + 64 * (it2 >> 6); unsigned sp = 0u; while (xb_ld(c3) < 32u) { __builtin_amdgcn_s_sleep(1); if (++sp > (1u << 22)) break; } } }
        u32x4 sgv[4];
        { const int rown = tid >> 2, partn = tid & 3;
            const u32x4* sp = (const u32x4*)(SRG + (row0 + rown) * 512 + h * 128 + 32 * partn);
#pragma unroll
            for (int k = 0; k < 4; ++k) sgv[k] = sp[k]; }
        __syncthreads();
        if (it2 < 8 * 64) { const int bh2 = it2 >> 6, n2 = 1 + (it2 & 63); const size_t row2 = (size_t)(bh2 >> 2) * SEQ + (size_t)(n2 - 1) * 128;
            tile_ld(pq, QS + row2 * 512 + (bh2 & 3) * 128, 512, tid); tile_ld(pk, KZ + row2 * 512 + (bh2 & 3) * 128, 512, tid); tile_ld(pv, V + row2 * 512 + (bh2 & 3) * 128, 512, tid);
            tile_ld(pt, TT + ((size_t)bh2 * 65 + n2) * 16384, 128, tid); }
        bf16x8 qf[8];
#pragma unroll
        for (int s = 0; s < 8; ++s) qf[s] = row_frag(Qimg, ib, s, lane);
        f32x16 O0, O1;
#pragma unroll
        for (int i = 0; i < 16; ++i) { O0[i] = 0.f; O1[i] = 0.f; }
#pragma unroll
        for (int jb = 0; jb < 4; ++jb) {
            if (jb <= ib) {
                f32x16 c;
#pragma unroll
                for (int i = 0; i < 16; ++i) c[i] = 0.f;
#pragma unroll
                for (int s = 0; s < 8; ++s) c = MFMA32(row_frag(Kimg, jb, s, lane), qf[s], c);
                if (jb == ib) {
#pragma unroll
                    for (int r = 0; r < 16; ++r) if (crow(r, h5) > (lane & 31)) c[r] = 0.f;
                }
#pragma unroll
                for (int s2 = 0; s2 < 2; ++s2) {
                    u32x4 pw; pw.x = pk2(c[8 * s2 + 0], c[8 * s2 + 1]); pw.y = pk2(c[8 * s2 + 2], c[8 * s2 + 3]); pw.z = pk2(c[8 * s2 + 4], c[8 * s2 + 5]); pw.w = pk2(c[8 * s2 + 6], c[8 * s2 + 7]);
                    const bf16x8 pa = __builtin_bit_cast(bf16x8, pw);
                    const bf16x8 v0 = tr_frag<true>(Vimg, 2 * eh, 32 * jb + 16 * s2, lane), v1 = tr_frag<true>(Vimg, 2 * eh + 1, 32 * jb + 16 * s2, lane);
                    O0 = MFMA32(pa, v0, O0); O1 = MFMA32(pa, v1, O1);
                }
            }
        }
#pragma unroll
        for (int s = 0; s < 8; ++s) { O0 = MFMA32(qf[s], row_frag(Timg, 2 * eh, s, lane), O0); O1 = MFMA32(qf[s], row_frag(Timg, 2 * eh + 1, s, lane), O1); }
        __syncthreads();
        {
            float* o = OL + (32 * ib) * 132 + 64 * eh + (lane & 31);
#pragma unroll
            for (int r = 0; r < 16; ++r) { const int i = crow(r, h5); o[i * 132] = O0[r]; o[i * 132 + 32] = O1[r]; }
        }
        __syncthreads();
        {
            const int row = tid >> 2, part = tid & 3;
            const float* o = OL + row * 132 + 32 * part;
            f32x4 v[8]; float s = 0.f;
#pragma unroll
            for (int k = 0; k < 8; ++k) { v[k] = *(const f32x4*)(o + 4 * k); s += (v[k][0] + v[k][1]) + (v[k][2] + v[k][3]); }
            s += __shfl_xor(s, 1); s += __shfl_xor(s, 2);
            const float mu = s * (1.f / 128.f); float q = 0.f;
#pragma unroll
            for (int k = 0; k < 8; ++k) { v[k] = v[k] - mu; q += (v[k][0] * v[k][0] + v[k][1] * v[k][1]) + (v[k][2] * v[k][2] + v[k][3] * v[k][3]); }
            q += __shfl_xor(q, 1); q += __shfl_xor(q, 2);
            const float rs = 1.f / sqrtf(q * (1.f / 128.f) + EPS);
            const size_t grow = row0 + row;
            u32x4* dp = (u32x4*)(MIX + grow * 1024 + 512 + h * 128 + 32 * part);
            const f32x4* gp = (const f32x4*)(p.rg + h * 128 + 32 * part);
#pragma unroll
            for (int k2 = 0; k2 < 4; ++k2) {
                const u32x4 sg = sgv[k2]; const f32x4 g0 = gp[2 * k2], g1 = gp[2 * k2 + 1];
                const f32x4 a = v[2 * k2], c2 = v[2 * k2 + 1];
                u32x4 w;
                w.x = pk2(a[0] * rs * g0[0] * bf_lo(sg.x), a[1] * rs * g0[1] * bf_hi(sg.x));
                w.y = pk2(a[2] * rs * g0[2] * bf_lo(sg.y), a[3] * rs * g0[3] * bf_hi(sg.y));
                w.z = pk2(c2[0] * rs * g1[0] * bf_lo(sg.z), c2[1] * rs * g1[1] * bf_hi(sg.z));
                w.w = pk2(c2[2] * rs * g1[2] * bf_lo(sg.w), c2[3] * rs * g1[3] * bf_hi(sg.w));
                if constexpr (FUSED) store16_sc1(dp + k2, w); else dp[k2] = w;
            }
        }
        if constexpr (FUSED) asm volatile("s_waitcnt vmcnt(0)" ::: "memory");
        __syncthreads();
        if constexpr (FUSED) { if (tid == 0) xb_add(ctl + CW_P5 + 64 * (b * 32 + ((n - 1) >> 1)), 1u); }
    }
}

DI void phase_convfix(const Params& p, unsigned* ctl) {
    const int tid = opaque_tid();
    const float* halo = (const float*)(p.ws + WS_HALO); const float* MP = (const float*)(p.ws + WS_MP); bf16_t* MIX = (bf16_t*)(p.ws + WS_MIX);
    for (int pm = blockIdx.x; pm < 64; pm += gridDim.x) {
        const int ch = tid;
        float um1, um2;
        if ((pm & 31) == 0) { um2 = MP[14 * NPROJ + ch] * MP[14 * NPROJ + 1024 + ch]; um1 = MP[15 * NPROJ + ch] * MP[15 * NPROJ + 1024 + ch]; }
        else { um2 = halo[((size_t)((pm - 1) * 3 + 2) * 2 + 0) * 512 + ch]; um1 = halo[((size_t)((pm - 1) * 3 + 2) * 2 + 1) * 512 + ch]; }
        const float w0 = p.conv_w[ch], w1 = p.conv_w[512 + ch];
        const float c0 = halo[((size_t)(pm * 3 + 0) * 2 + 0) * 512 + ch] + w0 * um2 + w1 * um1;
        const float c1 = halo[((size_t)(pm * 3 + 0) * 2 + 1) * 512 + ch] + w0 * um1;
        const float g0 = halo[((size_t)(pm * 3 + 1) * 2 + 0) * 512 + ch], g1 = halo[((size_t)(pm * 3 + 1) * 2 + 1) * 512 + ch];
        __hip_atomic_store(MIX + (size_t)(pm * 256) * 1024 + ch, (bf16_t)(pk2(g0 * c0, 0.f) & 0xffffu), __ATOMIC_RELAXED, __HIP_MEMORY_SCOPE_AGENT);
        __hip_atomic_store(MIX + (size_t)(pm * 256 + 1) * 1024 + ch, (bf16_t)(pk2(g1 * c1, 0.f) & 0xffffu), __ATOMIC_RELAXED, __HIP_MEMORY_SCOPE_AGENT);
        asm volatile("s_waitcnt vmcnt(0)" ::: "memory");
        __syncthreads();
        if (tid == 0) xb_add(ctl + CW_P5 + 64 * pm, 256u);
    }
}

DI void phase6(const Params& p) {
    const int tid = opaque_tid(), lane = tid & 63, wave = tid >> 6;
    const float* part = (const float*)(p.ws + WS_PART);
    const int gw = blockIdx.x * 8 + wave, NGW = gridDim.x * 8;
    f32x4 g[4];
#pragma unroll
    for (int j = 0; j < 4; ++j) g[j] = ((const f32x4*)p.gf)[lane + 64 * j];
    for (int row = gw; row < M_TOK; row += NGW) {
        float s = (lane < 16) ? part[(size_t)lane * M_TOK + row] : 0.f;
        s = wave_sum(s);
        const float rs = 1.f / sqrtf(s * (1.f / 1024.f) + EPS);
        f32x4* o = (f32x4*)(p.out + (size_t)row * DM) + lane;
#pragma unroll
        for (int j = 0; j < 4; ++j) { f32x4 v = o[64 * j]; v = v * rs * g[j]; o[64 * j] = v; }
    }
}

#ifndef DUP
#define DUP -1
#endif
#define REP(k) for (int rep_ = 0; rep_ < ((DUP == (k)) ? 2 : 1); ++rep_)
__global__ void __launch_bounds__(512, 2) hymba_fwd(Params p) {
    extern __shared__ __attribute__((aligned(16))) unsigned char lds[];
#ifdef USE_CG_FALLBACK
    cg::grid_group grid = cg::this_grid();
#endif
    unsigned char* ws = p.ws;
    unsigned* ctl = (unsigned*)ws;
    const bool fast = (gridDim.x == 256);
    volatile LAS unsigned* st = (volatile LAS unsigned*)((LAS unsigned char*)lds + 131072);
    if (threadIdx.x < 4) st[threadIdx.x] = 0u;
    __syncthreads();
    XcdBarrier bar = xcd_barrier_post(ctl, st);
#ifdef USE_CG_FALLBACK
#define GSYNC() grid.sync()
#else
#define GSYNC() xcd_barrier(bar)
#endif
#define SEAM() do { if (fast) xcd_barrier(bar); else GSYNC(); } while (0)
#ifdef PROBE_T
    unsigned long long ts_[12]; int nts_ = 0;
#define STAMP() do { ts_[nts_++] = __builtin_amdgcn_s_memrealtime(); } while (0)
#else
#define STAMP() do {} while (0)
#endif
    STAMP();
    for (int pass_ = 0; pass_ < ((DUP == 9) ? 2 : 1); ++pass_) {
    REP(0) { phase0(p, lds); __syncthreads(); }
    STAMP();
    SEAM();
    STAMP();
    if (DUP == 7) { for (int i_ = 0; i_ < 6; ++i_) SEAM(); }
    REP(1) {
        pg8::Gemm g{(const bf16_t*)(ws + WS_XB), (const bf16_t*)(ws + WS_WIN), M_TOK, NPROJ, DM};
        pg8::StaticOrder S; S.init(M_TOK, NPROJ, (int)gridDim.x, (int)blockIdx.x);
        EpiProj E{(const float*)(ws + WS_RSTD), (bf16_t*)(ws + WS_MIX), (bf16_t*)(ws + WS_QS), (bf16_t*)(ws + WS_KZ), (bf16_t*)(ws + WS_V), (bf16_t*)(ws + WS_SRG), p.conv_w, (float*)(ws + WS_HALO), (LAS unsigned char*)lds + 131072 + 2048};
        pg8::gemm_phase<EpiProj, pg8::StaticOrder, true, true>((LAS unsigned char*)lds, g, S, E);
    }
    STAMP();
    SEAM();
    STAMP();
    if (fast) {
        phase2<true>(p, lds, ctl);
        STAMP();
        phase_convfix(p, ctl);
        STAMP();
        phase3<true>(p, lds, ctl);
        STAMP();
        int pm5; { pg8::StaticOrder S5; S5.init(M_TOK, DM, (int)gridDim.x, (int)blockIdx.x); pg8::Unit u5; (void)S5.next(0, u5); pm5 = u5.pm; }
        phase4<true>(p, lds, ctl, pm5);
    } else {
        phase2<false>(p, lds, ctl);
        GSYNC();
        phase3<false>(p, lds, ctl);
        GSYNC();
        phase4<false>(p, lds, ctl, 0);
        phase_convfix(p, ctl);
    }
    STAMP();
    if (!fast) SEAM();
    STAMP();
    if (fast) REP(5) {
        pg8::Gemm g{(const bf16_t*)(ws + WS_MIX), (const bf16_t*)(ws + WS_WOUT), M_TOK, DM, DM};
        pg8::PanelOrder S; S.init(M_TOK, DM, (int)gridDim.x, (int)blockIdx.x); S.cnt = ctl + CW_P5;
        EpiOutNorm E{p.x, p.out, p.gf, (float*)(ws + WS_PART), ctl};
        pg8::gemm_phase<EpiOutNorm, pg8::PanelOrder, false, true, false>((LAS unsigned char*)lds, g, S, E);
    } else {
        pg8::Gemm g{(const bf16_t*)(ws + WS_MIX), (const bf16_t*)(ws + WS_WOUT), M_TOK, DM, DM};
        pg8::StaticOrder S; S.init(M_TOK, DM, (int)gridDim.x, (int)blockIdx.x);
        EpiOut E{p.x, p.out, (float*)(ws + WS_PART)};
        pg8::gemm_phase<EpiOut, pg8::StaticOrder, true, true>((LAS unsigned char*)lds, g, S, E);
        GSYNC();
        phase6(p);
    }
    if (DUP == 9) SEAM();
    }
#ifdef PROBE_T
    STAMP(); SEAM();
    if (blockIdx.x == PROBE_B && threadIdx.x == 0) { const unsigned long long* ds_ = (const unsigned long long*)(p.ws + 49152);
        p.out[0] = (PROBE_T >= 100) ? (float)(ds_[PROBE_T - 99] - ds_[PROBE_T - 100]) * 0.01f : (PROBE_T == 99) ? (float)(ds_[0] - ts_[6]) * 0.01f : (PROBE_T == 98) ? (float)(ts_[10] - ts_[0]) * 0.001f : (float)(ts_[PROBE_T + 1] - ts_[PROBE_T]) * 0.01f; }
#endif
}

extern "C" void kernel_launch(void* const* d_in, const int* in_sizes, int n_in, void* d_out, int out_size, void* d_ws, size_t ws_size, hipStream_t stream) {
    static int grid = 0;
    if (grid == 0) {
        if (n_in != 8 || in_sizes[0] != M_TOK * DM || out_size != M_TOK * DM || ws_size < WS_END) { fprintf(stderr, "kernel_launch: unexpected shapes (n_in %d, in0 %d, out %d, ws %zu)\n", n_in, n_in > 0 ? in_sizes[0] : -1, out_size, ws_size); grid = -1; return; }
        int dev = 0, cus = 0, per_cu = 0;
        hipGetDevice(&dev);
        hipDeviceGetAttribute(&cus, hipDeviceAttributeMultiprocessorCount, dev);
        if (hipFuncSetAttribute((const void*)hymba_fwd, hipFuncAttributeMaxDynamicSharedMemorySize, LDS_BYTES) != hipSuccess) { fprintf(stderr, "kernel_launch: hipFuncSetAttribute failed\n"); grid = -1; return; }
        if (hipOccupancyMaxActiveBlocksPerMultiprocessor(&per_cu, (const void*)hymba_fwd, 512, LDS_BYTES) != hipSuccess || per_cu < 1) { fprintf(stderr, "kernel_launch: occupancy query gave %d\n", per_cu); (void)hipGetLastError(); per_cu = 1; }
        grid = cus * per_cu;
        if (grid > 256) grid = 256;
    }
    if (grid < 0) return;
    Params p{};
    p.x = (const float*)d_in[0]; p.meta = (const float*)d_in[1]; p.g1 = (const float*)d_in[2]; p.w_in = (const float*)d_in[3];
    p.conv_w = (const float*)d_in[4]; p.rg = (const float*)d_in[5]; p.w_out = (const float*)d_in[6]; p.gf = (const float*)d_in[7];
    p.out = (float*)d_out; p.ws = (unsigned char*)d_ws;
    if (hipMemsetAsync(d_ws, 0, CTL_ZERO_BYTES, stream) != hipSuccess) { fprintf(stderr, "kernel_launch: hipMemsetAsync failed\n"); return; }
    void* args[] = {&p};
#ifdef PLAIN_LAUNCH
    (void)args; hipLaunchKernelGGL(hymba_fwd, dim3(grid), dim3(512), LDS_BYTES, stream, p); hipError_t e = hipPeekAtLastError();
#else
    hipError_t e = hipLaunchCooperativeKernel((const void*)hymba_fwd, dim3(grid), dim3(512), args, LDS_BYTES, stream);
#endif
    if (e != hipSuccess) fprintf(stderr, "cooperative launch failed: %s (grid %d)\n", hipGetErrorString(e), grid);
}
```

```cpp
#include <hip/hip_runtime.h>
#include <hip/hip_cooperative_groups.h>
#include <cstdio>
#include <cstdint>
namespace cg = cooperative_groups;

#define DI __device__ __forceinline__
#define LAS __attribute__((address_space(3)))
typedef unsigned short bf16_t;
typedef short bf16x8 __attribute__((ext_vector_type(8)));
typedef short s16x4 __attribute__((ext_vector_type(4)));
typedef short v4i16_t __attribute__((ext_vector_type(4)));
typedef float f32x2 __attribute__((ext_vector_type(2)));
typedef float f32x4 __attribute__((ext_vector_type(4)));
typedef float f32x16 __attribute__((ext_vector_type(16)));
typedef unsigned u32x2 __attribute__((ext_vector_type(2)));
typedef unsigned u32x4 __attribute__((ext_vector_type(4)));
typedef __bf16 bf16x2_t __attribute__((ext_vector_type(2)));

constexpr int M_TOK = 16384, DM = 1024, NPROJ = 4096, SEQ = 8192, NMETA = 16, NCHUNK = 64;
constexpr float EPS = 1e-6f;

constexpr size_t MiB = 1u << 20;
constexpr size_t WS_RSTD = 64 * 1024, WS_MP = 128 * 1024, WS_PART = 1 * MiB, WS_WIN = 2 * MiB, WS_WOUT = 10 * MiB, WS_XB = 16 * MiB;
constexpr size_t WS_HALO = 12 * MiB;
constexpr size_t WS_U = 48 * MiB, WS_G = 64 * MiB, WS_QS = 80 * MiB, WS_KZ = 96 * MiB, WS_V = 112 * MiB, WS_SRG = 128 * MiB;
constexpr size_t WS_UPD = 144 * MiB, WS_TT = 176 * MiB, WS_MIX = 194 * MiB, WS_END = 226 * MiB;
constexpr int LDS_BYTES = 147456;

DI unsigned pk2(float lo, float hi) { f32x2 v = {lo, hi}; bf16x2_t b = __builtin_convertvector(v, bf16x2_t); return __builtin_bit_cast(unsigned, b); }
DI float bf_lo(unsigned u) { return __uint_as_float(u << 16); }
DI float bf_hi(unsigned u) { return __uint_as_float(u & 0xffff0000u); }
DI float silu_f(float x) { return x * __builtin_amdgcn_rcpf(1.f + __expf(-x)); }
DI float shfl_idx(float v, int src_lane) { return __builtin_bit_cast(float, __builtin_amdgcn_ds_bpermute(src_lane << 2, __builtin_bit_cast(int, v))); }
DI float wave_sum(float v, int lane) {
#pragma unroll
    for (int o = 1; o < 64; o <<= 1) v += shfl_idx(v, lane ^ o);
    return v;
}
DI void sincos_rr(float ang, float& s, float& c) {
    const float k = rintf(ang * 0.15915494309189535f);
    float r = fmaf(-k, 6.2831854820251465f, ang);
    r = fmaf(-k, -1.7484555e-7f, r);
    const float rev = r * 0.15915494309189535f;
    s = __builtin_amdgcn_sinf(rev); c = __builtin_amdgcn_cosf(rev);
}
DI int lane_id() { return (int)__builtin_amdgcn_mbcnt_hi(~0u, __builtin_amdgcn_mbcnt_lo(~0u, 0u)); }
DI int opaque_tid(int wv) { int l; asm volatile("v_mbcnt_lo_u32_b32 %0, -1, 0\n\tv_mbcnt_hi_u32_b32 %0, -1, %0" : "=v"(l)); return wv * 64 + l; }
DI float rope_freq(int d) { return exp2f(-(float)d * (13.287712379549449f / 64.f)); }
DI float log2_gamma(int h) { return log2f(1.f - exp2f(-5.f - (float)h)); }

namespace pg8 {
constexpr int BM = 256, BK = 64, HALF = 128, HTB = HALF * BK * 2, STAGE_BYTES = 8 * HTB, NXCD = 8, WGM = 8;
DI int lds_byte(int r, int c) { const int st = (r >> 4) * 2 + (c >> 5), rr = r & 15, cc = c & 31, ob = rr * 64 + cc * 2; return st * 1024 + (ob ^ (((ob >> 9) & 1) << 5)); }
DI void stage_rc(int b, int& R, int& C) { const int st = b / 1024, sb = b % 1024, swz = sb ^ (((sb >> 9) & 1) << 5); R = (st >> 1) * 16 + swz / 64; C = (st & 1) * 32 + (swz % 64) / 2; }
DI int perm32(int rho) { const int n = rho >> 4, i = rho & 15; return 8 * (i >> 2) + 4 * n + (i & 3); }
struct Unit { int pm, pn; };
struct Gemm { const bf16_t* A; const bf16_t* Bt; int M, N, K; };
struct StaticOrder {
    int nM, nN, nwg, G, c;
    DI void init(int M, int N, int G_, int c_) { nM = M / BM; nN = N / BM; nwg = nM * nN; G = G_; c = c_; }
    DI bool next(int i, Unit& u) const {
        const long L = (long)i * G + c; if (L >= nwg) return false;
        int wgid = (int)L; { const int q = nwg / NXCD, r = nwg % NXCD, xcd = wgid % NXCD, off = wgid / NXCD; wgid = (xcd < r ? xcd * (q + 1) : r * (q + 1) + (xcd - r) * q) + off; }
        const int nig = WGM * nN, gid = wgid / nig, fm = gid * WGM, gsz = (nM - fm) < WGM ? (nM - fm) : WGM;
        u.pm = fm + ((wgid % nig) % gsz); u.pn = (wgid % nig) / gsz; return true;
    }
    DI void a_ready(const Unit&) const {}
    DI void done(const Unit&) const {}
    DI void mid(const Unit&, int) const {}
};
struct PanelOrder : StaticOrder {
    unsigned* cnt;
    DI void mid(const Unit& u, int t) const {
        if (t == 6) { if (lane_id() == 0) { unsigned* c5 = cnt + 64 * u.pm; unsigned sp = 0u;
            while ((__hip_atomic_load(c5, __ATOMIC_RELAXED, __HIP_MEMORY_SCOPE_AGENT) & 255u) < 8u) { __builtin_amdgcn_s_sleep(1); if (++sp > (1u << 22)) break; } } }
    }
};

template <class Epi, class Sched, bool ALIGN_EPI = false, bool SP2 = false, bool TOUCH = false>
DI void gemm_phase(int wv, LAS unsigned char* lds, const Gemm g, const Sched& S, const Epi& E, const char* tbase = nullptr, size_t tpitch = 0, unsigned dump_off = 0) {
    const int tid = opaque_tid(wv), wid = __builtin_amdgcn_readfirstlane(tid >> 6), lane = tid & 63, wr = wid >> 2, wc = wid & 3, fr = lane & 15, fq = lane >> 4;
    const int K = g.K, nt = K / BK;
    unsigned voffA[2], voffB[2];
#pragma unroll
    for (int i = 0; i < 2; ++i) { int R, C; stage_rc(tid * 16 + i * 8192, R, C); const int Rb = Epi::PERM ? ((R & ~31) + perm32(R & 31)) : R;
        voffA[i] = (unsigned)(R * K + C) * 2u; voffB[i] = (unsigned)(Rb * K + C) * 2u; }
    const size_t kstep = (size_t)(BK * 2);
    const size_t hstep = (size_t)HALF * K * 2;
    const size_t tstep = 2 * hstep;
    const unsigned ldsw = (unsigned)wid * 1024u;
    const int aoff = lds_byte(wr * 64 + fr, fq * 8), boff = lds_byte(wc * 32 + fr, fq * 8);
#define PG8_SA(b, h) (((b) * 2 + (h)) * HTB)
#define PG8_SB(b, h) ((4 + (b) * 2 + (h)) * HTB)
#define PG8_STAGE(bufoff, gbase, voff) do { _Pragma("unroll") for (int _i = 0; _i < 2; ++_i) \
        __builtin_amdgcn_global_load_lds((const unsigned*)((const char*)(gbase) + (voff)[_i]), (LAS unsigned*)(lds + (bufoff) + ldsw + _i * 8192), 16, 0, 0); } while (0)
#define PG8_LDA(dst, b, h) do { _Pragma("unroll") for (int m = 0; m < 4; ++m) _Pragma("unroll") for (int k = 0; k < 2; ++k) dst[m][k] = *(const LAS bf16x8*)(lds + PG8_SA(b, h) + aoff + m * 2048 + k * 1024); } while (0)
#define PG8_LDB(dst, b, h) do { _Pragma("unroll") for (int n = 0; n < 2; ++n) _Pragma("unroll") for (int k = 0; k < 2; ++k) dst[n][k] = *(const LAS bf16x8*)(lds + PG8_SB(b, h) + boff + n * 2048 + k * 1024); } while (0)
#define PG8_MMA(ai, bj, At, Bt) do { __builtin_amdgcn_s_setprio(1); _Pragma("unroll") for (int m = 0; m < 4; ++m) _Pragma("unroll") for (int n = 0; n < 2; ++n) _Pragma("unroll") for (int k = 0; k < 2; ++k) \
        acc[ai][bj][m][n] = __builtin_amdgcn_mfma_f32_16x16x32_bf16(Bt[n][k], At[m][k], acc[ai][bj][m][n], 0, 0, 0); __builtin_amdgcn_s_setprio(0); } while (0)
#define PG8_WAIT_V(n) asm volatile("s_waitcnt vmcnt(" #n ")" ::: "memory")
#define PG8_WAIT_SP() do { if constexpr (TOUCH) PG8_WAIT_V(10); else PG8_WAIT_V(8); } while (0)
#define PG8_TOUCH(j) do { if constexpr (TOUCH) __builtin_amdgcn_global_load_lds((const unsigned*)(tptr + (size_t)(j) * tpitch), (LAS unsigned*)(lds + dump_off + ldsw), 16, 0, 0); } while (0)
#define PG8_WAIT_L(n) asm volatile("s_waitcnt lgkmcnt(" #n ")" ::: "memory")
#define PG8_BAR __builtin_amdgcn_s_barrier()
#define PG8_SCHED __builtin_amdgcn_sched_barrier(0)
    Unit cur, nxt; int ui = 0;
    if (!S.next(0, cur)) return;
    const char* tptr = nullptr;
    if constexpr (TOUCH) tptr = tbase + ((size_t)cur.pm * 256 + (size_t)wid * 32) * tpitch + (size_t)cur.pn * 1024 + (size_t)lane * 16;
    f32x4 acc[2][2][4][2];
#pragma unroll
    for (int a = 0; a < 2; ++a)
#pragma unroll
        for (int b = 0; b < 2; ++b)
#pragma unroll
            for (int m = 0; m < 4; ++m)
#pragma unroll
                for (int n = 0; n < 2; ++n) acc[a][b][m][n] = (f32x4){0.f, 0.f, 0.f, 0.f};
    bf16x8 At[4][2], B0[2][2], B1[2][2];
    const char* cA = (const char*)g.A + (size_t)cur.pm * tstep; const char* cB = (const char*)g.Bt + (size_t)cur.pn * tstep;
    S.a_ready(cur);
    if constexpr (SP2) {
        PG8_STAGE(PG8_SB(0, 0), cB, voffB); PG8_STAGE(PG8_SB(0, 1), cB + hstep, voffB); PG8_STAGE(PG8_SA(0, 0), cA, voffA); PG8_STAGE(PG8_SA(0, 1), cA + hstep, voffA);
        if (wr == 1) PG8_BAR;
        PG8_WAIT_V(2); PG8_BAR;
        PG8_STAGE(PG8_SB(1, 0), cB + kstep, voffB); PG8_STAGE(PG8_SA(1, 0), cA + kstep, voffA); PG8_STAGE(PG8_SB(1, 1), cB + hstep + kstep, voffB);
        PG8_WAIT_V(6); PG8_BAR;
    } else {
        PG8_STAGE(PG8_SB(0, 0), cB, voffB); PG8_STAGE(PG8_SA(0, 0), cA, voffA); PG8_STAGE(PG8_SB(0, 1), cB + hstep, voffB); PG8_STAGE(PG8_SA(0, 1), cA + hstep, voffA);
        if (wr == 1) PG8_BAR;
        PG8_WAIT_V(4); PG8_BAR;
        PG8_STAGE(PG8_SB(1, 0), cB + kstep, voffB); PG8_STAGE(PG8_SA(1, 0), cA + kstep, voffA); PG8_STAGE(PG8_SB(1, 1), cB + hstep + kstep, voffB);
        PG8_WAIT_V(6); PG8_BAR;
    }
    for (;;) {
        const bool has_next = S.next(ui + 1, nxt);
        const char* nA = has_next ? (const char*)g.A + (size_t)nxt.pm * tstep : cA; const char* nB = has_next ? (const char*)g.Bt + (size_t)nxt.pn * tstep : cB;
        for (int t = 0; t < nt; t += 2) {
            S.mid(cur, t);
            const bool last = (t == nt - 2);
            const char* a1 = cA + (size_t)(t + 1) * kstep;
            const char* a2 = last ? nA : cA + (size_t)(t + 2) * kstep; const char* b2 = last ? nB : cB + (size_t)(t + 2) * kstep;
            const char* a3 = a2 + kstep; const char* b3 = b2 + kstep;
            if (last && has_next) S.a_ready(nxt);
            if constexpr (SP2) {
            PG8_LDB(B0, 0, 0); PG8_LDB(B1, 0, 1); PG8_SCHED; PG8_LDA(At, 0, 0); PG8_STAGE(PG8_SA(1, 1), a1 + hstep, voffA); PG8_TOUCH(2 * t);
            PG8_WAIT_SP(); PG8_WAIT_L(0); PG8_BAR; PG8_MMA(0, 0, At, B0); PG8_MMA(0, 1, At, B1); PG8_BAR; PG8_SCHED;
            PG8_LDA(At, 0, 1); PG8_STAGE(PG8_SB(0, 0), b2, voffB); PG8_STAGE(PG8_SB(0, 1), b2 + hstep, voffB); PG8_STAGE(PG8_SA(0, 0), a2, voffA); PG8_TOUCH(2 * t + 1);
            PG8_WAIT_SP(); PG8_WAIT_L(0); PG8_BAR; PG8_MMA(1, 0, At, B0); PG8_MMA(1, 1, At, B1); PG8_BAR; PG8_SCHED;
            PG8_LDB(B0, 1, 0); PG8_LDB(B1, 1, 1); PG8_SCHED; PG8_LDA(At, 1, 0); PG8_STAGE(PG8_SA(0, 1), a2 + hstep, voffA); PG8_TOUCH(2 * t + 2);
            PG8_WAIT_SP(); PG8_WAIT_L(0); PG8_BAR; PG8_MMA(0, 0, At, B0); PG8_MMA(0, 1, At, B1); PG8_BAR; PG8_SCHED;
            PG8_LDA(At, 1, 1); PG8_STAGE(PG8_SB(1, 0), b3, voffB); PG8_STAGE(PG8_SB(1, 1), b3 + hstep, voffB); PG8_STAGE(PG8_SA(1, 0), a3, voffA); PG8_TOUCH(2 * t + 3);
            PG8_WAIT_SP(); PG8_WAIT_L(0); PG8_BAR; PG8_MMA(1, 0, At, B0); PG8_MMA(1, 1, At, B1); PG8_BAR; PG8_SCHED;
            } else {
            PG8_LDB(B0, 0, 0); PG8_SCHED; PG8_LDA(At, 0, 0); PG8_STAGE(PG8_SA(1, 1), a1 + hstep, voffA);
            PG8_WAIT_L(8); PG8_BAR; PG8_WAIT_L(0); PG8_MMA(0, 0, At, B0); PG8_BAR; PG8_SCHED;
            PG8_LDB(B1, 0, 1); PG8_STAGE(PG8_SB(0, 0), b2, voffB);
            PG8_BAR; PG8_WAIT_L(0); PG8_MMA(0, 1, At, B1); PG8_BAR;
            PG8_LDA(At, 0, 1); PG8_STAGE(PG8_SA(0, 0), a2, voffA);
            PG8_BAR; PG8_WAIT_L(0); PG8_MMA(1, 0, At, B0); PG8_BAR; PG8_SCHED;
            PG8_STAGE(PG8_SB(0, 1), b2 + hstep, voffB);
            PG8_WAIT_V(6); PG8_BAR; PG8_MMA(1, 1, At, B1); PG8_BAR;
            PG8_LDB(B0, 1, 0); PG8_SCHED; PG8_LDA(At, 1, 0); PG8_STAGE(PG8_SA(0, 1), a2 + hstep, voffA);
            PG8_WAIT_L(8); PG8_BAR; PG8_WAIT_L(0); PG8_MMA(0, 0, At, B0); PG8_BAR; PG8_SCHED;
            PG8_LDB(B1, 1, 1); PG8_STAGE(PG8_SB(1, 0), b3, voffB);
            PG8_BAR; PG8_WAIT_L(0); PG8_MMA(0, 1, At, B1); PG8_BAR;
            PG8_LDA(At, 1, 1); PG8_STAGE(PG8_SA(1, 0), a3, voffA);
            PG8_BAR; PG8_WAIT_L(0); PG8_MMA(1, 0, At, B0); PG8_BAR; PG8_SCHED;
            PG8_STAGE(PG8_SB(1, 1), b3 + hstep, voffB);
            PG8_WAIT_V(6); PG8_BAR; PG8_MMA(1, 1, At, B1); PG8_BAR;
            }
        }
        if constexpr (ALIGN_EPI) { if (wr == 0) PG8_BAR; }
        if constexpr (!Epi::AFTER_DRAIN) { E(acc, cur, wr, wc, fr, fq); S.done(cur); }
        if (!has_next) break;
#pragma unroll
        for (int a = 0; a < 2; ++a)
#pragma unroll
            for (int b = 0; b < 2; ++b)
#pragma unroll
                for (int m = 0; m < 4; ++m)
#pragma unroll
                    for (int n = 0; n < 2; ++n) acc[a][b][m][n] = (f32x4){0.f, 0.f, 0.f, 0.f};
        cur = nxt; cA = nA; cB = nB; ++ui;
        if constexpr (ALIGN_EPI) { if (wr == 1) PG8_BAR; }
    }
    PG8_WAIT_V(0);
    if constexpr (!ALIGN_EPI) { if (wr == 0) PG8_BAR; }
    PG8_BAR;
    if constexpr (Epi::AFTER_DRAIN) { E.fused(acc, cur, wr, wc, fr, fq, lds, wid, lane); S.done(cur); }
#undef PG8_SA
#undef PG8_SB
#undef PG8_STAGE
#undef PG8_LDA
#undef PG8_LDB
#undef PG8_MMA
#undef PG8_WAIT_V
#undef PG8_WAIT_SP
#undef PG8_TOUCH
#undef PG8_WAIT_L
#undef PG8_BAR
#undef PG8_SCHED
}
}


#define XB_TMO      128
#define XB_XCNT(j)  (256  + 64 * (j))
#define XB_XSUB(j)  (1280 + 64 * (j))
#define XB_XGEN(j)  (2304 + 64 * (j))
#define XB_TOP      3328
#define XB_TOPGEN   3392
#define XCD_BAR_WORDS 3456
#define XB_SPIN_CAP (1u << 18)
constexpr int CW_PANEL = 4096, CW_C2 = 8192, CW_C3 = 8192 + 512, CW_P5 = 9216;
constexpr size_t CTL_ZERO_BYTES = 57344;
DI unsigned xb_ld(unsigned* p)              { return __hip_atomic_load(p, __ATOMIC_RELAXED, __HIP_MEMORY_SCOPE_AGENT); }
DI unsigned xb_add(unsigned* p, unsigned v) { return __hip_atomic_fetch_add(p, v, __ATOMIC_RELAXED, __HIP_MEMORY_SCOPE_AGENT); }
DI unsigned xb_xcc_id() { return (unsigned)__builtin_amdgcn_s_getreg((3 << 11) | 20) & 0xFu; }
#define XB_SPIN(cond, bar) do { unsigned _sp = 0; while (cond) { __builtin_amdgcn_s_sleep(1); \
    if ((++_sp & 255u) == 0u) { if (xb_ld(&(bar)[XB_TMO])) break; if (_sp > XB_SPIN_CAP) { atomicAdd(&(bar)[XB_TMO], 1u); break; } } } } while (0)
struct XcdBarrier { unsigned* bar; unsigned x; volatile LAS unsigned* st; int wv; };
DI XcdBarrier xcd_barrier_post(unsigned* bar, volatile LAS unsigned* st) {
    XcdBarrier b; b.bar = bar; b.x = xb_xcc_id(); b.st = st;
    if (threadIdx.x == 0) (void)xb_add(&bar[XB_XCNT(b.x)], 1u);
    return b;
}
DI void xcd_barrier_complete(unsigned* bar, unsigned x, unsigned& nloc, unsigned& nx) {
    const unsigned G = gridDim.x * gridDim.y * gridDim.z;
    unsigned sum, cnt, mine, sp = 0u;
    for (;;) {
        sum = 0u; cnt = 0u; mine = 0u;
#pragma unroll
        for (unsigned j = 0; j < 16; ++j) { const unsigned c = xb_ld(&bar[XB_XCNT(j)]); sum += c; cnt += (c > 0u) ? 1u : 0u; mine = (j == x) ? c : mine; }
        if (sum == G) break;
        __builtin_amdgcn_s_sleep(1);
        if ((++sp & 255u) == 0u) { if (xb_ld(&bar[XB_TMO])) break; if (sp > XB_SPIN_CAP) { atomicAdd(&bar[XB_TMO], 1u); break; } }
    }
    nloc = mine > 0u ? mine : 1u; nx = cnt > 0u ? cnt : 1u;
}
DI void xcd_barrier(const XcdBarrier& b) {
    asm volatile("s_waitcnt vmcnt(0)" ::: "memory");
    __syncthreads();
    if (b.wv == 0 && lane_id() == 0) {
        unsigned* bar = b.bar;
        __builtin_amdgcn_s_waitcnt(0);
        unsigned nloc = b.st[0], nx = b.st[1];
        if (nloc == 0u) { xcd_barrier_complete(bar, b.x, nloc, nx); b.st[0] = nloc; b.st[1] = nx; }
        const unsigned old = xb_add(&bar[XB_XSUB(b.x)], 1u);
        const unsigned gen = old / nloc;
        if (old + 1u == (gen + 1u) * nloc) {
            __builtin_amdgcn_fence(__ATOMIC_RELEASE, "agent");
            asm volatile("s_waitcnt vmcnt(0)" ::: "memory");
            const unsigned og = xb_add(&bar[XB_TOP], 1u);
            const unsigned tg = og / nx;
            if (og + 1u == (tg + 1u) * nx) xb_add(&bar[XB_TOPGEN], 1u);
            else XB_SPIN(xb_ld(&bar[XB_TOPGEN]) == tg, bar);
            __builtin_amdgcn_fence(__ATOMIC_ACQUIRE, "agent");
            xb_add(&bar[XB_XGEN(b.x)], 1u);
            asm volatile("s_waitcnt vmcnt(0)" ::: "memory");
        } else {
            XB_SPIN(xb_ld(&bar[XB_XGEN(b.x)]) == gen, bar);
            __builtin_amdgcn_fence(__ATOMIC_ACQUIRE, "agent");
            asm volatile("s_waitcnt vmcnt(0)" ::: "memory");
        }
    }
    __syncthreads();
}


DI u32x4 pack8(f32x4 a, f32x4 b) { u32x4 w; w.x = pk2(a[0], a[1]); w.y = pk2(a[2], a[3]); w.z = pk2(b[0], b[1]); w.w = pk2(b[2], b[3]); return w; }
DI f32x4 silu4(f32x4 v) { f32x4 o; o[0] = silu_f(v[0]); o[1] = silu_f(v[1]); o[2] = silu_f(v[2]); o[3] = silu_f(v[3]); return o; }

DI void store16_sc1(void* ptr, u32x4 v) { asm volatile("global_store_dwordx4 %0, %1, off sc1\n\ts_nop 1" :: "v"(ptr), "v"(v) : "memory"); }

struct EpiProj {
    static constexpr bool PERM = true, AFTER_DRAIN = false;
    const float* rstd; bf16_t *MIX, *QS, *KZ, *V, *SRG; const float* convw; float* halo; LAS unsigned char* xlds;
    DI void operator()(const f32x4 (&acc)[2][2][4][2], const pg8::Unit& u, int wr, int wc, int fr, int fq) const {
        const int pn = u.pn;
        const int row0 = u.pm * 256 + wr * 64 + fr;
        const int cw = wc * 32 + 8 * fq;
        if (pn < 8) {
            const int ch0 = pn * 64 + 16 * wc + 4 * fq;
            const f32x4 w0 = *(const f32x4*)(convw + ch0), w1 = *(const f32x4*)(convw + 512 + ch0), w2 = *(const f32x4*)(convw + 1024 + ch0);
            f32x4 u3[2];
#pragma unroll
            for (int ai = 0; ai < 2; ++ai) { const float rs = 1.f; u3[ai] = (acc[ai][0][3][0] * rs) * (acc[ai][0][3][1] * rs); }
            LAS float* xb = (LAS float*)(xlds);
            if (fr >= 14) {
#pragma unroll
                for (int ai = 0; ai < 2; ++ai) *(LAS f32x4*)(xb + (((ai * 2 + wr) * 4 + wc) * 2 + (fr - 14)) * 16 + 4 * fq) = u3[ai];
                if (wr == 1) *(f32x4*)(halo + ((size_t)(u.pm * 3 + 2) * 2 + (fr - 14)) * 512 + ch0) = u3[1];
            }
            asm volatile("s_waitcnt lgkmcnt(0)" ::: "memory");
            __builtin_amdgcn_s_barrier();
#pragma unroll
            for (int ai = 0; ai < 2; ++ai) {
                f32x4 o1, o2, up = (f32x4){0.f, 0.f, 0.f, 0.f};
                bool havep = true;
                if (ai == 0 && wr == 0) { havep = false; o1 = (f32x4){0.f, 0.f, 0.f, 0.f}; o2 = o1; }
                else { const int pa = (wr == 1) ? ai : 0, pw = (wr == 1) ? 0 : 1;
                    const f32x4 p15 = *(const LAS f32x4*)(xb + (((pa * 2 + pw) * 4 + wc) * 2 + 1) * 16 + 4 * fq), p14 = *(const LAS f32x4*)(xb + (((pa * 2 + pw) * 4 + wc) * 2 + 0) * 16 + 4 * fq);
                    o1 = p15; o2 = (fr == 0) ? p14 : p15; }
#pragma unroll
                for (int m = 0; m < 4; ++m) {
                    const int row = row0 + ai * 128 + m * 16; const float rs = 1.f;
                    const f32x4 uc = (acc[ai][0][m][0] * rs) * (acc[ai][0][m][1] * rs);
                    const int lane_ = fq * 16 + fr;
                    if (m > 0) {
#pragma unroll
                        for (int j = 0; j < 4; ++j) { o1[j] = shfl_idx(up[j], (lane_ & 48) + ((fr + 15) & 15)); o2[j] = shfl_idx(up[j], (lane_ & 48) + ((fr + 14) & 15)); }
                    }
                    f32x4 u1, u2;
#pragma unroll
                    for (int j = 0; j < 4; ++j) { const float s1 = shfl_idx(uc[j], (lane_ & 48) + ((fr + 15) & 15)), s2 = shfl_idx(uc[j], (lane_ & 48) + ((fr + 14) & 15));
                        u1[j] = (fr >= 1) ? s1 : o1[j]; u2[j] = (fr >= 2) ? s2 : o2[j]; }
                    const f32x4 cv3 = w0 * u2 + w1 * u1 + w2 * uc;
                    const f32x4 gate = (acc[ai][1][m][0] * rs) * silu4(acc[ai][1][m][1] * rs);
                    if (!havep && m == 0 && fr < 2) {
                        *(f32x4*)(halo + ((size_t)(u.pm * 3 + 0) * 2 + fr) * 512 + ch0) = cv3;
                        *(f32x4*)(halo + ((size_t)(u.pm * 3 + 1) * 2 + fr) * 512 + ch0) = gate;
                    } else {
                        const f32x4 o = gate * cv3; u32x2 w; w.x = pk2(o[0], o[1]); w.y = pk2(o[2], o[3]);
                        *(u32x2*)(MIX + (size_t)row * 1024 + ch0) = w;
                    }
                    up = uc;
                }
            }
        } else if (pn < 12) {
            const bool isq = pn < 10;
            const int head = 2 * ((pn - 8) & 1) + (wc >> 1);
            const int d0 = cw & 63;
            float fr8[8];
#pragma unroll
            for (int j = 0; j < 8; ++j) fr8[j] = rope_freq(d0 + j);
            const float lg = log2_gamma(head);
            bf16_t* dst = (isq ? QS : KZ) + head * 128 + d0;
#pragma unroll
            for (int ai = 0; ai < 2; ++ai)
#pragma unroll
                for (int m = 0; m < 4; ++m) {
                    const int row = row0 + ai * 128 + m * 16; const float rs = 1.f;
                    const int t = row & (SEQ - 1), tl = t & 127; const float pos = (float)(NMETA + t);
                    const float sc = rs * (isq ? 0.08838834764831845f * exp2f((float)(tl - 127) * lg) : exp2f((float)(127 - tl) * lg));
                    f32x4 r1[2], r2[2];
#pragma unroll
                    for (int j = 0; j < 8; ++j) {
                        float s, c; sincos_rr(pos * fr8[j], s, c);
                        const float x1 = acc[ai][0][m][j >> 2][j & 3], x2 = acc[ai][1][m][j >> 2][j & 3];
                        r1[j >> 2][j & 3] = (x1 * c - x2 * s) * sc; r2[j >> 2][j & 3] = (x1 * s + x2 * c) * sc;
                    }
                    *(u32x4*)(dst + (size_t)row * 512) = pack8(r1[0], r1[1]);
                    *(u32x4*)(dst + (size_t)row * 512 + 64) = pack8(r2[0], r2[1]);
                }
        } else {
            const bool isv = pn < 14;
            bf16_t* dst = (isv ? V : SRG) + ((pn - 12) & 1) * 256 + cw;
#pragma unroll
            for (int ai = 0; ai < 2; ++ai)
#pragma unroll
                for (int m = 0; m < 4; ++m) {
                    const int row = row0 + ai * 128 + m * 16; const float rs = 1.f;
#pragma unroll
                    for (int bj = 0; bj < 2; ++bj) {
                        f32x4 a0 = acc[ai][bj][m][0] * rs, a1 = acc[ai][bj][m][1] * rs;
                        if (!isv) { a0 = silu4(a0); a1 = silu4(a1); }
                        *(u32x4*)(dst + (size_t)row * 512 + bj * 128) = pack8(a0, a1);
                    }
                }
        }
    }
};

struct EpiOut {
    static constexpr bool PERM = true, AFTER_DRAIN = false;
    const float* x; float* out; float* part;
    DI void operator()(const f32x4 (&acc)[2][2][4][2], const pg8::Unit& u, int wr, int wc, int fr, int fq) const {
        const int row0 = u.pm * 256 + wr * 64 + fr, col0 = u.pn * 256 + wc * 32 + 8 * fq;
#pragma unroll
        for (int ai = 0; ai < 2; ++ai)
#pragma unroll
            for (int m = 0; m < 4; ++m) {
                const int row = row0 + ai * 128 + m * 16; float ss = 0.f;
#pragma unroll
                for (int bj = 0; bj < 2; ++bj) {
                    const size_t o = (size_t)row * DM + col0 + bj * 128;
                    const f32x4 y0 = acc[ai][bj][m][0] + *(const f32x4*)(x + o), y1 = acc[ai][bj][m][1] + *(const f32x4*)(x + o + 4);
                    ss += (y0[0] * y0[0] + y0[1] * y0[1]) + (y0[2] * y0[2] + y0[3] * y0[3]) + (y1[0] * y1[0] + y1[1] * y1[1]) + (y1[2] * y1[2] + y1[3] * y1[3]);
                    *(f32x4*)(out + o) = y0; *(f32x4*)(out + o + 4) = y1;
                }
                { const int l_ = fq * 16 + fr; ss += shfl_idx(ss, l_ ^ 16); ss += shfl_idx(ss, l_ ^ 32); }
                if (fq == 0) part[(size_t)(u.pn * 4 + wc) * M_TOK + row] = ss;
            }
    }
};


struct EpiOutNorm {
    static constexpr bool PERM = true, AFTER_DRAIN = true;
    const float* x; float* out; const float* gf; float* xch; unsigned* ctl;
    DI void fused(f32x4 (&acc)[2][2][4][2], const pg8::Unit& u, int wr, int wc, int fr, int fq, LAS unsigned char* lds, int wid, int lane) const {
        LAS float* R = (LAS float*)(lds + 131072 + 1024);
        f32x4 y[2][16];
        float* slot = xch + (size_t)(u.pm * 4) * 256;
#pragma unroll
        for (int ai = 0; ai < 2; ++ai) {
            if (ai) __syncthreads();
#pragma unroll
            for (int m = 0; m < 4; ++m)
#pragma unroll
                for (int bj = 0; bj < 2; ++bj)
#pragma unroll
                    for (int n = 0; n < 2; ++n) { const int r = wr * 64 + m * 16 + fr, ch = 32 * bj + 8 * wc + 2 * fq + n;
                        *(LAS f32x4*)(lds + r * 1024 + ((ch ^ (r & 15)) << 4)) = acc[ai][bj][m][n]; }
            __syncthreads();
            f32x4 xv[16];
#pragma unroll
            for (int k = 0; k < 16; ++k) { const int r = wid + 8 * k; xv[k] = __builtin_nontemporal_load((const f32x4*)(x + (size_t)(u.pm * 256 + ai * 128 + r) * DM + u.pn * 256) + lane); }
#pragma unroll
            for (int k = 0; k < 16; ++k) { const int r = wid + 8 * k;
                const f32x4 v = *(const LAS f32x4*)(lds + r * 1024 + ((lane ^ (r & 15)) << 4)) + xv[k];
                y[ai][k] = v;
                const float ss = wave_sum((v[0] * v[0] + v[1] * v[1]) + (v[2] * v[2] + v[3] * v[3]), lane);
                if (lane == 0) __hip_atomic_store(slot + u.pn * 256 + ai * 128 + r, ss, __ATOMIC_RELAXED, __HIP_MEMORY_SCOPE_AGENT); }
        }
        const int tid = wid * 64 + lane;
        asm volatile("s_waitcnt vmcnt(0)" ::: "memory");
        __syncthreads();
        if (tid == 0) {
            unsigned* cnt = ctl + CW_PANEL + 64 * u.pm;
            xb_add(cnt, 1u);
            unsigned sp = 0u;
            while (xb_ld(cnt) < 4u) { __builtin_amdgcn_s_sleep(1); if (++sp > (1u << 22)) break; }
        }
        __syncthreads();
        if (tid < 256) { float s = 0.f;
#pragma unroll
            for (int q = 0; q < 4; ++q) s += __hip_atomic_load(slot + q * 256 + tid, __ATOMIC_RELAXED, __HIP_MEMORY_SCOPE_AGENT);
            R[tid] = 1.f / sqrtf(s * (1.f / 1024.f) + EPS); }
        __syncthreads();
        const f32x4 gv = *((const f32x4*)(gf + u.pn * 256) + lane);
#pragma unroll
        for (int ai = 0; ai < 2; ++ai)
#pragma unroll
            for (int k = 0; k < 16; ++k) { const int r = ai * 128 + wid + 8 * k; const float rs = R[r];
                __builtin_nontemporal_store(y[ai][k] * rs * gv, (f32x4*)(out + (size_t)(u.pm * 256 + r) * DM + u.pn * 256) + lane); }
    }
};

DI unsigned off_b(unsigned row, unsigned ch) { return 256u * row + 16u * (ch ^ (((row & 3) << 2) | ((row >> 2) & 3))); }
DI bf16x8 row_frag(const unsigned char* img, int rb, int s, int lane) {
    return *(const bf16x8*)(img + 8192 * rb + off_b(lane & 31, 2 * s + (lane >> 5)));
}
DI s16x4 tr_read(const unsigned char* p) { return __builtin_bit_cast(s16x4, __builtin_amdgcn_ds_read_tr16_b64_v4i16((LAS v4i16_t*)(const LAS unsigned char*)p)); }
template <bool PERMK> DI bf16x8 tr_frag(const unsigned char* img, int c, int rbase, int lane) {
    const int h = lane >> 5, blk = (lane >> 4) & 1, q = (lane & 15) >> 2, p = lane & 3;
    const int r0 = rbase + (PERMK ? 4 * h : 8 * h) + q, r1 = r0 + (PERMK ? 8 : 4);
    const unsigned ch = 4 * c + 2 * blk + (p >> 1), bo = 8 * (p & 1);
    const s16x4 lo = tr_read(img + off_b(r0, ch) + bo), hi = tr_read(img + off_b(r1, ch) + bo);
    return __builtin_shufflevector(lo, hi, 0, 1, 2, 3, 4, 5, 6, 7);
}
DI void load_tile(unsigned char* img, const bf16_t* src, int ld, int tid) {
#pragma unroll
    for (int i = 0; i < 4; ++i) { const int idx = tid + 512 * i, row = idx >> 4, ch = idx & 15;
        *(u32x4*)(img + off_b(row, ch)) = *(const u32x4*)(src + (size_t)row * ld + ch * 8); }
}
DI void tile_ld(u32x4 (&r)[4], const bf16_t* src, int ld, int tid) {
#pragma unroll
    for (int i = 0; i < 4; ++i) { const int idx = tid + 512 * i, row = idx >> 4, ch = idx & 15; r[i] = *(const u32x4*)(src + (size_t)row * ld + ch * 8); }
}
DI void tile_st(unsigned char* img, const u32x4 (&r)[4], int tid) {
#pragma unroll
    for (int i = 0; i < 4; ++i) { const int idx = tid + 512 * i, row = idx >> 4, ch = idx & 15; *(u32x4*)(img + off_b(row, ch)) = r[i]; }
}
DI int crow(int reg, int h) { return (reg & 3) + 8 * (reg >> 2) + 4 * h; }
#define MFMA32(a, b, c) __builtin_amdgcn_mfma_f32_32x32x16_bf16((a), (b), (c), 0, 0, 0)

struct Params { const float *x, *meta, *g1, *w_in, *conv_w, *rg, *w_out, *gf; float* out; unsigned char* ws; };


DI int dest_pos(int n) {
    const int type = n >> 9, r = n & 511;
    if (type < 4) {
        const int rr = r & 63, wc = rr >> 4, fq = (rr >> 2) & 3, j = rr & 3;
        const int bj = (type == 1 || type == 3) ? 1 : 0, nn = (type >= 2) ? 1 : 0;
        return (r >> 6) * 256 + 128 * bj + 32 * wc + 8 * fq + 4 * nn + j;
    }
    if (type < 6) { const int h = r >> 7, d = r & 127; return (8 + (type - 4) * 2 + (h >> 1)) * 256 + (d >> 6) * 128 + (h & 1) * 64 + (d & 63); }
    return n;
}

DI void p0_tr_load(float (&w)[32], const float* W, const float* gain, int N, int item, int lane) {
    const int nblk = N / 32, kb = item / nblk, nb = item % nblk, k0 = 64 * kb, n0 = 32 * nb;
#pragma unroll
    for (int i = 0; i < 32; ++i) { const int kk = 2 * i + (lane >> 5); w[i] = __builtin_nontemporal_load(W + (size_t)(k0 + kk) * N + n0 + (lane & 31)); if (gain) w[i] *= gain[k0 + kk]; }
}
DI void p0_tr_finish(const float (&w)[32], int K, int N, bf16_t* WT, bool perm, float* scr, int item, int lane) {
    const int nblk = N / 32, kb = item / nblk, nb = item % nblk, k0 = 64 * kb, n0 = 32 * nb;
#pragma unroll
    for (int i = 0; i < 32; ++i) { const int kk = 2 * i + (lane >> 5); scr[kk * 33 + (lane & 31)] = w[i]; }
    __builtin_amdgcn_s_waitcnt(0xc07f); asm volatile("" ::: "memory");
    const int c = lane & 7;
#pragma unroll
    for (int j = 0; j < 4; ++j) { const int n = (lane >> 3) + 8 * j; const float* s = scr + (8 * c) * 33 + n;
        u32x4 o; o.x = pk2(s[0 * 33], s[1 * 33]); o.y = pk2(s[2 * 33], s[3 * 33]); o.z = pk2(s[4 * 33], s[5 * 33]); o.w = pk2(s[6 * 33], s[7 * 33]);
        *(u32x4*)(WT + (size_t)(perm ? dest_pos(n0 + n) : n0 + n) * K + k0 + 8 * c) = o; }
    __builtin_amdgcn_s_waitcnt(0xc07f); asm volatile("" ::: "memory");
}

DI void phase0(int wv, const Params& p, unsigned char* lds) {
    const int tid = opaque_tid(wv), lane = tid & 63, wave = tid >> 6;
    unsigned char* ws = p.ws;
    float* rstd = (float*)(ws + WS_RSTD); float* MP = (float*)(ws + WS_MP);
    bf16_t* XB = (bf16_t*)(ws + WS_XB); bf16_t* WIN = (bf16_t*)(ws + WS_WIN); bf16_t* WOUT = (bf16_t*)(ws + WS_WOUT);
    {
        float* metaL = (float*)lds; float* red = (float*)(lds + 65536); float* rsL = (float*)(lds + 98304);
        for (int i = tid; i < 4096; i += 512) ((f32x4*)metaL)[i] = ((const f32x4*)p.meta)[i];
        __syncthreads();
#pragma unroll
        for (int rr = 0; rr < 2; ++rr) { const int m = 2 * wave + rr; float s = 0.f;
#pragma unroll
            for (int i = 0; i < 16; ++i) { const float v = metaL[m * 1024 + lane + 64 * i]; s += v * v; }
            s = wave_sum(s, lane); if (lane == 0) rsL[m] = 1.f / sqrtf(s * (1.f / 1024.f) + EPS); }
        for (int cgp = blockIdx.x; cgp < 256; cgp += gridDim.x) {
            const int col = tid & 15, ks = tid >> 4, n = cgp * 16 + col;
            float a[16], wv[32];
#pragma unroll
            for (int m = 0; m < 16; ++m) a[m] = 0.f;
#pragma unroll
            for (int kk = 0; kk < 32; ++kk) { const int k = kk * 32 + ks; wv[kk] = p.w_in[(size_t)k * NPROJ + n] * p.g1[k]; }
#pragma unroll
            for (int kk = 0; kk < 32; ++kk) { const int k = kk * 32 + ks;
#pragma unroll
                for (int m = 0; m < 16; ++m) a[m] = fmaf(metaL[m * 1024 + k], wv[kk], a[m]); }
#pragma unroll
            for (int m = 0; m < 16; ++m) red[(ks * 16 + m) * 16 + col] = a[m];
            __syncthreads();
            if (tid < 256) { const int m = tid >> 4, c = tid & 15; float s = 0.f;
#pragma unroll 8
                for (int k2 = 0; k2 < 32; ++k2) s += red[(k2 * 16 + m) * 16 + c];
                MP[m * NPROJ + cgp * 16 + c] = s * rsL[m]; }
            __syncthreads();
        }
    }
    __syncthreads();
    const int gw = blockIdx.x * 8 + wave, NGW = gridDim.x * 8;
    {
        float* scr = (float*)(lds + wave * 16384);
        constexpr int I_IN = (DM / 64) * (NPROJ / 32), I_OUT = (DM / 64) * (DM / 32);
        for (int it = gw; it < I_IN + I_OUT; it += 2 * NGW) {
            const int it2 = it + NGW; const bool has2 = it2 < I_IN + I_OUT;
            float wa[32], wb[32];
            if (it < I_IN) p0_tr_load(wa, p.w_in, p.g1, NPROJ, it, lane); else p0_tr_load(wa, p.w_out, nullptr, DM, it - I_IN, lane);
            if (has2) { if (it2 < I_IN) p0_tr_load(wb, p.w_in, p.g1, NPROJ, it2, lane); else p0_tr_load(wb, p.w_out, nullptr, DM, it2 - I_IN, lane); }
            if (it < I_IN) p0_tr_finish(wa, DM, NPROJ, WIN, true, scr, it, lane); else p0_tr_finish(wa, DM, DM, WOUT, false, scr, it - I_IN, lane);
            if (has2) { if (it2 < I_IN) p0_tr_finish(wb, DM, NPROJ, WIN, true, scr, it2, lane); else p0_tr_finish(wb, DM, DM, WOUT, false, scr, it2 - I_IN, lane); }
        }
    }
    for (int row = gw; row < M_TOK; row += 4 * NGW) {
        f32x4 v[4][4]; float s[4];
#pragma unroll
        for (int q = 0; q < 4; ++q) { const f32x4* xr = (const f32x4*)(p.x + (size_t)(row + q * NGW) * DM) + lane;
#pragma unroll
            for (int j = 0; j < 4; ++j) v[q][j] = __builtin_nontemporal_load(xr + 64 * j); }
#pragma unroll
        for (int q = 0; q < 4; ++q) { float a = 0.f;
#pragma unroll
            for (int j = 0; j < 4; ++j) a += (v[q][j][0] * v[q][j][0] + v[q][j][1] * v[q][j][1]) + (v[q][j][2] * v[q][j][2] + v[q][j][3] * v[q][j][3]);
            s[q] = wave_sum(a, lane); }
#pragma unroll
        for (int q = 0; q < 4; ++q) { const int r = row + q * NGW;
            const float rs = 1.f / sqrtf(s[q] * (1.f / 1024.f) + EPS);
            if (lane == 0) rstd[r] = rs;
            u32x2* o = (u32x2*)(XB + (size_t)r * DM) + lane;
#pragma unroll
            for (int j = 0; j < 4; ++j) { u32x2 w; w.x = pk2(v[q][j][0] * rs, v[q][j][1] * rs); w.y = pk2(v[q][j][2] * rs, v[q][j][3] * rs); o[64 * j] = w; } }
    }
}

template <bool FUSED> DI void phase2(int wv, const Params& p, unsigned char* lds, unsigned* ctl) {
    const int tid = opaque_tid(wv), lane = tid & 63, wave = tid >> 6, h5 = lane >> 5;
    const bf16_t* KZ = (const bf16_t*)(p.ws + WS_KZ); const bf16_t* V = (const bf16_t*)(p.ws + WS_V); bf16_t* UPD = (bf16_t*)(p.ws + WS_UPD);
    unsigned char* Kimg = lds; unsigned char* Vimg = lds + 32768;
    const int eb = wave & 3, dh = wave >> 2;
    u32x4 pk[4], pv[4];
    if (blockIdx.x < 8 * 63) { const int it = blockIdx.x, bh = it / 63, n = 1 + it % 63; const size_t row0 = (size_t)(bh >> 2) * SEQ + (size_t)(n - 1) * 128;
        tile_ld(pk, KZ + row0 * 512 + (bh & 3) * 128, 512, tid); tile_ld(pv, V + row0 * 512 + (bh & 3) * 128, 512, tid); }
    for (int it = blockIdx.x; it < 8 * 63; it += gridDim.x) {
        const int bh = it / 63, n = 1 + it % 63;
        tile_st(Kimg, pk, tid); tile_st(Vimg, pv, tid);
        __syncthreads();
        { const int it2 = it + gridDim.x; if (it2 < 8 * 63) { const int bh2 = it2 / 63, n2 = 1 + it2 % 63; const size_t row2 = (size_t)(bh2 >> 2) * SEQ + (size_t)(n2 - 1) * 128;
            tile_ld(pk, KZ + row2 * 512 + (bh2 & 3) * 128, 512, tid); tile_ld(pv, V + row2 * 512 + (bh2 & 3) * 128, 512, tid); } }
        f32x16 a0, a1;
#pragma unroll
        for (int i = 0; i < 16; ++i) { a0[i] = 0.f; a1[i] = 0.f; }
#pragma unroll
        for (int ks = 0; ks < 8; ++ks) {
            const bf16x8 av = tr_frag<false>(Vimg, eb, 16 * ks, lane);
            const bf16x8 b0 = tr_frag<false>(Kimg, 2 * dh, 16 * ks, lane), b1 = tr_frag<false>(Kimg, 2 * dh + 1, 16 * ks, lane);
            a0 = MFMA32(av, b0, a0); a1 = MFMA32(av, b1, a1);
        }
        bf16_t* dst = UPD + ((size_t)(bh * 64 + n) * 128 + 32 * eb) * 128 + 64 * dh + (lane & 31);
#pragma unroll
        for (int r = 0; r < 16; ++r) { const int e = crow(r, h5);
            const unsigned pw_ = pk2(a0[r], a1[r]); const bf16_t v0 = (bf16_t)(pw_ & 0xffffu), v1 = (bf16_t)(pw_ >> 16);
            if constexpr (FUSED) { __hip_atomic_store(dst + e * 128, v0, __ATOMIC_RELAXED, __HIP_MEMORY_SCOPE_AGENT); __hip_atomic_store(dst + e * 128 + 32, v1, __ATOMIC_RELAXED, __HIP_MEMORY_SCOPE_AGENT); }
            else { dst[e * 128] = v0; dst[e * 128 + 32] = v1; } }
        if constexpr (FUSED) asm volatile("s_waitcnt vmcnt(0)" ::: "memory");
        __syncthreads();
        if constexpr (FUSED) { if (tid == 0) xb_add(ctl + CW_C2 + 64 * bh, 1u); }
    }
}

#ifdef PROBE_T
#define DSTAMP(k) do { if (blockIdx.x == PROBE_B && threadIdx.x == 0) ((unsigned long long*)(p.ws + 49152))[k] = __builtin_amdgcn_s_memrealtime(); } while (0)
#else
#define DSTAMP(k) do {} while (0)
#endif
template <bool FUSED> DI void phase3(int wv, const Params& p, unsigned char* lds, unsigned* ctl) {
    const float* MP = (const float*)(p.ws + WS_MP); const bf16_t* UPD = (const bf16_t*)(p.ws + WS_UPD); bf16_t* TT = (bf16_t*)(p.ws + WS_TT);
    const int tid3 = opaque_tid(wv);
    float* kzL = (float*)lds; float* vL = (float*)(lds + 8192);
    if constexpr (FUSED) {
        const int h = (blockIdx.x >> 5) & 3, e0 = (blockIdx.x & 31) * 4; const float lg = log2_gamma(h);
#pragma unroll
        for (int i = 0; i < 4; ++i) { const int idx = tid3 + 512 * i, m = idx >> 7, d = idx & 127, dl = d & 63;
            const float* mp = MP + m * NPROJ + 5 * 512 + h * 128;
            const float x1 = mp[dl], x2 = mp[64 + dl]; float sn, cs; sincos_rr((float)m * rope_freq(dl), sn, cs);
            kzL[idx] = ((d < 64) ? (x1 * cs - x2 * sn) : (x1 * sn + x2 * cs)) * exp2f((float)(15 - m) * lg); }
        if (tid3 < 64) vL[tid3] = MP[(tid3 >> 2) * NPROJ + 6 * 512 + h * 128 + e0 + (tid3 & 3)];
        if (tid3 == 0) { unsigned* c2 = ctl + CW_C2 + 64 * (blockIdx.x >> 5); unsigned sp = 0u;
            while (xb_ld(c2) < 63u) { __builtin_amdgcn_s_sleep(1); if (++sp > (1u << 22)) break; } }
        __syncthreads();
    }
    DSTAMP(0);
    for (int gid = blockIdx.x * 512 + tid3; gid < 8 * 16384; gid += gridDim.x * 512) {
        const int bh = gid >> 14, idx = gid & 16383, e = idx >> 7, d = idx & 127, h = bh & 3;
        const float lg = log2_gamma(h), cdec = exp2f(128.f * lg);
        const int dl = d & 63; const float fq = rope_freq(dl);
        float s1 = 0.f;
        if constexpr (FUSED) {
#pragma unroll
            for (int m = 0; m < NMETA; ++m) s1 = fmaf(vL[m * 4 + (e & 3)], kzL[m * 128 + d], s1);
        } else {
#pragma unroll 4
        for (int m = 0; m < NMETA; ++m) {
            const float* mp = MP + m * NPROJ;
            const float x1 = mp[5 * 512 + h * 128 + dl], x2 = mp[5 * 512 + h * 128 + 64 + dl];
            float s, c; sincos_rr((float)m * fq, s, c);
            const float kr = (d < 64) ? (x1 * c - x2 * s) : (x1 * s + x2 * c);
            s1 = fmaf(mp[6 * 512 + h * 128 + e] * exp2f((float)(15 - m) * lg), kr, s1);
        }
        }
        DSTAMP(1);
        float T = cdec * s1;
        const bf16_t* up = UPD + (size_t)bh * 64 * 16384 + idx;
        bf16_t* tt = TT + (size_t)bh * 65 * 16384 + idx;
        if constexpr (FUSED) __hip_atomic_store(tt + 16384, (bf16_t)(pk2(T, 0.f) & 0xffffu), __ATOMIC_RELAXED, __HIP_MEMORY_SCOPE_AGENT); else tt[16384] = (bf16_t)(pk2(T, 0.f) & 0xffffu);
        bf16_t u[63];
#pragma unroll
        for (int i = 0; i < 63; ++i) u[i] = up[(size_t)(i + 1) * 16384];
#pragma unroll
        for (int i = 0; i < 63; ++i) { T = cdec * (T + __uint_as_float((unsigned)u[i] << 16)); const bf16_t tv = (bf16_t)(pk2(T, 0.f) & 0xffffu);
            if constexpr (FUSED) __hip_atomic_store(tt + (size_t)(i + 2) * 16384, tv, __ATOMIC_RELAXED, __HIP_MEMORY_SCOPE_AGENT); else tt[(size_t)(i + 2) * 16384] = tv; }
    }
    DSTAMP(2);
    if constexpr (FUSED) {
        asm volatile("s_waitcnt vmcnt(0)" ::: "memory");
        __syncthreads();
        DSTAMP(3);
        if (tid3 == 0) xb_add(ctl + CW_C3 + 64 * (blockIdx.x >> 5), 1u);
    }
}

template <bool FUSED> DI void phase4(int wv, const Params& p, unsigned char* lds, unsigned* ctl, int pm5) {
    const int tid = opaque_tid(wv), lane = tid & 63, wave = tid >> 6, h5 = lane >> 5;
    const bf16_t* QS = (const bf16_t*)(p.ws + WS_QS); const bf16_t* KZ = (const bf16_t*)(p.ws + WS_KZ); const bf16_t* V = (const bf16_t*)(p.ws + WS_V);
    const bf16_t* SRG = (const bf16_t*)(p.ws + WS_SRG); const bf16_t* TT = (const bf16_t*)(p.ws + WS_TT); bf16_t* MIX = (bf16_t*)(p.ws + WS_MIX);
    unsigned char* Qimg = lds; unsigned char* Kimg = lds + 32768; unsigned char* Vimg = lds + 65536; unsigned char* Timg = lds + 98304;
    float* OL = (float*)lds;
    const int ib = (wave < 4) ? wave : 7 - wave, eh = wave >> 2;
    u32x4 pq[4], pk[4], pv[4], pt[4];
    if (blockIdx.x < 8 * 64) { const int it = blockIdx.x, bh = it >> 6, n = 1 + (it & 63); const size_t row0 = (size_t)(bh >> 2) * SEQ + (size_t)(n - 1) * 128;
        tile_ld(pq, QS + row0 * 512 + (bh & 3) * 128, 512, tid); tile_ld(pk, KZ + row0 * 512 + (bh & 3) * 128, 512, tid); tile_ld(pv, V + row0 * 512 + (bh & 3) * 128, 512, tid);
        if constexpr (FUSED) {
            if (tid == 0) { unsigned* c3 = ctl + CW_C3 + 64 * bh; unsigned sp = 0u; while (xb_ld(c3) < 32u) { __builtin_amdgcn_s_sleep(1); if (++sp > (1u << 22)) break; }
                unsigned* c5 = ctl + CW_P5 + 64 * pm5; sp = 0u; while (xb_ld(c5) < 256u) { __builtin_amdgcn_s_sleep(1); if (++sp > (1u << 22)) break; } }
            __syncthreads();
        }
        tile_ld(pt, TT + ((size_t)bh * 65 + n) * 16384, 128, tid); }
    for (int it = blockIdx.x; it < 8 * 64; it += gridDim.x) {
        const int bh = it >> 6, n = 1 + (it & 63), b = bh >> 2, h = bh & 3;
        const size_t row0 = (size_t)b * SEQ + (size_t)(n - 1) * 128;
        const int it2 = it + gridDim.x;
        tile_st(Qimg, pq, tid); tile_st(Kimg, pk, tid); tile_st(Vimg, pv, tid); tile_st(Timg, pt, tid);
        if constexpr (FUSED) { if (it2 < 8 * 64 && tid == 0) { unsigned* c3 = ctl + CW_C3 + 64 * (it2 >> 6); unsigned sp = 0u; while (xb_ld(c3) < 32u) { __builtin_amdgcn_s_sleep(1); if (++sp > (1u << 22)) break; } } }
        u32x4 sgv[4];
        { const int rown = tid >> 2, partn = tid & 3;
            const u32x4* sp = (const u32x4*)(SRG + (row0 + rown) * 512 + h * 128 + 32 * partn);
#pragma unroll
            for (int k = 0; k < 4; ++k) sgv[k] = sp[k]; }
        __syncthreads();
        if (it2 < 8 * 64) { const int bh2 = it2 >> 6, n2 = 1 + (it2 & 63); const size_t row2 = (size_t)(bh2 >> 2) * SEQ + (size_t)(n2 - 1) * 128;
            tile_ld(pq, QS + row2 * 512 + (bh2 & 3) * 128, 512, tid); tile_ld(pk, KZ + row2 * 512 + (bh2 & 3) * 128, 512, tid); tile_ld(pv, V + row2 * 512 + (bh2 & 3) * 128, 512, tid);
            tile_ld(pt, TT + ((size_t)bh2 * 65 + n2) * 16384, 128, tid); }
        bf16x8 qf[8];
#pragma unroll
        for (int s = 0; s < 8; ++s) qf[s] = row_frag(Qimg, ib, s, lane);
        f32x16 O0, O1;
#pragma unroll
        for (int i = 0; i < 16; ++i) { O0[i] = 0.f; O1[i] = 0.f; }
#pragma unroll
        for (int jb = 0; jb < 4; ++jb) {
            if (jb <= ib) {
                f32x16 c;
#pragma unroll
                for (int i = 0; i < 16; ++i) c[i] = 0.f;
#pragma unroll
                for (int s = 0; s < 8; ++s) c = MFMA32(row_frag(Kimg, jb, s, lane), qf[s], c);
                if (jb == ib) {
#pragma unroll
                    for (int r = 0; r < 16; ++r) if (crow(r, h5) > (lane & 31)) c[r] = 0.f;
                }
#pragma unroll
                for (int s2 = 0; s2 < 2; ++s2) {
                    u32x4 pw; pw.x = pk2(c[8 * s2 + 0], c[8 * s2 + 1]); pw.y = pk2(c[8 * s2 + 2], c[8 * s2 + 3]); pw.z = pk2(c[8 * s2 + 4], c[8 * s2 + 5]); pw.w = pk2(c[8 * s2 + 6], c[8 * s2 + 7]);
                    const bf16x8 pa = __builtin_bit_cast(bf16x8, pw);
                    const bf16x8 v0 = tr_frag<true>(Vimg, 2 * eh, 32 * jb + 16 * s2, lane), v1 = tr_frag<true>(Vimg, 2 * eh + 1, 32 * jb + 16 * s2, lane);
                    O0 = MFMA32(pa, v0, O0); O1 = MFMA32(pa, v1, O1);
                }
            }
        }
#pragma unroll
        for (int s = 0; s < 8; ++s) { O0 = MFMA32(qf[s], row_frag(Timg, 2 * eh, s, lane), O0); O1 = MFMA32(qf[s], row_frag(Timg, 2 * eh + 1, s, lane), O1); }
        __syncthreads();
        {
            float* o = OL + (32 * ib) * 132 + 64 * eh + (lane & 31);
#pragma unroll
            for (int r = 0; r < 16; ++r) { const int i = crow(r, h5); o[i * 132] = O0[r]; o[i * 132 + 32] = O1[r]; }
        }
        __syncthreads();
        {
            const int row = tid >> 2, part = tid & 3;
            const float* o = OL + row * 132 + 32 * part;
            f32x4 v[8]; float s = 0.f;
#pragma unroll
            for (int k = 0; k < 8; ++k) { v[k] = *(const f32x4*)(o + 4 * k); s += (v[k][0] + v[k][1]) + (v[k][2] + v[k][3]); }
            s += shfl_idx(s, lane ^ 1); s += shfl_idx(s, lane ^ 2);
            const float mu = s * (1.f / 128.f); float q = 0.f;
#pragma unroll
            for (int k = 0; k < 8; ++k) { v[k] = v[k] - mu; q += (v[k][0] * v[k][0] + v[k][1] * v[k][1]) + (v[k][2] * v[k][2] + v[k][3] * v[k][3]); }
            q += shfl_idx(q, lane ^ 1); q += shfl_idx(q, lane ^ 2);
            const float rs = 1.f / sqrtf(q * (1.f / 128.f) + EPS);
            const size_t grow = row0 + row;
            u32x4* dp = (u32x4*)(MIX + grow * 1024 + 512 + h * 128 + 32 * part);
            const f32x4* gp = (const f32x4*)(p.rg + h * 128 + 32 * part);
#pragma unroll
            for (int k2 = 0; k2 < 4; ++k2) {
                const u32x4 sg = sgv[k2]; const f32x4 g0 = gp[2 * k2], g1 = gp[2 * k2 + 1];
                const f32x4 a = v[2 * k2], c2 = v[2 * k2 + 1];
                u32x4 w;
                w.x = pk2(a[0] * rs * g0[0] * bf_lo(sg.x), a[1] * rs * g0[1] * bf_hi(sg.x));
                w.y = pk2(a[2] * rs * g0[2] * bf_lo(sg.y), a[3] * rs * g0[3] * bf_hi(sg.y));
                w.z = pk2(c2[0] * rs * g1[0] * bf_lo(sg.z), c2[1] * rs * g1[1] * bf_hi(sg.z));
                w.w = pk2(c2[2] * rs * g1[2] * bf_lo(sg.w), c2[3] * rs * g1[3] * bf_hi(sg.w));
                if constexpr (FUSED) store16_sc1(dp + k2, w); else dp[k2] = w;
            }
        }
        if constexpr (FUSED) asm volatile("s_waitcnt vmcnt(0)" ::: "memory");
        __syncthreads();
        if constexpr (FUSED) { if (tid == 0) xb_add(ctl + CW_P5 + 64 * (b * 32 + ((n - 1) >> 1)), 1u); }
    }
}

DI void phase_convfix(int wv, const Params& p, unsigned* ctl) {
    const int tid = opaque_tid(wv);
    const float* halo = (const float*)(p.ws + WS_HALO); const float* MP = (const float*)(p.ws + WS_MP); bf16_t* MIX = (bf16_t*)(p.ws + WS_MIX);
    for (int pm = blockIdx.x; pm < 64; pm += gridDim.x) {
        const int ch = tid;
        float um1, um2;
        if ((pm & 31) == 0) { um2 = MP[14 * NPROJ + ch] * MP[14 * NPROJ + 1024 + ch]; um1 = MP[15 * NPROJ + ch] * MP[15 * NPROJ + 1024 + ch]; }
        else { um2 = halo[((size_t)((pm - 1) * 3 + 2) * 2 + 0) * 512 + ch]; um1 = halo[((size_t)((pm - 1) * 3 + 2) * 2 + 1) * 512 + ch]; }
        const float w0 = p.conv_w[ch], w1 = p.conv_w[512 + ch];
        const float c0 = halo[((size_t)(pm * 3 + 0) * 2 + 0) * 512 + ch] + w0 * um2 + w1 * um1;
        const float c1 = halo[((size_t)(pm * 3 + 0) * 2 + 1) * 512 + ch] + w0 * um1;
        const float g0 = halo[((size_t)(pm * 3 + 1) * 2 + 0) * 512 + ch], g1 = halo[((size_t)(pm * 3 + 1) * 2 + 1) * 512 + ch];
        __hip_atomic_store(MIX + (size_t)(pm * 256) * 1024 + ch, (bf16_t)(pk2(g0 * c0, 0.f) & 0xffffu), __ATOMIC_RELAXED, __HIP_MEMORY_SCOPE_AGENT);
        __hip_atomic_store(MIX + (size_t)(pm * 256 + 1) * 1024 + ch, (bf16_t)(pk2(g1 * c1, 0.f) & 0xffffu), __ATOMIC_RELAXED, __HIP_MEMORY_SCOPE_AGENT);
        asm volatile("s_waitcnt vmcnt(0)" ::: "memory");
        __syncthreads();
        if (tid == 0) xb_add(ctl + CW_P5 + 64 * pm, 256u);
    }
}

DI void phase6(int wv, const Params& p) {
    const int tid = opaque_tid(wv), lane = tid & 63, wave = tid >> 6;
    const float* part = (const float*)(p.ws + WS_PART);
    const int gw = blockIdx.x * 8 + wave, NGW = gridDim.x * 8;
    f32x4 g[4];
#pragma unroll
    for (int j = 0; j < 4; ++j) g[j] = ((const f32x4*)p.gf)[lane + 64 * j];
    for (int row = gw; row < M_TOK; row += NGW) {
        float s = (lane < 16) ? part[(size_t)lane * M_TOK + row] : 0.f;
        s = wave_sum(s, lane);
        const float rs = 1.f / sqrtf(s * (1.f / 1024.f) + EPS);
        f32x4* o = (f32x4*)(p.out + (size_t)row * DM) + lane;
#pragma unroll
        for (int j = 0; j < 4; ++j) { f32x4 v = o[64 * j]; v = v * rs * g[j]; o[64 * j] = v; }
    }
}

#ifndef DUP
#define DUP -1
#endif
#define REP(k) for (int rep_ = 0; rep_ < ((DUP == (k)) ? 2 : 1); ++rep_)
__global__ void __launch_bounds__(512, 2) hymba_fwd(Params p) {
    extern __shared__ __attribute__((aligned(16))) unsigned char lds[];
#ifdef USE_CG_FALLBACK
    cg::grid_group grid = cg::this_grid();
#endif
    const int wv = __builtin_amdgcn_readfirstlane((int)(threadIdx.x >> 6));
    unsigned char* ws = p.ws;
    unsigned* ctl = (unsigned*)ws;
    const bool fast = (gridDim.x == 256);
    volatile LAS unsigned* st = (volatile LAS unsigned*)((LAS unsigned char*)lds + 131072);
    if (threadIdx.x < 4) st[threadIdx.x] = 0u;
    __syncthreads();
    XcdBarrier bar = xcd_barrier_post(ctl, st); bar.wv = wv;
#ifdef USE_CG_FALLBACK
#define GSYNC() grid.sync()
#else
#define GSYNC() xcd_barrier(bar)
#endif
#define SEAM() do { if (fast) xcd_barrier(bar); else GSYNC(); } while (0)
#ifdef PROBE_T
    unsigned long long ts_[12]; int nts_ = 0;
#define STAMP() do { ts_[nts_++] = __builtin_amdgcn_s_memrealtime(); } while (0)
#else
#define STAMP() do {} while (0)
#endif
    STAMP();
    for (int pass_ = 0; pass_ < ((DUP == 9) ? 2 : 1); ++pass_) {
    REP(0) { phase0(wv, p, lds); __syncthreads(); }
    STAMP();
    SEAM();
    STAMP();
    if (DUP == 7) { for (int i_ = 0; i_ < 6; ++i_) SEAM(); }
    REP(1) {
        pg8::Gemm g{(const bf16_t*)(ws + WS_XB), (const bf16_t*)(ws + WS_WIN), M_TOK, NPROJ, DM};
        pg8::StaticOrder S; S.init(M_TOK, NPROJ, (int)gridDim.x, (int)blockIdx.x);
        EpiProj E{(const float*)(ws + WS_RSTD), (bf16_t*)(ws + WS_MIX), (bf16_t*)(ws + WS_QS), (bf16_t*)(ws + WS_KZ), (bf16_t*)(ws + WS_V), (bf16_t*)(ws + WS_SRG), p.conv_w, (float*)(ws + WS_HALO), (LAS unsigned char*)lds + 131072 + 2048};
        pg8::gemm_phase<EpiProj, pg8::StaticOrder, true, true>(wv, (LAS unsigned char*)lds, g, S, E);
    }
    STAMP();
    SEAM();
    STAMP();
    if (fast) {
        phase2<true>(wv, p, lds, ctl);
        STAMP();
        phase_convfix(wv, p, ctl);
        STAMP();
        phase3<true>(wv, p, lds, ctl);
        STAMP();
        int pm5; { pg8::StaticOrder S5; S5.init(M_TOK, DM, (int)gridDim.x, (int)blockIdx.x); pg8::Unit u5; (void)S5.next(0, u5); pm5 = u5.pm; }
        phase4<true>(wv, p, lds, ctl, pm5);
    } else {
        phase2<false>(wv, p, lds, ctl);
        GSYNC();
        phase3<false>(wv, p, lds, ctl);
        GSYNC();
        phase4<false>(wv, p, lds, ctl, 0);
        phase_convfix(wv, p, ctl);
    }
    STAMP();
    if (!fast) SEAM();
    STAMP();
    if (fast) REP(5) {
        pg8::Gemm g{(const bf16_t*)(ws + WS_MIX), (const bf16_t*)(ws + WS_WOUT), M_TOK, DM, DM};
        pg8::PanelOrder S; S.init(M_TOK, DM, (int)gridDim.x, (int)blockIdx.x); S.cnt = ctl + CW_P5;
        EpiOutNorm E{p.x, p.out, p.gf, (float*)(ws + WS_PART), ctl};
        pg8::gemm_phase<EpiOutNorm, pg8::PanelOrder, false, true, false>(wv, (LAS unsigned char*)lds, g, S, E);
    } else {
        pg8::Gemm g{(const bf16_t*)(ws + WS_MIX), (const bf16_t*)(ws + WS_WOUT), M_TOK, DM, DM};
        pg8::StaticOrder S; S.init(M_TOK, DM, (int)gridDim.x, (int)blockIdx.x);
        EpiOut E{p.x, p.out, (float*)(ws + WS_PART)};
        pg8::gemm_phase<EpiOut, pg8::StaticOrder, true, true>(wv, (LAS unsigned char*)lds, g, S, E);
        GSYNC();
        phase6(wv, p);
    }
    if (DUP == 9) SEAM();
    }
#ifdef PROBE_T
    STAMP(); SEAM();
    if (blockIdx.x == PROBE_B && threadIdx.x == 0) { const unsigned long long* ds_ = (const unsigned long long*)(p.ws + 49152);
        p.out[0] = (PROBE_T >= 100) ? (float)(ds_[PROBE_T - 99] - ds_[PROBE_T - 100]) * 0.01f : (PROBE_T == 99) ? (float)(ds_[0] - ts_[6]) * 0.01f : (PROBE_T == 98) ? (float)(ts_[10] - ts_[0]) * 0.001f : (float)(ts_[PROBE_T + 1] - ts_[PROBE_T]) * 0.01f; }
#endif
}

extern "C" void kernel_launch(void* const* d_in, const int* in_sizes, int n_in, void* d_out, int out_size, void* d_ws, size_t ws_size, hipStream_t stream) {
    static int grid = 0;
    if (grid == 0) {
        if (n_in != 8 || in_sizes[0] != M_TOK * DM || out_size != M_TOK * DM || ws_size < WS_END) { fprintf(stderr, "kernel_launch: unexpected shapes (n_in %d, in0 %d, out %d, ws %zu)\n", n_in, n_in > 0 ? in_sizes[0] : -1, out_size, ws_size); grid = -1; return; }
        int dev = 0, cus = 0, per_cu = 0;
        hipGetDevice(&dev);
        hipDeviceGetAttribute(&cus, hipDeviceAttributeMultiprocessorCount, dev);
        if (hipFuncSetAttribute((const void*)hymba_fwd, hipFuncAttributeMaxDynamicSharedMemorySize, LDS_BYTES) != hipSuccess) { fprintf(stderr, "kernel_launch: hipFuncSetAttribute failed\n"); grid = -1; return; }
        if (hipOccupancyMaxActiveBlocksPerMultiprocessor(&per_cu, (const void*)hymba_fwd, 512, LDS_BYTES) != hipSuccess || per_cu < 1) { fprintf(stderr, "kernel_launch: occupancy query gave %d\n", per_cu); (void)hipGetLastError(); per_cu = 1; }
        grid = cus * per_cu;
        if (grid > 256) grid = 256;
    }
    if (grid < 0) return;
    Params p{};
    p.x = (const float*)d_in[0]; p.meta = (const float*)d_in[1]; p.g1 = (const float*)d_in[2]; p.w_in = (const float*)d_in[3];
    p.conv_w = (const float*)d_in[4]; p.rg = (const float*)d_in[5]; p.w_out = (const float*)d_in[6]; p.gf = (const float*)d_in[7];
    p.out = (float*)d_out; p.ws = (unsigned char*)d_ws;
    if (hipMemsetAsync(d_ws, 0, CTL_ZERO_BYTES, stream) != hipSuccess) { fprintf(stderr, "kernel_launch: hipMemsetAsync failed\n"); return; }
    void* args[] = {&p};
#ifdef PLAIN_LAUNCH
    (void)args; hipLaunchKernelGGL(hymba_fwd, dim3(grid), dim3(512), LDS_BYTES, stream, p); hipError_t e = hipPeekAtLastError();
#else
    hipError_t e = hipLaunchCooperativeKernel((const void*)hymba_fwd, dim3(grid), dim3(512), args, LDS_BYTES, stream);
#endif
    if (e != hipSuccess) fprintf(stderr, "cooperative launch failed: %s (grid %d)\n", hipGetErrorString(e), grid);
}
```
